# Optimizing an MI355X kernel written in HIP

```python
import jax, jax.numpy as jnp
from jax import lax
import numpy as np

D_MODEL = 1024
BATCH = 8
SEQ = 4096
DEPTH = 4

N_A_LAYERS = DEPTH // 2
N_B_LAYERS = DEPTH - N_A_LAYERS

NSA_HEADS = 16
NSA_HEAD_DIM = D_MODEL // NSA_HEADS
NSA_KV_GROUPS = 2
NSA_HEADS_PER_GROUP = NSA_HEADS // NSA_KV_GROUPS
NSA_KV_WIDTH = NSA_KV_GROUPS * NSA_HEAD_DIM
NSA_GATE_WIDTH = 3 * NSA_HEADS
NSA_IN_WIDTH = D_MODEL + 6 * NSA_KV_WIDTH + NSA_GATE_WIDTH
CMP_BLOCK = 32
CMP_STRIDE = 16
CMP_MLP_HIDDEN = 128
SLC_BLOCK = 64
SLC_TOPK = 16
WINDOW = 512
NSA_Q_BLOCK = 64
FORCE_BONUS = 1000.0

DIFF_HEADS = 8
DIFF_HEAD_DIM = D_MODEL // (2 * DIFF_HEADS)
DIFF_V_DIM = 2 * DIFF_HEAD_DIM
DIFF_Q_BLOCK = 128

ROPE_THETA = 500000.0
ROPE_FRACTION = 4
D_FF = 2816
DEEPNORM_ALPHA = (2 * DEPTH) ** 0.25
DEEPNORM_BETA = (8 * DEPTH) ** -0.25
NORM_EPS = 1e-5
NEG = -1e30

kernel_name = 'yoco_nsa_diffattn_macaron_deepnorm'


def partial_rope(x, positions):
    d = x.shape[-1]
    r = d // ROPE_FRACTION
    half = r // 2
    inv = ROPE_THETA ** (-jnp.arange(half, dtype=jnp.float32) * 2.0 / r)
    ang = positions.astype(jnp.float32)[:, None] * inv[None, :]
    cos = jnp.cos(ang)[:, None, :].astype(x.dtype)
    sin = jnp.sin(ang)[:, None, :].astype(x.dtype)
    x1 = x[..., :half]
    x2 = x[..., half:r]
    return jnp.concatenate([x1 * cos - x2 * sin, x1 * sin + x2 * cos, x[..., r:]], axis=-1)


def layer_norm(x, g, b):
    xf = x.astype(jnp.float32)
    mu = jnp.mean(xf, axis=-1, keepdims=True)
    var = jnp.mean(jnp.square(xf - mu), axis=-1, keepdims=True)
    return ((xf - mu) * lax.rsqrt(var + NORM_EPS) * g + b).astype(x.dtype)


def rms_norm(x, g):
    xf = x.astype(jnp.float32)
    return (xf * lax.rsqrt(jnp.mean(jnp.square(xf), axis=-1, keepdims=True) + NORM_EPS) * g).astype(x.dtype)


def post_norm(x, f, g, b):
    return layer_norm(DEEPNORM_ALPHA * x + f, g, b)


def swiglu(x, w_gate, w_up, w_down):
    return (jax.nn.silu(x @ w_gate) * (x @ w_up)) @ w_down


def compress(k, pos_emb, w1, b1, w2):
    B, S, G, Dh = k.shape
    n_c = (S - CMP_BLOCK) // CMP_STRIDE + 1
    idx = np.arange(n_c)[:, None] * CMP_STRIDE + np.arange(CMP_BLOCK)[None, :]
    blocks = k[:, idx] + pos_emb[:, None, :]
    blocks = jnp.swapaxes(blocks, 2, 3).reshape(B, n_c, G, CMP_BLOCK * Dh)
    return jax.nn.gelu(blocks @ w1 + b1) @ w2


def cmp_to_slc_matrix(n_c, n_sel):
    c0 = np.arange(n_c)[:, None] * CMP_STRIDE
    s0 = np.arange(n_sel)[None, :] * SLC_BLOCK
    ov = np.minimum(c0 + CMP_BLOCK, s0 + SLC_BLOCK) - np.maximum(c0, s0)
    return (np.clip(ov, 0, None) / CMP_BLOCK).astype(np.float32)


def nsa_mixer(x, w_in, pos_k, w1_k, b1_k, w2_k, pos_v, w1_v, b1_v, w2_v, w_out, positions):
    B, S, _ = x.shape
    H, G, Hg, Dh = NSA_HEADS, NSA_KV_GROUPS, NSA_HEADS_PER_GROUP, NSA_HEAD_DIM
    QB = NSA_Q_BLOCK
    proj = x @ w_in
    cuts = [int(c) for c in np.cumsum([D_MODEL] + [NSA_KV_WIDTH] * 6)]
    q, kc, vc, ks, vs, kw, vw, gates = jnp.split(proj, cuts, axis=-1)
    q = q.reshape(B, S, H, Dh) * (Dh ** -0.5)
    q_rot = partial_rope(q, positions)
    kv = lambda t: t.reshape(B, S, G, Dh)
    k_cmp = compress(kv(kc), pos_k, w1_k, b1_k, w2_k)
    v_cmp = compress(kv(vc), pos_v, w1_v, b1_v, w2_v)
    n_c = k_cmp.shape[1]
    n_sel = S // SLC_BLOCK
    k_blocks = partial_rope(kv(ks), positions).reshape(B, n_sel, SLC_BLOCK, G, Dh).transpose(0, 3, 1, 2, 4)
    v_blocks = kv(vs).reshape(B, n_sel, SLC_BLOCK, G, Dh).transpose(0, 3, 1, 2, 4)
    pad = ((0, 0), (WINDOW, 0), (0, 0), (0, 0))
    kw_pad = jnp.pad(partial_rope(kv(kw), positions), pad)
    vw_pad = jnp.pad(kv(vw), pad)

    cmp_end = jnp.asarray(np.arange(n_c) * CMP_STRIDE + CMP_BLOCK - 1)
    overlap = jnp.asarray(cmp_to_slc_matrix(n_c, n_sel))
    k_top = min(SLC_TOPK, n_sel)
    nqb = S // QB
    bi = jnp.arange(B)[:, None, None, None]
    gi = jnp.arange(G)[None, None, :, None]
    blk = jnp.arange(n_sel)

    def to_blocks(t):
        return jnp.moveaxis(t.reshape(B, nqb, QB, G, Hg, Dh), 1, 0)

    def step(args):
        qc, qr, i = args
        t = i * QB + jnp.arange(QB)
        vis = cmp_end[None, :] <= t[:, None]
        s = jnp.einsum('bqghd,bcgd->bqghc', qc, k_cmp).astype(jnp.float32)
        s = jnp.where(vis[None, :, None, None, :], s, NEG)
        p_cmp = jax.nn.softmax(s, axis=-1) * jnp.any(vis, axis=-1)[None, :, None, None, None]
        o_cmp = jnp.einsum('bqghc,bcgd->bqghd', p_cmp.astype(v_cmp.dtype), v_cmp)
        cur = t // SLC_BLOCK
        imp = jnp.einsum('bqghc,cn->bqgn', p_cmp, overlap)
        forced = (blk[None] == 0) | (blk[None] == cur[:, None]) | (blk[None] == cur[:, None] - 1)
        valid = blk[None] <= cur[:, None]
        imp = jnp.where(valid[None, :, None, :], imp + jnp.where(forced, FORCE_BONUS, 0.0)[None, :, None, :], NEG)
        _, sel = lax.top_k(imp, k_top)
        k_sel = k_blocks[bi, gi, sel]
        v_sel = v_blocks[bi, gi, sel]
        key_pos = sel[..., None] * SLC_BLOCK + jnp.arange(SLC_BLOCK)
        ok = key_pos <= t[None, :, None, None, None]
        s = jnp.einsum('bqghd,bqgnkd->bqghnk', qr, k_sel).astype(jnp.float32)
        s = jnp.where(ok[:, :, :, None], s, NEG)
        p = jax.nn.softmax(s.reshape(s.shape[:4] + (-1,)), axis=-1).reshape(s.shape)
        o_slc = jnp.einsum('bqghnk,bqgnkd->bqghd', p.astype(v_sel.dtype), v_sel)
        start = i * QB
        k_win = lax.dynamic_slice_in_dim(kw_pad, start, QB + WINDOW, axis=1)
        v_win = lax.dynamic_slice_in_dim(vw_pad, start, QB + WINDOW, axis=1)
        kpos = start - WINDOW + jnp.arange(QB + WINDOW)
        okw = (kpos[None] <= t[:, None]) & (kpos[None] > t[:, None] - WINDOW) & (kpos[None] >= 0)
        s = jnp.einsum('bqghd,bkgd->bqghk', qr, k_win).astype(jnp.float32)
        s = jnp.where(okw[None, :, None, None, :], s, NEG)
        p = jax.nn.softmax(s, axis=-1)
        o_win = jnp.einsum('bqghk,bkgd->bqghd', p.astype(v_win.dtype), v_win)
        return o_cmp, o_slc, o_win

    outs = lax.map(step, (to_blocks(q), to_blocks(q_rot), jnp.arange(nqb)))
    o_cmp, o_slc, o_win = [jnp.moveaxis(o, 0, 1).reshape(B, S, H, Dh) for o in outs]
    g = jax.nn.sigmoid(gates.reshape(B, S, 3, H))[..., None]
    o = g[:, :, 0] * o_cmp + g[:, :, 1] * o_slc + g[:, :, 2] * o_win
    return o.reshape(B, S, D_MODEL) @ w_out


def shared_kv(x, w_kv, positions):
    B, S, _ = x.shape
    k, v = jnp.split(x @ w_kv, [D_MODEL], axis=-1)
    k = k.reshape(B, S, 2, DIFF_HEADS, DIFF_HEAD_DIM)
    k1 = partial_rope(k[:, :, 0], positions)
    k2 = partial_rope(k[:, :, 1], positions)
    return k1, k2, v.reshape(B, S, DIFF_HEADS, DIFF_V_DIM)


def diff_mixer(x, k1, k2, v, w_q, lq1, lk1, lq2, lk2, subln_g, w_out, positions, lambda_init):
    B, S, _ = x.shape
    H, Dh, QB = DIFF_HEADS, DIFF_HEAD_DIM, DIFF_Q_BLOCK
    q = (x @ w_q).reshape(B, S, 2, H, Dh) * (Dh ** -0.5)
    q1 = partial_rope(q[:, :, 0], positions)
    q2 = partial_rope(q[:, :, 1], positions)
    lam = (jnp.exp(jnp.sum(lq1.astype(jnp.float32) * lk1.astype(jnp.float32)))
           - jnp.exp(jnp.sum(lq2.astype(jnp.float32) * lk2.astype(jnp.float32))) + lambda_init)
    nqb = S // QB
    to_blocks = lambda t: jnp.moveaxis(t.reshape(B, nqb, QB, H, Dh), 1, 0)
    kpos = jnp.arange(S)

    def step(args):
        q1b, q2b, i = args
        t = i * QB + jnp.arange(QB)
        mask = (kpos[None, :] <= t[:, None])[None, None]

        def attn_map(qb, k):
            s = jnp.einsum('bqhd,bkhd->bhqk', qb, k).astype(jnp.float32)
            return jax.nn.softmax(jnp.where(mask, s, NEG), axis=-1)

        a = attn_map(q1b, k1) - lam * attn_map(q2b, k2)
        return jnp.einsum('bhqk,bkhe->bqhe', a.astype(v.dtype), v)

    o = lax.map(step, (to_blocks(q1), to_blocks(q2), jnp.arange(nqb)))
    o = jnp.moveaxis(o, 0, 1).reshape(B, S, H, DIFF_V_DIM)
    o = rms_norm(o, subln_g) * (1.0 - lambda_init)
    return o.reshape(B, S, D_MODEL) @ w_out


def setup_inputs(seed: int = 0) -> dict:
    key = jax.random.key(seed)
    ks = jax.random.split(key, 32)
    f32 = jnp.float32
    nrm = lambda k, shape, scale: jax.random.normal(k, shape, f32) * scale
    D, F, Dh = D_MODEL, D_FF, NSA_HEAD_DIM
    L_flat = CMP_BLOCK * Dh
    return {
        'x': nrm(ks[0], (BATCH, SEQ, D), 1.0),
        'ffn1_w_gate': nrm(ks[1], (DEPTH, D, F), D ** -0.5),
        'ffn1_w_up': nrm(ks[2], (DEPTH, D, F), D ** -0.5),
        'ffn1_w_down': nrm(ks[3], (DEPTH, F, D), F ** -0.5 * DEEPNORM_BETA),
        'ffn2_w_gate': nrm(ks[4], (DEPTH, D, F), D ** -0.5),
        'ffn2_w_up': nrm(ks[5], (DEPTH, D, F), D ** -0.5),
        'ffn2_w_down': nrm(ks[6], (DEPTH, F, D), F ** -0.5 * DEEPNORM_BETA),
        'ln_g': 1.0 + nrm(ks[7], (DEPTH, 3, D), 0.02),
        'ln_b': nrm(ks[8], (DEPTH, 3, D), 0.02),
        'a_w_in': nrm(ks[9], (N_A_LAYERS, D, NSA_IN_WIDTH), D ** -0.5),
        'a_cmp_pos_k': nrm(ks[10], (N_A_LAYERS, CMP_BLOCK, Dh), 0.02),
        'a_cmp_w1_k': nrm(ks[11], (N_A_LAYERS, L_flat, CMP_MLP_HIDDEN), L_flat ** -0.5),
        'a_cmp_b1_k': nrm(ks[12], (N_A_LAYERS, CMP_MLP_HIDDEN), 0.02),
        'a_cmp_w2_k': nrm(ks[13], (N_A_LAYERS, CMP_MLP_HIDDEN, Dh), CMP_MLP_HIDDEN ** -0.5),
        'a_cmp_pos_v': nrm(ks[14], (N_A_LAYERS, CMP_BLOCK, Dh), 0.02),
        'a_cmp_w1_v': nrm(ks[15], (N_A_LAYERS, L_flat, CMP_MLP_HIDDEN), L_flat ** -0.5),
        'a_cmp_b1_v': nrm(ks[16], (N_A_LAYERS, CMP_MLP_HIDDEN), 0.02),
        'a_cmp_w2_v': nrm(ks[17], (N_A_LAYERS, CMP_MLP_HIDDEN, Dh), CMP_MLP_HIDDEN ** -0.5),
        'a_w_out': nrm(ks[18], (N_A_LAYERS, D, D), D ** -0.5 * DEEPNORM_BETA),
        'b_w_kv_shared': nrm(ks[19], (D, 2 * D), D ** -0.5),
        'b_w_q': nrm(ks[20], (N_B_LAYERS, D, D), D ** -0.5),
        'b_lambda_q1': nrm(ks[21], (N_B_LAYERS, DIFF_HEAD_DIM), 0.1),
        'b_lambda_k1': nrm(ks[22], (N_B_LAYERS, DIFF_HEAD_DIM), 0.1),
        'b_lambda_q2': nrm(ks[23], (N_B_LAYERS, DIFF_HEAD_DIM), 0.1),
        'b_lambda_k2': nrm(ks[24], (N_B_LAYERS, DIFF_HEAD_DIM), 0.1),
        'b_subln_g': 1.0 + nrm(ks[25], (N_B_LAYERS, DIFF_V_DIM), 0.02),
        'b_w_out': nrm(ks[26], (N_B_LAYERS, D, D), D ** -0.5 * DEEPNORM_BETA),
    }


def reference(x, ffn1_w_gate, ffn1_w_up, ffn1_w_down, ffn2_w_gate, ffn2_w_up, ffn2_w_down,
              ln_g, ln_b, a_w_in, a_cmp_pos_k, a_cmp_w1_k, a_cmp_b1_k, a_cmp_w2_k,
              a_cmp_pos_v, a_cmp_w1_v, a_cmp_b1_v, a_cmp_w2_v, a_w_out,
              b_w_kv_shared, b_w_q, b_lambda_q1, b_lambda_k1, b_lambda_q2, b_lambda_k2,
              b_subln_g, b_w_out):
    S = x.shape[1]
    positions = jnp.arange(S)
    k1 = k2 = v = None
    for layer in range(DEPTH):
        x = post_norm(x, 0.5 * swiglu(x, ffn1_w_gate[layer], ffn1_w_up[layer], ffn1_w_down[layer]),
                      ln_g[layer, 0], ln_b[layer, 0])
        if layer < N_A_LAYERS:
            mix = nsa_mixer(x, a_w_in[layer], a_cmp_pos_k[layer], a_cmp_w1_k[layer], a_cmp_b1_k[layer],
                            a_cmp_w2_k[layer], a_cmp_pos_v[layer], a_cmp_w1_v[layer], a_cmp_b1_v[layer],
                            a_cmp_w2_v[layer], a_w_out[layer], positions)
        else:
            j = layer - N_A_LAYERS
            lambda_init = 0.8 - 0.6 * float(np.exp(-0.3 * layer))
            mix = diff_mixer(x, k1, k2, v, b_w_q[j], b_lambda_q1[j], b_lambda_k1[j], b_lambda_q2[j],
                             b_lambda_k2[j], b_subln_g[j], b_w_out[j], positions, lambda_init)
        x = post_norm(x, mix, ln_g[layer, 1], ln_b[layer, 1])
        x = post_norm(x, 0.5 * swiglu(x, ffn2_w_gate[layer], ffn2_w_up[layer], ffn2_w_down[layer]),
                      ln_g[layer, 2], ln_b[layer, 2])
        if layer == N_A_LAYERS - 1:
            k1, k2, v = shared_kv(x, b_w_kv_shared, positions)
    return x
```

```cpp
#include <hip/hip_runtime.h>
#include <hip/hip_cooperative_groups.h>
#include <cstdio>
namespace cg = cooperative_groups;

#define DI __device__ __forceinline__
typedef unsigned short u16;
typedef unsigned long long u64;
using bf16x8 = __attribute__((ext_vector_type(8))) short;
using s16x4 = __attribute__((ext_vector_type(4))) short;
using f32x4 = __attribute__((ext_vector_type(4))) float;
using f32x16 = __attribute__((ext_vector_type(16))) float;
using f32x2 = __attribute__((ext_vector_type(2))) float;
using bf16v2 = __attribute__((ext_vector_type(2))) __bf16;

constexpr int NB = 8, S = 4096, M = NB * S, D = 1024, F = 2816;
constexpr int NTHR = 512;
constexpr int SMEM_BYTES = 155648;
constexpr float ALPHA = 1.681792830507429f;
constexpr float NEGF = -1e30f;

constexpr size_t OFF_XB = 0;
constexpr size_t OFF_H = 67108864;
constexpr size_t OFF_KV = OFF_H + 184549376;
constexpr size_t OFF_W = OFF_KV + 134217728;
constexpr size_t SZ_WGU = 11534336, SZ_WD = 5767168;
constexpr size_t LW_A = 41943040, LW_B = 38797312;
constexpr size_t OFF_WKV = OFF_W + 2 * LW_B;
constexpr size_t OFF_SEG = OFF_WKV + 4194304;
constexpr size_t SZ_SEG = 8388608;
constexpr size_t OFF_GATES = OFF_SEG + 6 * SZ_SEG;
constexpr size_t OFF_KCMP = OFF_GATES + 6291456;
constexpr size_t OFF_VCMPT = OFF_KCMP + 524288;
constexpr size_t OFF_ROPE = OFF_VCMPT + 524288;
constexpr size_t OFF_B1P = OFF_ROPE + 262144;
constexpr size_t OFF_BAR = OFF_B1P + 4096;
constexpr size_t OFF_CNT = OFF_BAR + 16384;
constexpr size_t OFF_SLOTS = OFF_CNT + 32768;
constexpr size_t WS_NEED = OFF_SLOTS + 1048576;
constexpr size_t OFF_PROJ = OFF_H;
constexpr size_t OFF_QR = OFF_H + 67108864;
constexpr size_t OFF_PARK = OFF_H + 134217728;
constexpr size_t OFF_KD = OFF_KV;
constexpr size_t OFF_VD = OFF_KV + 67108864;

struct Params {
  const float* in[27];
  float* out;
  char* ws;
};

struct Params;
typedef __attribute__((address_space(1))) char gchar_t;
DI char* launder_ptr(char* w) { gchar_t* g = (gchar_t*)w; asm volatile("" : "+s"(g)); return (char*)g; }
DI int get_tid() { int t = threadIdx.x; asm volatile("" : "+v"(t)); return t; }
DI float shx(float v, int mask, int lane) { return __int_as_float(__builtin_amdgcn_ds_bpermute((lane ^ mask) << 2, __float_as_int(v))); }
DI u16 f2bf(float x) { return __builtin_bit_cast(u16, (__bf16)x); }
DI unsigned pack2(float a, float b) {
  f32x2 v = {a, b};
  return __builtin_bit_cast(unsigned, __builtin_convertvector(v, bf16v2));
}
DI float bf2f(u16 v) { return __uint_as_float(((unsigned)v) << 16); }
DI f32x16 mfma32(bf16x8 a, bf16x8 b, f32x16 c) { return __builtin_amdgcn_mfma_f32_32x32x16_bf16(a, b, c, 0, 0, 0); }

DI char* layer_w(char* ws, int l) { return l < 2 ? ws + OFF_KV + (size_t)l * LW_A : ws + OFF_W + (size_t)(l - 2) * LW_B; }

struct Task { const float* src; u16* dst; int K, Nsrc, Ndst, mode; };
DI Task get_task(const Params& p, int task) {
  Task t; t.src = nullptr; t.dst = nullptr; t.K = 0; t.Nsrc = 0; t.Ndst = 0; t.mode = 0;
  if (task == 40) { t.src = p.in[19]; t.dst = (u16*)(p.ws + OFF_WKV); t.K = 1024; t.Nsrc = 2048; t.Ndst = 2048; return t; }
  int l = task / 10, k = task % 10;
  char* wb = layer_w(p.ws, l);
  if (k < 6) {
    int f2 = k / 3, kk = k % 3;
    const float* src = p.in[1 + f2 * 3 + kk];
    if (kk < 2) { t.src = src + (size_t)l * D * F; t.dst = (u16*)(wb + f2 * (SZ_WGU + SZ_WD)); t.K = D; t.Nsrc = F; t.Ndst = F; t.mode = 1 + kk; }
    else { t.src = src + (size_t)l * F * D; t.dst = (u16*)(wb + f2 * (SZ_WGU + SZ_WD) + SZ_WGU); t.K = F; t.Nsrc = D; t.Ndst = D; }
    return t;
  }
  char* mb = wb + 2 * (SZ_WGU + SZ_WD);
  if (l < 2) {
    if (k == 6) { t.src = p.in[9] + (size_t)l * D * 1840; t.dst = (u16*)mb; t.K = D; t.Nsrc = 1840; t.Ndst = 2048; }
    else if (k == 7) { t.src = p.in[18] + (size_t)l * D * D; t.dst = (u16*)(mb + 4194304); t.K = D; t.Nsrc = D; t.Ndst = D; }
    else if (k == 8) { t.src = p.in[11] + (size_t)l * 2048 * 128; t.dst = (u16*)(mb + 4194304 + 2097152); t.K = 2048; t.Nsrc = 128; t.Ndst = 128; }
    else { t.src = p.in[15] + (size_t)l * 2048 * 128; t.dst = (u16*)(mb + 4194304 + 2097152 + 524288); t.K = 2048; t.Nsrc = 128; t.Ndst = 128; }
  } else {
    int j = l - 2;
    if (k == 6) { t.src = p.in[20] + (size_t)j * D * D; t.dst = (u16*)mb; t.K = D; t.Nsrc = D; t.Ndst = D; }
    else if (k == 7) { t.src = p.in[26] + (size_t)j * D * D; t.dst = (u16*)(mb + 2097152); t.K = D; t.Nsrc = D; t.Ndst = D; }
  }
  return t;
}

DI void prep_phase(const Params& p, char* smem) {
  const int tid = get_tid();
  float* T = (float*)smem;
  {
    for (int gt = blockIdx.x; gt < 5056; gt += gridDim.x) {
      int task, tile;
      if (gt >= 4928) { task = 40; tile = gt - 4928; }
      else {
        int l, r;
        if (gt < 2560) { l = gt / 1280; r = gt - l * 1280; } else { l = 2 + (gt - 2560) / 1184; r = (gt - 2560) % 1184; }
        if (r < 1056) { task = l * 10 + r / 176; tile = r % 176; }
        else {
          r -= 1056;
          if (l < 2) { if (r < 128) { task = l * 10 + 6; tile = r; } else if (r < 192) { task = l * 10 + 7; tile = r - 128; } else if (r < 208) { task = l * 10 + 8; tile = r - 192; } else { task = l * 10 + 9; tile = r - 208; } }
          else { if (r < 64) { task = l * 10 + 6; tile = r; } else { task = l * 10 + 7; tile = r - 64; } }
        }
      }
      Task t = get_task(p, task);
      const int nkt = t.K / 256;
      const int k0 = (tile % nkt) * 256, n0 = (tile / nkt) * 64;
      __syncthreads();
      float4 v[8];
#pragma unroll
      for (int e = 0; e < 8; ++e) {
        int idx = tid + e * 512, kk = idx >> 4, n4 = (idx & 15) * 4;
        v[e] = (n0 + n4 < t.Nsrc) ? *(const float4*)(t.src + (size_t)(k0 + kk) * t.Nsrc + n0 + n4) : make_float4(0.f, 0.f, 0.f, 0.f);
      }
#pragma unroll
      for (int e = 0; e < 8; ++e) {
        int idx = tid + e * 512, kk = idx >> 4, n4 = (idx & 15) * 4;
        T[(n4 + 0) * 257 + kk] = v[e].x; T[(n4 + 1) * 257 + kk] = v[e].y; T[(n4 + 2) * 257 + kk] = v[e].z; T[(n4 + 3) * 257 + kk] = v[e].w;
      }
      __syncthreads();
      const int nn = tid >> 3;
      int n = n0 + nn;
      int drow = t.mode == 0 ? n : ((n >> 7) * 256 + (t.mode - 1) * 128 + (n & 127));
#pragma unroll
      for (int j = 0; j < 4; ++j) {
        const int kc = (tid & 7) * 8 + j * 64;
        const float* tp = T + nn * 257 + kc;
        uint4 o;
        o.x = pack2(tp[0], tp[1]); o.y = pack2(tp[2], tp[3]); o.z = pack2(tp[4], tp[5]); o.w = pack2(tp[6], tp[7]);
        *(uint4*)(t.dst + (size_t)drow * t.K + k0 + kc) = o;
      }
    }
  }
  {
    const float4* xs = (const float4*)p.in[0];
    uint2* xb = (uint2*)(p.ws + OFF_XB);
    u16* lo = (u16*)p.out;
    const size_t n4 = (size_t)M * D / 4;
    const size_t stride = (size_t)gridDim.x * NTHR;
    for (size_t i = (size_t)blockIdx.x * NTHR + tid; i < n4; i += 4 * stride) {
      float4 v[4];
#pragma unroll
      for (int j = 0; j < 4; ++j) v[j] = xs[i + j * stride];
#pragma unroll
      for (int j = 0; j < 4; ++j) {
        const size_t e = i + j * stride;
        uint2 o; o.x = pack2(v[j].x, v[j].y); o.y = pack2(v[j].z, v[j].w);
        xb[e] = o;
        const unsigned l0 = __float_as_uint(v[j].x) - (o.x << 16), l1 = __float_as_uint(v[j].y) - (o.x & 0xffff0000u);
        const unsigned l2 = __float_as_uint(v[j].z) - (o.y << 16), l3 = __float_as_uint(v[j].w) - (o.y & 0xffff0000u);
        uint2 lw; lw.x = (l0 & 0xffffu) | (l1 << 16); lw.y = (l2 & 0xffffu) | (l3 << 16);
        const size_t row = e >> 8, c4 = e & 255;
        *(uint2*)(lo + row * 2048 + 1024 + c4 * 4) = lw;
      }
    }
  }
  {
    float2* rt = (float2*)(p.ws + OFF_ROPE);
    for (int i = blockIdx.x * NTHR + tid; i < 4096 * 8; i += gridDim.x * NTHR) {
      int pos = i >> 3, k = i & 7;
      float inv = (float)pow(500000.0, -(double)k / 8.0);
      float ang = (float)pos * inv;
      rt[i] = make_float2((float)cos((double)ang), (float)sin((double)ang));
    }
  }
  if (blockIdx.x < 4 && tid < 128) {
    int l = blockIdx.x >> 1, kv = blockIdx.x & 1;
    const float* pos = p.in[kv ? 14 : 10] + (size_t)l * 2048;
    const float* w1 = p.in[kv ? 15 : 11] + (size_t)l * 2048 * 128;
    const float* b1 = p.in[kv ? 16 : 12] + (size_t)l * 128;
    float acc = b1[tid];
    for (int i = 0; i < 2048; ++i) acc += pos[i] * w1[(size_t)i * 128 + tid];
    ((float*)(p.ws + OFF_B1P))[(l * 2 + kv) * 128 + tid] = acc;
  }
}

#define LAS __attribute__((address_space(3)))
constexpr int BM = 256, BK = 64, HALF = 128, HTB = HALF * BK * 2;

DI int lds_byte(int r, int c) {
  const int st = (r >> 4) * 2 + (c >> 5), rr = r & 15, cc = c & 31, ob = rr * 64 + cc * 2;
  return st * 1024 + (ob ^ (((ob >> 9) & 1) << 5));
}
DI void stage_rc(int b, int& R, int& C) {
  const int st = b / 1024, sb = b % 1024, swz = sb ^ (((sb >> 9) & 1) << 5);
  R = (st >> 1) * 16 + swz / 64; C = (st & 1) * 32 + (swz % 64) / 2;
}
DI int perm32(int rho) { const int n = rho >> 4, i = rho & 15; return 8 * (i >> 2) + 4 * n + (i & 3); }

enum { EPI_GATEUP = 0, EPI_RESID = 1, EPI_NSA_IN = 2, EPI_DIFF_Q = 3, EPI_DIFF_KV = 4 };

DI bool unit_next(int i, int nM, int nN, int& pm, int& pn) {
  const int nwg = nM * nN;
  const long L = (long)i * gridDim.x + blockIdx.x;
  if (L >= nwg) return false;
  int wgid = (int)L;
  { const int q = nwg / 8, r = nwg % 8, xcd = wgid % 8, off = wgid / 8; wgid = (xcd < r ? xcd * (q + 1) : r * (q + 1) + (xcd - r) * q) + off; }
  const int nig = 8 * nN, gid = wgid / nig, fm = gid * 8, gsz = (nM - fm) < 8 ? (nM - fm) : 8;
  pm = fm + ((wgid % nig) % gsz); pn = (wgid % nig) / gsz;
  return true;
}

DI void rope8(float* v, int fq, int pos, const float* rt, int lane) {
  float o[8];
#pragma unroll
  for (int i = 0; i < 8; ++i) o[i] = shx(v[i], 16, lane);
  if (fq < 2) {
    const float4* r4 = (const float4*)(rt + pos * 16);
#pragma unroll
    for (int i = 0; i < 4; ++i) {
      float4 cs = r4[i];
      float a0 = v[2 * i], a1 = v[2 * i + 1];
      if (fq == 0) { v[2 * i] = a0 * cs.x - o[2 * i] * cs.y; v[2 * i + 1] = a1 * cs.z - o[2 * i + 1] * cs.w; }
      else { v[2 * i] = o[2 * i] * cs.y + a0 * cs.x; v[2 * i + 1] = o[2 * i + 1] * cs.w + a1 * cs.z; }
    }
  }
}
DI uint4 pack8(const float* v) {
  uint4 o; o.x = pack2(v[0], v[1]); o.y = pack2(v[2], v[3]); o.z = pack2(v[4], v[5]); o.w = pack2(v[6], v[7]);
  return o;
}

DI void gemm_epi(const Params& p, int mode, float coef, const f32x4 (&acc)[2][2][4][2], int pm, int pn, int wr, int wc, int fr, int fq) {
  char* ws = launder_ptr(p.ws);
  const float* rt = (const float*)(ws + OFF_ROPE);
#pragma unroll
  for (int ai = 0; ai < 2; ++ai)
#pragma unroll
    for (int m = 0; m < 4; ++m) {
      const int row = pm * BM + ai * HALF + wr * 64 + m * 16 + fr;
      const int b = row >> 12, s = row & 4095;
      if (mode == EPI_GATEUP) {
        float v[8];
#pragma unroll
        for (int n = 0; n < 2; ++n)
#pragma unroll
          for (int e = 0; e < 4; ++e) {
            float gv = acc[ai][0][m][n][e], uv = acc[ai][1][m][n][e];
            v[n * 4 + e] = gv * uv * __builtin_amdgcn_rcpf(1.f + __builtin_amdgcn_exp2f(-1.4426950408889634f * gv));
          }
        *(uint4*)((u16*)(ws + OFF_H) + (size_t)row * F + pn * 128 + wc * 32 + 8 * fq) = pack8(v);
      } else if (mode == EPI_RESID) {
#pragma unroll
        for (int bj = 0; bj < 2; ++bj)
#pragma unroll
          for (int n = 0; n < 2; ++n) {
            float4* xp = (float4*)(p.out + (size_t)row * D + pn * BM + bj * HALF + wc * 32 + 16 * n + 4 * fq);
            float4 x = *xp; f32x4 a = acc[ai][bj][m][n];
            x.x = ALPHA * x.x + coef * a[0]; x.y = ALPHA * x.y + coef * a[1]; x.z = ALPHA * x.z + coef * a[2]; x.w = ALPHA * x.w + coef * a[3];
            *xp = x;
          }
      } else {
#pragma unroll
        for (int bj = 0; bj < 2; ++bj) {
          const int cb = pn * BM + bj * HALF + wc * 32, c = cb + 8 * fq;
          const bool head0 = (wc & 1) == 0;
          float v[8];
#pragma unroll
          for (int e = 0; e < 4; ++e) { v[e] = acc[ai][bj][m][0][e]; v[4 + e] = acc[ai][bj][m][1][e]; }
          if (mode == EPI_NSA_IN) {
            if (cb < 1024) {
#pragma unroll
              for (int e = 0; e < 8; ++e) v[e] *= 0.18033688011112042f;
              *(uint4*)((u16*)(ws + OFF_PROJ) + (size_t)row * D + c) = pack8(v);
              if (head0) rope8(v, fq, s, rt, fq * 16 + fr);
              *(uint4*)((u16*)(ws + OFF_QR) + (size_t)row * D + c) = pack8(v);
            } else if (cb < 1792) {
              const int seg = (cb - 1024) >> 7, g = ((cb - 1024) >> 6) & 1, d = c & 63;
              if (head0 && (seg == 2 || seg == 4)) rope8(v, fq, s, rt, fq * 16 + fr);
              *(uint4*)((u16*)(ws + OFF_SEG + (size_t)seg * SZ_SEG) + ((size_t)(b * 2 + g) * S + s) * 64 + d) = pack8(v);
            } else if (c < 1840) {
              float4* gp = (float4*)((float*)(ws + OFF_GATES) + (size_t)row * 48 + (c - 1792));
              gp[0] = make_float4(v[0], v[1], v[2], v[3]); gp[1] = make_float4(v[4], v[5], v[6], v[7]);
            }
          } else if (mode == EPI_DIFF_Q) {
#pragma unroll
            for (int e = 0; e < 8; ++e) v[e] *= 0.18033688011112042f;
            if (head0) rope8(v, fq, s, rt, fq * 16 + fr);
            *(uint4*)((u16*)(ws + OFF_PROJ) + (size_t)row * D + c) = pack8(v);
          } else {
            if (cb < 1024) {
              const int which = cb >> 9, hd = (cb >> 6) & 7, d = c & 63;
              if (head0) rope8(v, fq, s, rt, fq * 16 + fr);
              *(uint4*)((u16*)(ws + OFF_KD) + ((size_t)((b * 2 + which) * 8 + hd) * S + s) * 64 + d) = pack8(v);
            } else {
              const int e0 = c - 1024, hd = e0 >> 7, dv = e0 & 127;
              *(uint4*)((u16*)(ws + OFF_VD) + ((size_t)(b * 8 + hd) * S + s) * 128 + dv) = pack8(v);
            }
          }
        }
      }
    }
}


DI void fused_ln_epi(const Params& p, char* smem, float coef, f32x4 (&acc)[2][2][4][2], int pm, int pn, int wr, int wc, int fr, int fq,
                     int tid, int lnk, const float* g, const float* bt) {
  const int lane = fq * 16 + fr;
  char* ws = launder_ptr(p.ws); float* xout = (float*)launder_ptr((char*)p.out);
  u16* xb = (u16*)(ws + OFF_XB);
  u16* xlo = (u16*)xout;
  float2* P = (float2*)smem;
  float2* Sx = P + 1024;
  u64* slots = (u64*)(ws + OFF_SLOTS);
  unsigned* cnt = (unsigned*)(ws + OFF_CNT);
  int rl0 = wr * 64 + fr;
  asm volatile("" : "+v"(rl0));
  const int coff = pn * BM + wc * 32 + 8 * fq;
#pragma unroll
  for (int ai = 0; ai < 2; ++ai) {
    uint4 hreg[4][2], lreg[4][2];
#pragma unroll
    for (int m = 0; m < 4; ++m) {
      const size_t roff = (size_t)(pm * BM + rl0 + ai * HALF + m * 16);
#pragma unroll
      for (int bj = 0; bj < 2; ++bj) {
        hreg[m][bj] = *(const uint4*)(xb + roff * D + coff + bj * HALF);
        lreg[m][bj] = *(const uint4*)(xlo + roff * 2048 + 1024 + coff + bj * HALF);
      }
    }
#pragma unroll
    for (int m = 0; m < 4; ++m) {
      int rl = rl0 + ai * HALF + m * 16;
      asm volatile("" : "+v"(rl));
      float s = 0.f, q = 0.f;
#pragma unroll
      for (int bj = 0; bj < 2; ++bj) {
        const uint4 h8 = hreg[m][bj], l8 = lreg[m][bj];
        const unsigned hw[4] = {h8.x, h8.y, h8.z, h8.w}, lw[4] = {l8.x, l8.y, l8.z, l8.w};
#pragma unroll
        for (int n = 0; n < 2; ++n) {
          float4 x;
          x.x = __uint_as_float((hw[2 * n] << 16) + (unsigned)(int)(short)(lw[2 * n] & 0xffffu));
          x.y = __uint_as_float((hw[2 * n] & 0xffff0000u) + (unsigned)((int)lw[2 * n] >> 16));
          x.z = __uint_as_float((hw[2 * n + 1] << 16) + (unsigned)(int)(short)(lw[2 * n + 1] & 0xffffu));
          x.w = __uint_as_float((hw[2 * n + 1] & 0xffff0000u) + (unsigned)((int)lw[2 * n + 1] >> 16));
          f32x4 a = acc[ai][bj][m][n];
          a[0] = ALPHA * x.x + coef * a[0]; a[1] = ALPHA * x.y + coef * a[1]; a[2] = ALPHA * x.z + coef * a[2]; a[3] = ALPHA * x.w + coef * a[3];
          acc[ai][bj][m][n] = a;
          s += (a[0] + a[1]) + (a[2] + a[3]);
          q += (a[0] * a[0] + a[1] * a[1]) + (a[2] * a[2] + a[3] * a[3]);
        }
      }
      s += shx(s, 16, lane); q += shx(q, 16, lane);
      s += shx(s, 32, lane); q += shx(q, 32, lane);
      if (fq == 0) P[rl * 4 + wc] = make_float2(s, q);
    }
  }
  float4 gq[2][2], bq2[2][2];
#pragma unroll
  for (int bj = 0; bj < 2; ++bj) {
    const int c = pn * BM + bj * HALF + wc * 32 + 8 * fq;
    gq[bj][0] = *(const float4*)(g + c); gq[bj][1] = *(const float4*)(g + c + 4);
    bq2[bj][0] = *(const float4*)(bt + c); bq2[bj][1] = *(const float4*)(bt + c + 4);
  }
  __syncthreads();
  if (tid < 256) {
    const float2 a0 = P[tid * 4], a1 = P[tid * 4 + 1], a2 = P[tid * 4 + 2], a3 = P[tid * 4 + 3];
    const float s = (a0.x + a1.x) + (a2.x + a3.x), q = (a0.y + a1.y) + (a2.y + a3.y);
    const u64 bits = ((u64)__float_as_uint(q) << 32) | (u64)__float_as_uint(s);
    __hip_atomic_store(slots + ((size_t)(pm * 4 + pn) * 256 + tid), bits, __ATOMIC_RELAXED, __HIP_MEMORY_SCOPE_AGENT);
  }
  asm volatile("s_waitcnt vmcnt(0)" ::: "memory");
  __syncthreads();
  if (tid == 0) {
    unsigned* c = cnt + pm * 64;
    (void)__hip_atomic_fetch_add(c, 1u, __ATOMIC_RELAXED, __HIP_MEMORY_SCOPE_AGENT);
    const unsigned need = 4u * (unsigned)(lnk + 1);
    unsigned sp = 0;
    while (__hip_atomic_load(c, __ATOMIC_RELAXED, __HIP_MEMORY_SCOPE_AGENT) < need) {
      __builtin_amdgcn_s_sleep(1);
      if (++sp > (1u << 24)) break;
    }
  }
  __syncthreads();
  if (tid < 256) {
    float s = 0.f, q = 0.f;
#pragma unroll
    for (int j = 0; j < 4; ++j) {
      const u64 bits = __hip_atomic_load(slots + ((size_t)(pm * 4 + j) * 256 + tid), __ATOMIC_RELAXED, __HIP_MEMORY_SCOPE_AGENT);
      s += __uint_as_float((unsigned)bits); q += __uint_as_float((unsigned)(bits >> 32));
    }
    const float mean = s * (1.f / D);
    const float var = fmaxf(q * (1.f / D) - mean * mean, 0.f);
    Sx[tid] = make_float2(mean, rsqrtf(var + 1e-5f));
  }
  __syncthreads();
#pragma unroll
  for (int bj = 0; bj < 2; ++bj) {
    const int c = pn * BM + bj * HALF + wc * 32 + 8 * fq;
    const float4 g0 = gq[bj][0], g1 = gq[bj][1];
    const float4 b0 = bq2[bj][0], b1 = bq2[bj][1];
#pragma unroll
    for (int ai = 0; ai < 2; ++ai)
#pragma unroll
      for (int m = 0; m < 4; ++m) {
        int rl = rl0 + ai * HALF + m * 16;
        asm volatile("" : "+v"(rl));
        const float2 ms = Sx[rl];
        const f32x4 a = acc[ai][bj][m][0], bq = acc[ai][bj][m][1];
        float v[8];
        v[0] = (a[0] - ms.x) * ms.y * g0.x + b0.x; v[1] = (a[1] - ms.x) * ms.y * g0.y + b0.y;
        v[2] = (a[2] - ms.x) * ms.y * g0.z + b0.z; v[3] = (a[3] - ms.x) * ms.y * g0.w + b0.w;
        v[4] = (bq[0] - ms.x) * ms.y * g1.x + b1.x; v[5] = (bq[1] - ms.x) * ms.y * g1.y + b1.y;
        v[6] = (bq[2] - ms.x) * ms.y * g1.z + b1.z; v[7] = (bq[3] - ms.x) * ms.y * g1.w + b1.w;
        const size_t roff = (size_t)(pm * BM + rl);
        if (lnk == 11) {
          float* xo = xout + roff * D + c;
          *(float4*)xo = make_float4(v[0], v[1], v[2], v[3]);
          *(float4*)(xo + 4) = make_float4(v[4], v[5], v[6], v[7]);
        } else {
          const uint4 h8 = pack8(v);
          *(uint4*)(xb + roff * D + c) = h8;
          uint4 l8;
          l8.x = ((__float_as_uint(v[0]) - (h8.x << 16)) & 0xffffu) | ((__float_as_uint(v[1]) - (h8.x & 0xffff0000u)) << 16);
          l8.y = ((__float_as_uint(v[2]) - (h8.y << 16)) & 0xffffu) | ((__float_as_uint(v[3]) - (h8.y & 0xffff0000u)) << 16);
          l8.z = ((__float_as_uint(v[4]) - (h8.z << 16)) & 0xffffu) | ((__float_as_uint(v[5]) - (h8.z & 0xffff0000u)) << 16);
          l8.w = ((__float_as_uint(v[6]) - (h8.w << 16)) & 0xffffu) | ((__float_as_uint(v[7]) - (h8.w & 0xffff0000u)) << 16);
          *(uint4*)(xlo + roff * 2048 + 1024 + c) = l8;
        }
      }
  }
  __syncthreads();
}

DI void gemm_phase(const Params& p, char* smem, const u16* Ag, const u16* Btg, int N, int K, int mode, float coef, int lnk, const float* lng, const float* lnb) {
  LAS unsigned char* lds = (LAS unsigned char*)smem;
  const int tid = get_tid(), wid = __builtin_amdgcn_readfirstlane(tid >> 6), lane = tid & 63, wr = wid >> 2, wc = wid & 3, fr = lane & 15, fq = lane >> 4;
  const int nt = K / BK, nM = M / BM, nN = N / BM;
  const bool perm = true;
  const bool single = (mode == EPI_RESID);
  unsigned voffA[2], voffB[2];
#pragma unroll
  for (int i = 0; i < 2; ++i) {
    int R, C; stage_rc(tid * 16 + i * 8192, R, C);
    const int Rb = perm ? ((R & ~31) + perm32(R & 31)) : R;
    voffA[i] = (unsigned)(R * K + C) * 2u; voffB[i] = (unsigned)(Rb * K + C) * 2u;
  }
  const size_t kstep = (size_t)(BK * 2);
  const size_t hstep = (size_t)HALF * K * 2;
  const size_t tstep = 2 * hstep;
  const unsigned ldsw = (unsigned)wid * 1024u;
  const int aoff = lds_byte(wr * 64 + fr, fq * 8), boff = lds_byte(wc * 32 + fr, fq * 8);
#define G_SA(b, h) (((b) * 2 + (h)) * HTB)
#define G_SB(b, h) ((4 + (b) * 2 + (h)) * HTB)
#define G_STAGE(bufoff, gbase, voff) do { _Pragma("unroll") for (int _i = 0; _i < 2; ++_i) \
    __builtin_amdgcn_global_load_lds((const unsigned*)((const char*)(gbase) + (voff)[_i]), (LAS unsigned*)(lds + (bufoff) + ldsw + _i * 8192), 16, 0, 0); } while (0)
#define G_LDA(dst, b, h) do { _Pragma("unroll") for (int m = 0; m < 4; ++m) _Pragma("unroll") for (int k = 0; k < 2; ++k) dst[m][k] = *(const LAS bf16x8*)(lds + G_SA(b, h) + aoff + m * 2048 + k * 1024); } while (0)
#define G_LDB(dst, b, h) do { _Pragma("unroll") for (int n = 0; n < 2; ++n) _Pragma("unroll") for (int k = 0; k < 2; ++k) dst[n][k] = *(const LAS bf16x8*)(lds + G_SB(b, h) + boff + n * 2048 + k * 1024); } while (0)
#define G_MMA(ai, bj, At, Bt) do { __builtin_amdgcn_s_setprio(1); _Pragma("unroll") for (int m = 0; m < 4; ++m) _Pragma("unroll") for (int n = 0; n < 2; ++n) _Pragma("unroll") for (int k = 0; k < 2; ++k) \
    acc[ai][bj][m][n] = __builtin_amdgcn_mfma_f32_16x16x32_bf16(Bt[n][k], At[m][k], acc[ai][bj][m][n], 0, 0, 0); __builtin_amdgcn_s_setprio(0); } while (0)
#define G_WAIT_V(n) asm volatile("s_waitcnt vmcnt(" #n ")" ::: "memory")
#define G_WAIT_L(n) asm volatile("s_waitcnt lgkmcnt(" #n ")" ::: "memory")
#define G_BAR __builtin_amdgcn_s_barrier()
#define G_SCHED __builtin_amdgcn_sched_barrier(0)
  int cpm, cpn, npm = 0, npn = 0, ui = 0;
  f32x4 acc[2][2][4][2];
  bf16x8 At[4][2], B0[2][2], B1[2][2];
  for (int ubase = 0;; ++ubase) {
  if (!unit_next(ubase, nM, nN, cpm, cpn)) break;
  ui = ubase;
#pragma unroll
  for (int a = 0; a < 2; ++a)
#pragma unroll
    for (int b = 0; b < 2; ++b)
#pragma unroll
      for (int m = 0; m < 4; ++m)
#pragma unroll
        for (int n = 0; n < 2; ++n) acc[a][b][m][n] = (f32x4){0.f, 0.f, 0.f, 0.f};
  const char* cA = (const char*)Ag + (size_t)cpm * tstep; const char* cB = (const char*)Btg + (size_t)cpn * tstep;
  G_STAGE(G_SB(0, 0), cB, voffB); G_STAGE(G_SA(0, 0), cA, voffA); G_STAGE(G_SB(0, 1), cB + hstep, voffB); G_STAGE(G_SA(0, 1), cA + hstep, voffA);
  if (wr == 1) G_BAR;
  G_WAIT_V(4); G_BAR;
  G_STAGE(G_SB(1, 0), cB + kstep, voffB); G_STAGE(G_SA(1, 0), cA + kstep, voffA); G_STAGE(G_SB(1, 1), cB + hstep + kstep, voffB);
  G_WAIT_V(6); G_BAR;
  for (;;) {
    const bool has_next = unit_next(ui + 1, nM, nN, npm, npn);
    const char* nA = has_next ? (const char*)Ag + (size_t)npm * tstep : cA; const char* nB = has_next ? (const char*)Btg + (size_t)npn * tstep : cB;
    for (int t = 0; t < nt; t += 2) {
      const bool last = (t == nt - 2);
      const char* a1 = cA + (size_t)(t + 1) * kstep;
      const char* a2 = last ? nA : cA + (size_t)(t + 2) * kstep; const char* b2 = last ? nB : cB + (size_t)(t + 2) * kstep;
      const char* a3 = a2 + kstep; const char* b3 = b2 + kstep;
      G_LDB(B0, 0, 0); G_SCHED; G_LDA(At, 0, 0); G_STAGE(G_SA(1, 1), a1 + hstep, voffA);
      G_WAIT_L(8); G_BAR; G_WAIT_L(0); G_MMA(0, 0, At, B0); G_BAR; G_SCHED;
      G_LDB(B1, 0, 1); G_STAGE(G_SB(0, 0), b2, voffB);
      G_BAR; G_WAIT_L(0); G_MMA(0, 1, At, B1); G_BAR;
      G_LDA(At, 0, 1); G_STAGE(G_SA(0, 0), a2, voffA);
      G_BAR; G_WAIT_L(0); G_MMA(1, 0, At, B0); G_BAR; G_SCHED;
      G_STAGE(G_SB(0, 1), b2 + hstep, voffB);
      G_WAIT_V(6); G_BAR; G_MMA(1, 1, At, B1); G_BAR;
      G_LDB(B0, 1, 0); G_SCHED; G_LDA(At, 1, 0); G_STAGE(G_SA(0, 1), a2 + hstep, voffA);
      G_WAIT_L(8); G_BAR; G_WAIT_L(0); G_MMA(0, 0, At, B0); G_BAR; G_SCHED;
      G_LDB(B1, 1, 1); G_STAGE(G_SB(1, 0), b3, voffB);
      G_BAR; G_WAIT_L(0); G_MMA(0, 1, At, B1); G_BAR;
      G_LDA(At, 1, 1); G_STAGE(G_SA(1, 0), a3, voffA);
      G_BAR; G_WAIT_L(0); G_MMA(1, 0, At, B0); G_BAR; G_SCHED;
      G_STAGE(G_SB(1, 1), b3 + hstep, voffB);
      G_WAIT_V(6); G_BAR; G_MMA(1, 1, At, B1); G_BAR;
    }
    if (!single) {
      gemm_epi(p, mode, coef, acc, cpm, cpn, wr, wc, fr, fq);
      if (!has_next) break;
    } else {
      if (!has_next) G_WAIT_V(0);
      if (wr == 0) G_BAR;
      if (!has_next) G_BAR;
      fused_ln_epi(p, smem + 131072, coef, acc, cpm, cpn, wr, wc, fr, fq, tid, lnk, lng, lnb);
      if (!has_next) break;
      if (wr == 1) G_BAR;
    }
#pragma unroll
    for (int a = 0; a < 2; ++a)
#pragma unroll
      for (int b = 0; b < 2; ++b)
#pragma unroll
        for (int m = 0; m < 4; ++m)
#pragma unroll
          for (int n = 0; n < 2; ++n) acc[a][b][m][n] = (f32x4){0.f, 0.f, 0.f, 0.f};
    cpm = npm; cpn = npn; cA = nA; cB = nB; ++ui;
  }
  if (!single) {
    G_WAIT_V(0);
    if (wr == 0) G_BAR;
    G_BAR;
  }
  break;
  }
#undef G_SA
#undef G_SB
#undef G_STAGE
#undef G_LDA
#undef G_LDB
#undef G_MMA
}

DI float gelu_tanh(float x) {
  float u = 0.7978845608028654f * (x + 0.044715f * x * x * x);
  return 0.5f * x * (1.f + tanhf(u));
}

DI void compress_phase(const Params& p, char* smem, int l) {
  const int tid = get_tid(), w = tid >> 6, lane = tid & 63, fr = lane & 15, fq = lane >> 4;
  float* hid = (float*)smem;
  char* ws = launder_ptr(p.ws);
  char* mb = layer_w(ws, l) + 2 * (SZ_WGU + SZ_WD);
  for (int item = blockIdx.x; item < 512; item += gridDim.x) {
    const int kv = item & 1, ct = (item >> 1) & 15, bg = item >> 5;
    const u16* src = (const u16*)(ws + OFF_SEG + (size_t)kv * SZ_SEG) + (size_t)bg * S * 64;
    const u16* w1t = (const u16*)(mb + 4194304 + 2097152 + (size_t)kv * 524288);
    const float* w2 = p.in[kv ? 17 : 13] + (size_t)l * 128 * 64;
    const float* b1p = (const float*)(ws + OFF_B1P) + (l * 2 + kv) * 128;
    const int c0 = ct * 16;
    int cr = c0 + fr; if (cr > 254) cr = 254;
    const u16* ap = src + (size_t)cr * 16 * 64 + fq * 8;
    const u16* bp = w1t + (size_t)(w * 16 + fr) * 2048 + fq * 8;
    f32x4 acc = {0.f, 0.f, 0.f, 0.f};
#pragma unroll 16
    for (int kk = 0; kk < 64; ++kk) {
      bf16x8 a = *(const bf16x8*)(ap + kk * 32);
      bf16x8 bb = *(const bf16x8*)(bp + kk * 32);
      acc = __builtin_amdgcn_mfma_f32_16x16x32_bf16(a, bb, acc, 0, 0, 0);
    }
    __syncthreads();
#pragma unroll
    for (int j = 0; j < 4; ++j) {
      int col = w * 16 + fr;
      hid[(fq * 4 + j) * 128 + col] = gelu_tanh(acc[j] + b1p[col]);
    }
    __syncthreads();
#pragma unroll
    for (int e = 0; e < 2; ++e) {
      int o = tid + e * 512, r = o >> 6, d = o & 63;
      float s = 0.f;
      for (int k = 0; k < 128; ++k) s += hid[r * 128 + k] * w2[k * 64 + d];
      int c = c0 + r;
      if (c < 255) {
        if (kv == 0) ((u16*)(ws + OFF_KCMP))[((size_t)bg * 256 + c) * 64 + d] = f2bf(s);
        else ((u16*)(ws + OFF_VCMPT))[((size_t)bg * 256 + c) * 64 + d] = f2bf(s);
      }
    }
  }
}

template <int KS>
DI f32x16 qk_tile(const u16* Ksub, const bf16x8* qf, int ql, int h, float init = 0.f) {
  f32x16 s;
#pragma unroll
  for (int i = 0; i < 16; ++i) s[i] = init;
#pragma unroll
  for (int ks = 0; ks < 4; ++ks) {
    bf16x8 a = *(const bf16x8*)(Ksub + ql * KS + ks * 16 + h * 8);
    s = mfma32(a, qf[ks], s);
  }
  return s;
}
template <int KS>
DI f32x16 qk_tile_lds(const u16* Ksub, const u16* Qsub, int ql, int h, float init) {
  f32x16 s;
#pragma unroll
  for (int i = 0; i < 16; ++i) s[i] = init;
#pragma unroll
  for (int ks = 0; ks < 4; ++ks) {
    bf16x8 a = *(const bf16x8*)(Ksub + ql * KS + ks * 16 + h * 8);
    bf16x8 b = *(const bf16x8*)(Qsub + ql * KS + ks * 16 + h * 8);
    s = mfma32(a, b, s);
  }
  return s;
}
DI s16x4 tr_read(const u16* ptr) { return __builtin_amdgcn_ds_read_tr16_b64_v4i16((LAS s16x4*)ptr); }
template <int NMB, int VS>
DI void pv_tile(const u16* vsub, const bf16x8* pf, f32x16* O, int lane) {
  const int l16 = lane & 15, q = l16 >> 2, pp = l16 & 3, blk = (lane >> 4) & 1, h = lane >> 5;
  const u16* base = vsub + (4 * h + q) * VS + 16 * blk + 4 * pp;
#pragma unroll
  for (int mb = 0; mb < NMB; ++mb)
#pragma unroll
    for (int s2 = 0; s2 < 2; ++s2) {
      s16x4 lo = tr_read(base + (16 * s2) * VS + mb * 32);
      s16x4 hi = tr_read(base + (16 * s2 + 8) * VS + mb * 32);
      bf16x8 a = __builtin_shufflevector(lo, hi, 0, 1, 2, 3, 4, 5, 6, 7);
      O[mb] = mfma32(a, pf[s2], O[mb]);
    }
}
template <int VS>
DI void pv_load(const u16* vsub, bf16x8* vf, int lane) {
  const int l16 = lane & 15, q = l16 >> 2, pp = l16 & 3, blk = (lane >> 4) & 1, h = lane >> 5;
  const u16* base = vsub + (4 * h + q) * VS + 16 * blk + 4 * pp;
#pragma unroll
  for (int mb = 0; mb < 2; ++mb)
#pragma unroll
    for (int s2 = 0; s2 < 2; ++s2) {
      s16x4 lo = tr_read(base + (16 * s2) * VS + mb * 32);
      s16x4 hi = tr_read(base + (16 * s2 + 8) * VS + mb * 32);
      vf[mb * 2 + s2] = __builtin_shufflevector(lo, hi, 0, 1, 2, 3, 4, 5, 6, 7);
    }
}
DI void pv_mma(const bf16x8* vf, const bf16x8* pf, f32x16* O) {
#pragma unroll
  for (int mb = 0; mb < 2; ++mb)
#pragma unroll
    for (int s2 = 0; s2 < 2; ++s2) O[mb] = mfma32(vf[mb * 2 + s2], pf[s2], O[mb]);
}
template <int KS>
DI void k_load8(const u16* Kt, bf16x8* kf, int ql, int h) {
#pragma unroll
  for (int sub = 0; sub < 2; ++sub)
#pragma unroll
    for (int ks = 0; ks < 4; ++ks) kf[sub * 4 + ks] = *(const bf16x8*)(Kt + (sub * 32 + ql) * KS + ks * 16 + h * 8);
}
DI f32x16 qk_mma(const bf16x8* kf, const bf16x8* qf, float init) {
  f32x16 s;
#pragma unroll
  for (int i = 0; i < 16; ++i) s[i] = init;
#pragma unroll
  for (int ks = 0; ks < 4; ++ks) s = mfma32(kf[ks], qf[ks], s);
  return s;
}
template <int VS>
DI void v_load8(const u16* Vt, bf16x8* vf, int lane) {
  const int l16 = lane & 15, q = l16 >> 2, pp = l16 & 3, blk = (lane >> 4) & 1, h = lane >> 5;
  const u16* base = Vt + (4 * h + q) * VS + 16 * blk + 4 * pp;
#pragma unroll
  for (int sub = 0; sub < 2; ++sub)
#pragma unroll
    for (int mb = 0; mb < 2; ++mb)
#pragma unroll
      for (int s2 = 0; s2 < 2; ++s2) {
        s16x4 lo = tr_read(base + (sub * 32 + 16 * s2) * VS + mb * 32);
        s16x4 hi = tr_read(base + (sub * 32 + 16 * s2 + 8) * VS + mb * 32);
        vf[sub * 4 + mb * 2 + s2] = __builtin_shufflevector(lo, hi, 0, 1, 2, 3, 4, 5, 6, 7);
      }
}
DI void pv_mma8(const bf16x8* vf, const bf16x8* pf, f32x16* O) {
#pragma unroll
  for (int sub = 0; sub < 2; ++sub)
#pragma unroll
    for (int mb = 0; mb < 2; ++mb)
#pragma unroll
      for (int s2 = 0; s2 < 2; ++s2) O[mb] = mfma32(vf[sub * 4 + mb * 2 + s2], pf[sub * 2 + s2], O[mb]);
}
constexpr float NINF = -__builtin_inff();
template <bool MASK>
DI bool softmax_step(f32x16& s, int kbase, int lo, int hi, float& m, float& l, float& alpha, bf16x8* pf, int lane) {
  if (MASK) {
#pragma unroll
    for (int i = 0; i < 16; ++i) {
      int kp = kbase + (i & 3) + 8 * (i >> 2);
      s[i] = ((kp > lo) && (kp <= hi)) ? s[i] : NINF;
    }
  }
  float mx = fmaxf(fmaxf(s[0], s[1]), s[2]);
#pragma unroll
  for (int i = 3; i < 15; i += 2) mx = fmaxf(fmaxf(mx, s[i]), s[i + 1]);
  mx = fmaxf(mx, s[15]);
  const bool need = __any(mx > 8.f);
  alpha = 1.f;
  if (need) {
    mx = fmaxf(mx, shx(mx, 32, lane));
    const float d = fmaxf(mx, 0.f);
    alpha = __builtin_amdgcn_exp2f(-d);
    l *= alpha;
    m += d;
#pragma unroll
    for (int i = 0; i < 16; ++i) s[i] -= d;
  }
  float rs = 0.f;
#pragma unroll
  for (int i = 0; i < 16; ++i) {
    float pv = __builtin_amdgcn_exp2f(s[i]);
    s[i] = pv; rs += pv;
  }
  l += rs;
#pragma unroll
  for (int s2 = 0; s2 < 2; ++s2) {
    unsigned u[4];
#pragma unroll
    for (int j = 0; j < 4; ++j) u[j] = pack2(s[8 * s2 + 2 * j], s[8 * s2 + 2 * j + 1]);
    pf[s2] = __builtin_bit_cast(bf16x8, *(uint4*)u);
  }
  return need;
}

template <bool MASK>
DI bool softmax_step64(f32x16& s0, f32x16& s1, int kbase, int lo, int hi, float& m, float& l, float& alpha, bf16x8* pf, int lane) {
  if (MASK) {
#pragma unroll
    for (int i = 0; i < 16; ++i) {
      int kp = kbase + (i & 3) + 8 * (i >> 2);
      s0[i] = ((kp > lo) && (kp <= hi)) ? s0[i] : NINF;
      s1[i] = ((kp + 32 > lo) && (kp + 32 <= hi)) ? s1[i] : NINF;
    }
  }
  float mx = fmaxf(s0[0], s1[0]);
#pragma unroll
  for (int i = 1; i < 16; ++i) mx = fmaxf(fmaxf(mx, s0[i]), s1[i]);
  const bool need = __any(mx > 8.f);
  alpha = 1.f;
  if (need) {
    mx = fmaxf(mx, shx(mx, 32, lane));
    const float d = fmaxf(mx, 0.f);
    alpha = __builtin_amdgcn_exp2f(-d);
    l *= alpha;
    m += d;
#pragma unroll
    for (int i = 0; i < 16; ++i) { s0[i] -= d; s1[i] -= d; }
  }
  float rs0 = 0.f, rs1 = 0.f;
#pragma unroll
  for (int i = 0; i < 16; ++i) {
    float p0 = __builtin_amdgcn_exp2f(s0[i]), p1 = __builtin_amdgcn_exp2f(s1[i]);
    s0[i] = p0; s1[i] = p1; rs0 += p0; rs1 += p1;
  }
  l += rs0 + rs1;
#pragma unroll
  for (int s2 = 0; s2 < 2; ++s2) {
    unsigned u[4], v[4];
#pragma unroll
    for (int j = 0; j < 4; ++j) { u[j] = pack2(s0[8 * s2 + 2 * j], s0[8 * s2 + 2 * j + 1]); v[j] = pack2(s1[8 * s2 + 2 * j], s1[8 * s2 + 2 * j + 1]); }
    pf[s2] = __builtin_bit_cast(bf16x8, *(uint4*)u);
    pf[2 + s2] = __builtin_bit_cast(bf16x8, *(uint4*)v);
  }
  return need;
}

constexpr int KST = 72, VST = 96, VDS = 160;

DI void nsa_load_q(const u16* qbase, long row, int hq, int h, bf16x8* qf) {
#pragma unroll
  for (int ks = 0; ks < 4; ++ks) qf[ks] = *(const bf16x8*)(qbase + row * D + hq * 64 + ks * 16 + h * 8);
}

DI void nsa_attn_phase(const Params& p, char* smem) {
  const int tid0 = get_tid();
  u16* Kb = (u16*)smem;
  u16* Vb = Kb + 2 * 64 * KST;
  u16* Kc = Vb + 2 * 64 * VST;
  u16* Vc = Kc + 256 * KST;
  unsigned* imp = (unsigned*)(Vc + 256 * VST);
  u64* sel = (u64*)(imp + 32 * 65);
  unsigned* uni = (unsigned*)(sel + 32);
  char* ws = launder_ptr(p.ws);
  const u16* KS_g = (const u16*)(ws + OFF_SEG + 2 * SZ_SEG);
  const u16* VS_g = (const u16*)(ws + OFF_SEG + 3 * SZ_SEG);
  const u16* KW_g = (const u16*)(ws + OFF_SEG + 4 * SZ_SEG);
  const u16* VW_g = (const u16*)(ws + OFF_SEG + 5 * SZ_SEG);
  const float* gates = (const float*)(ws + OFF_GATES);
  u16* Oout = (u16*)(ws + OFF_PROJ);

  for (int item = blockIdx.x; item < 2048; item += gridDim.x) {
    const int rnd = item >> 8, j256 = item & 255;
    int tid = tid0; asm volatile("" : "+v"(tid));
    const int w = tid >> 6, lane = tid & 63, ql = lane & 31, h = lane >> 5;
    const int bg = j256 & 15, k16 = j256 >> 4;
    const int tile = rnd * 16 + ((rnd & 1) ? 15 - k16 : k16);
    const int b = bg >> 1, g = bg & 1;
    const int t0 = tile * 32, t = t0 + ql, hq = g * 8 + w;
    const long row = (long)b * S + t;
    const int cur = t0 >> 6;

    __syncthreads();
    const int tidi = tid;
    const int ntc = (t0 >> 9) + 1, nc = ntc * 32;
    for (int i = tidi; i < 32 * 65; i += NTHR) imp[i] = 0;
    if (tidi < 2) uni[tidi] = 0;
    bf16x8 qf[4];
    nsa_load_q((const u16*)(ws + OFF_PROJ), row, hq, h, qf);
    const int lr = tid >> 3, lch = tid & 7;
    uint4 kreg, vreg;
    const float gr0 = gates[row * 48 + hq], gr1 = gates[row * 48 + 16 + hq], gr2 = gates[row * 48 + 32 + hq];
    const float g0 = __builtin_amdgcn_rcpf(1.f + __expf(-gr0)), g1 = __builtin_amdgcn_rcpf(1.f + __expf(-gr1)), g2 = __builtin_amdgcn_rcpf(1.f + __expf(-gr2));
    {
      const u16* kcg = (const u16*)(ws + OFF_KCMP) + (size_t)bg * 256 * 64;
      const u16* vcg = (const u16*)(ws + OFF_VCMPT) + (size_t)bg * 256 * 64;
      uint4 kc4[4], vc4[4];
#pragma unroll
      for (int j = 0; j < 4; ++j) {
        const int i = tidi + j * NTHR;
        kc4[j] = *(const uint4*)(kcg + (i >> 3) * 64 + (i & 7) * 8); vc4[j] = *(const uint4*)(vcg + (i >> 3) * 64 + (i & 7) * 8);
      }
#pragma unroll
      for (int j = 0; j < 4; ++j) {
        const int i = tidi + j * NTHR;
        if (i < nc * 8) { *(uint4*)(Kc + (i >> 3) * KST + (i & 7) * 8) = kc4[j]; *(uint4*)(Vc + (i >> 3) * VST + (i & 7) * 8) = vc4[j]; }
      }
    }
    __syncthreads();

    f32x16 O[2];
    unsigned outp[16];
    bf16x8 pf[4];
    const int cmaxq = (t >= 31) ? ((t - 31) >> 4) : -1;
    float m = NEGF, l = 0.f;
    for (int ct = 0; ct < ntc; ++ct) {
      f32x16 s = qk_tile<KST>(Kc + ct * 32 * KST, qf, ql, h);
      float mx = NEGF;
#pragma unroll
      for (int i = 0; i < 16; ++i) {
        int c = ct * 32 + 4 * h + (i & 3) + 8 * (i >> 2);
        s[i] = (c <= cmaxq) ? s[i] : NEGF;
        mx = fmaxf(mx, s[i]);
      }
      mx = fmaxf(mx, shx(mx, 32, lane));
      const float mn = fmaxf(m, mx);
      float rs = 0.f;
#pragma unroll
      for (int i = 0; i < 16; ++i) rs += (s[i] > -1e29f) ? __builtin_amdgcn_exp2f(s[i] - mn) : 0.f;
      rs += shx(rs, 32, lane);
      l = l * __builtin_amdgcn_exp2f(m - mn) + rs;
      m = mn;
    }
    const float invl = (l > 0.f) ? 1.f / l : 0.f;
#pragma unroll
    for (int mb = 0; mb < 2; ++mb)
#pragma unroll
      for (int i = 0; i < 16; ++i) O[mb][i] = 0.f;
    for (int ct = 0; ct < ntc; ++ct) {
      f32x16 s = qk_tile<KST>(Kc + ct * 32 * KST, qf, ql, h);
#pragma unroll
      for (int i = 0; i < 16; ++i) {
        int c = ct * 32 + 4 * h + (i & 3) + 8 * (i >> 2);
        s[i] = (c <= cmaxq) ? __builtin_amdgcn_exp2f(s[i] - m) * invl : 0.f;
      }
#pragma unroll
      for (int a = 0; a < 4; ++a) {
        int n = ct * 8 + 2 * a + h;
        float mainv = s[4 * a] + s[4 * a + 1] + s[4 * a + 2] + 0.5f * s[4 * a + 3];
        float carry = 0.5f * s[4 * a + 3];
        unsigned um = (unsigned)(mainv * 16777216.f + 0.5f), uc = (unsigned)(carry * 16777216.f + 0.5f);
        if (um) atomicAdd(&imp[ql * 65 + n], um);
        if (uc && n < 63) atomicAdd(&imp[ql * 65 + n + 1], uc);
      }
#pragma unroll
      for (int s2 = 0; s2 < 2; ++s2) {
        unsigned u[4];
#pragma unroll
        for (int j = 0; j < 4; ++j) u[j] = pack2(s[8 * s2 + 2 * j], s[8 * s2 + 2 * j + 1]);
        pf[s2] = __builtin_bit_cast(bf16x8, *(uint4*)u);
      }
      pv_tile<2, VST>(Vc + ct * 32 * VST, pf, O, lane);
    }
#pragma unroll
    for (int mb = 0; mb < 2; ++mb)
#pragma unroll
      for (int i = 0; i < 16; i += 2) outp[mb * 8 + (i >> 1)] = pack2(g0 * O[mb][i], g0 * O[mb][i + 1]);
    __syncthreads();
    for (int qq = 0; qq < 4; ++qq) {
      const int q = w * 4 + qq;
      unsigned v = imp[q * 65 + lane];
      const bool valid = lane <= cur;
      const bool forced = (lane == 0) || (lane == cur) || (lane == cur - 1);
      if (forced) v += (1u << 30);
      int rank = 0;
      for (int mth = 0; mth <= cur; ++mth) {
        unsigned vm = __builtin_amdgcn_readlane(v, mth);
        rank += (vm > v || (vm == v && mth < lane)) ? 1 : 0;
      }
      u64 msk = __ballot(valid && rank < 16);
      if (lane == 0) { sel[q] = msk; atomicOr(&uni[0], (unsigned)msk); atomicOr(&uni[1], (unsigned)(msk >> 32)); }
    }
    __syncthreads();
    const u64 selq = sel[ql];
    const u64 unim = ((u64)uni[1] << 32) | uni[0];
    nsa_load_q((const u16*)(ws + OFF_QR), row, hq, h, qf);

    for (int br = 1; br <= 2; ++br) {
      const u16* Kg = (br == 1 ? KS_g : KW_g) + (size_t)bg * S * 64;
      const u16* Vg = (br == 1 ? VS_g : VW_g) + (size_t)bg * S * 64;
      u64 tm;
      if (br == 1) tm = unim;
      else {
        int first = (t0 - 512) >> 6; if (first < 0) first = 0;
        tm = (~0ull >> (63 - cur)) & (~0ull << first);
      }
      m = 0.f; l = 0.f;
#pragma unroll
      for (int mb = 0; mb < 2; ++mb)
#pragma unroll
        for (int i = 0; i < 16; ++i) O[mb][i] = 0.f;
      int buf = 0;
      if (br == 1) {
        kreg = *(const uint4*)(Kg + (size_t)lr * 64 + lch * 8);
        vreg = *(const uint4*)(Vg + (size_t)lr * 64 + lch * 8);
      }
      *(uint4*)(Kb + lr * KST + lch * 8) = kreg;
      *(uint4*)(Vb + lr * VST + lch * 8) = vreg;
      __syncthreads();
      while (tm) {
        const int n = __builtin_ctzll(tm);
        tm &= tm - 1;
        const bool more = tm != 0;
        if (more) {
          int nn = __builtin_ctzll(tm);
          kreg = *(const uint4*)(Kg + (size_t)(nn * 64 + lr) * 64 + lch * 8);
          vreg = *(const uint4*)(Vg + (size_t)(nn * 64 + lr) * 64 + lch * 8);
        } else if (br == 1) {
          int wf = (t0 - 512) >> 6; if (wf < 0) wf = 0;
          kreg = *(const uint4*)(KW_g + (size_t)bg * S * 64 + (size_t)(wf * 64 + lr) * 64 + lch * 8);
          vreg = *(const uint4*)(VW_g + (size_t)bg * S * 64 + (size_t)(wf * 64 + lr) * 64 + lch * 8);
        }
        const u16* Kt = Kb + buf * 64 * KST;
        const u16* Vt = Vb + buf * 64 * VST;
        int lo, hi = t;
        const bool lsel = (selq >> n) & 1;
        lo = (br == 1) ? -1 : t - 512;
        {
          const int kp0 = n * 64;
          const float init = (br == 2 || lsel) ? -m : NINF;
          bf16x8 fr8[8];
          k_load8<KST>(Kt, fr8, ql, h);
          f32x16 s0 = qk_mma(fr8, qf, init);
          f32x16 s1 = qk_mma(fr8 + 4, qf, init);
          pv_load<VST>(Vt, fr8, lane);
          float alpha; bool need;
          const bool interior = (kp0 + 63 <= t0) && (br == 1 || kp0 > t0 + 31 - 512);
          if (!interior) need = softmax_step64<true>(s0, s1, kp0 + 4 * h, lo, hi, m, l, alpha, pf, lane);
          else need = softmax_step64<false>(s0, s1, 0, 0, 0, m, l, alpha, pf, lane);
          if (need) {
#pragma unroll
            for (int mb = 0; mb < 2; ++mb)
#pragma unroll
              for (int i = 0; i < 16; ++i) O[mb][i] *= alpha;
          }
          pv_mma(fr8, pf, O);
          pv_load<VST>(Vt + 32 * VST, fr8 + 4, lane);
          pv_mma(fr8 + 4, pf + 2, O);
        }
        if (more) {
          u16* Kn = Kb + (buf ^ 1) * 64 * KST; u16* Vn = Vb + (buf ^ 1) * 64 * VST;
          *(uint4*)(Kn + lr * KST + lch * 8) = kreg;
          *(uint4*)(Vn + lr * VST + lch * 8) = vreg;
        }
        __syncthreads();
        buf ^= 1;
      }
      l += shx(l, 32, lane);
      const float sc = (br == 1 ? g1 : g2) * ((l > 0.f) ? 1.f / l : 0.f);
#pragma unroll
      for (int mb = 0; mb < 2; ++mb)
#pragma unroll
        for (int i = 0; i < 16; i += 2) {
          const unsigned pk = outp[mb * 8 + (i >> 1)];
          const float a0 = sc * O[mb][i] + __uint_as_float(pk << 16), a1 = sc * O[mb][i + 1] + __uint_as_float(pk & 0xffff0000u);
          if (br == 1) outp[mb * 8 + (i >> 1)] = pack2(a0, a1);
          else { O[mb][i] = a0; O[mb][i + 1] = a1; }
        }
    }
#pragma unroll
    for (int mb = 0; mb < 2; ++mb)
#pragma unroll
      for (int a = 0; a < 4; ++a) {
        uint2 o; o.x = pack2(O[mb][4 * a], O[mb][4 * a + 1]); o.y = pack2(O[mb][4 * a + 2], O[mb][4 * a + 3]);
        *(uint2*)(Oout + row * D + hq * 64 + mb * 32 + 8 * a + 4 * h) = o;
      }
  }
}

DI void diff_attn_phase(const Params& p, char* smem, int j) {
  const int tid = get_tid(), w = tid >> 6, lane = tid & 63, ql = lane & 31, h = lane >> 5;
  char* ws = launder_ptr(p.ws);
  u16* K1b = (u16*)smem;
  u16* K2b = K1b + 2 * 64 * KST;
  u16* Vb = K2b + 2 * 64 * KST;
  u16* Qs = Vb + 2 * 64 * VDS + w * (2 * 32 * KST);
  const int layer = 2 + j;
  const float lambda_init = (layer == 2) ? 0.47071301834f : 0.55605820415f;
  float lam;
  {
    float a = p.in[21][j * 64 + lane] * p.in[22][j * 64 + lane];
    float c = p.in[23][j * 64 + lane] * p.in[24][j * 64 + lane];
#pragma unroll
    for (int o = 32; o > 0; o >>= 1) { a += shx(a, o, lane); c += shx(c, o, lane); }
    lam = expf(a) - expf(c) + lambda_init;
  }
  const u16* QD = (const u16*)(ws + OFF_PROJ);
  u16* Oout = (u16*)(ws + OFF_QR);
  const float* sg = p.in[25] + j * 128;

  for (int item = blockIdx.x; item < 1024; item += gridDim.x) {
    const int rnd = item >> 8, j256 = item & 255;
    const int bh = j256 & 63, kq = j256 >> 6;
    const int qb = (rnd == 0) ? kq : (rnd == 1) ? 15 - kq : (rnd == 2) ? 4 + kq : 11 - kq;
    const int b = bh >> 3, hd = bh & 7;
    const int t0 = qb * 256 + w * 32, t = t0 + ql;
    const long row = (long)b * S + t;
    const u16* K1g = (const u16*)(ws + OFF_KD) + ((size_t)((b * 2 + 0) * 8 + hd)) * S * 64;
    const u16* K2g = (const u16*)(ws + OFF_KD) + ((size_t)((b * 2 + 1) * 8 + hd)) * S * 64;
    const u16* Vg = (const u16*)(ws + OFF_VD) + ((size_t)(b * 8 + hd)) * S * 128;
#pragma unroll
    for (int ks = 0; ks < 4; ++ks) {
      bf16x8 qa = *(const bf16x8*)(QD + row * D + hd * 64 + ks * 16 + h * 8);
      bf16x8 qb2 = *(const bf16x8*)(QD + row * D + 512 + hd * 64 + ks * 16 + h * 8);
      *(bf16x8*)(Qs + ql * KST + ks * 16 + h * 8) = qa;
      *(bf16x8*)(Qs + 32 * KST + ql * KST + ks * 16 + h * 8) = qb2;
    }
    f32x16 O1[4], O2[4];
#pragma unroll
    for (int mb = 0; mb < 4; ++mb)
#pragma unroll
      for (int i = 0; i < 16; ++i) { O1[mb][i] = 0.f; O2[mb][i] = 0.f; }
    float m1 = 0.f, l1 = 0.f, m2 = 0.f, l2 = 0.f;
    const int ntile = (qb + 1) * 4;
    const int lr = tid >> 3, lch = tid & 7;
    uint4 k1r, k2r;
    __syncthreads();
    {
      k1r = *(const uint4*)(K1g + (size_t)lr * 64 + lch * 8);
      k2r = *(const uint4*)(K2g + (size_t)lr * 64 + lch * 8);
      *(uint4*)(K1b + lr * KST + lch * 8) = k1r;
      *(uint4*)(K2b + lr * KST + lch * 8) = k2r;
      k1r = *(const uint4*)(Vg + (size_t)lr * 128 + lch * 8);
      k2r = *(const uint4*)(Vg + (size_t)lr * 128 + 64 + lch * 8);
      *(uint4*)(Vb + lr * VDS + lch * 8) = k1r;
      *(uint4*)(Vb + lr * VDS + 64 + lch * 8) = k2r;
    }
    __syncthreads();
    int buf = 0;
    for (int n = 0; n < ntile; ++n) {
      const bool more = (n + 1 < ntile);
      if (more) {
        const int k0 = (n + 1) * 64;
        k1r = *(const uint4*)(K1g + (size_t)(k0 + lr) * 64 + lch * 8);
        k2r = *(const uint4*)(K2g + (size_t)(k0 + lr) * 64 + lch * 8);
      }
      const u16* K1t = K1b + buf * 64 * KST;
      const u16* K2t = K2b + buf * 64 * KST;
      const u16* Vt = Vb + buf * 64 * VDS;
#pragma unroll
      for (int sub = 0; sub < 2; ++sub) {
        if (sub == 1 && more) {
          const int nb = buf ^ 1, k0 = (n + 1) * 64;
          *(uint4*)(K1b + nb * 64 * KST + lr * KST + lch * 8) = k1r;
          *(uint4*)(K2b + nb * 64 * KST + lr * KST + lch * 8) = k2r;
          k1r = *(const uint4*)(Vg + (size_t)(k0 + lr) * 128 + lch * 8);
          k2r = *(const uint4*)(Vg + (size_t)(k0 + lr) * 128 + 64 + lch * 8);
        }
        const int kp0 = n * 64 + sub * 32;
        if (kp0 > t0 + 31) continue;
        bf16x8 pf1[2], pf2[2];
        {
          f32x16 sA = qk_tile_lds<KST>(K1t + sub * 32 * KST, Qs, ql, h, -m1);
          f32x16 sB = qk_tile_lds<KST>(K2t + sub * 32 * KST, Qs + 32 * KST, ql, h, -m2);
          float alpha1, alpha2; bool need1, need2;
          if (kp0 + 31 <= t0) {
            need1 = softmax_step<false>(sA, 0, 0, 0, m1, l1, alpha1, pf1, lane);
            need2 = softmax_step<false>(sB, 0, 0, 0, m2, l2, alpha2, pf2, lane);
          } else {
            need1 = softmax_step<true>(sA, kp0 + 4 * h, -1, t, m1, l1, alpha1, pf1, lane);
            need2 = softmax_step<true>(sB, kp0 + 4 * h, -1, t, m2, l2, alpha2, pf2, lane);
          }
          if (need1 || need2) {
#pragma unroll
            for (int mb = 0; mb < 4; ++mb)
#pragma unroll
              for (int i = 0; i < 16; ++i) { O1[mb][i] *= alpha1; O2[mb][i] *= alpha2; }
          }
        }
        {
          const int l16 = lane & 15, tq = l16 >> 2, tp = l16 & 3, blk = (lane >> 4) & 1;
          const u16* vbase = Vt + (sub * 32 + 4 * h + tq) * VDS + 16 * blk + 4 * tp;
#pragma unroll
          for (int mb = 0; mb < 4; ++mb)
#pragma unroll
            for (int s2 = 0; s2 < 2; ++s2) {
              s16x4 lo = tr_read(vbase + (16 * s2) * VDS + mb * 32);
              s16x4 hi = tr_read(vbase + (16 * s2 + 8) * VDS + mb * 32);
              bf16x8 a = __builtin_shufflevector(lo, hi, 0, 1, 2, 3, 4, 5, 6, 7);
              O1[mb] = mfma32(a, pf1[s2], O1[mb]);
              O2[mb] = mfma32(a, pf2[s2], O2[mb]);
            }
        }
      }
      if (more) {
        const int nb = buf ^ 1;
        *(uint4*)(Vb + nb * 64 * VDS + lr * VDS + lch * 8) = k1r;
        *(uint4*)(Vb + nb * 64 * VDS + lr * VDS + 64 + lch * 8) = k2r;
      }
      __syncthreads();
      buf ^= 1;
    }
    l1 += shx(l1, 32, lane); l2 += shx(l2, 32, lane);
    const float i1 = 1.f / l1, i2 = lam / l2;
    float ss = 0.f;
#pragma unroll
    for (int mb = 0; mb < 4; ++mb)
#pragma unroll
      for (int i = 0; i < 16; ++i) { float o = O1[mb][i] * i1 - O2[mb][i] * i2; O1[mb][i] = o; ss += o * o; }
    ss += shx(ss, 32, lane);
    const float rn = rsqrtf(ss * (1.f / 128.f) + 1e-5f) * (1.f - lambda_init);
#pragma unroll
    for (int mb = 0; mb < 4; ++mb)
#pragma unroll
      for (int a = 0; a < 4; ++a) {
        const int dv = mb * 32 + 8 * a + 4 * h;
        float4 gg = *(const float4*)(sg + dv);
        uint2 o;
        o.x = pack2(O1[mb][4 * a] * rn * gg.x, O1[mb][4 * a + 1] * rn * gg.y);
        o.y = pack2(O1[mb][4 * a + 2] * rn * gg.z, O1[mb][4 * a + 3] * rn * gg.w);
        *(uint2*)(Oout + row * D + hd * 128 + dv) = o;
      }
  }
}


#define XB_TMO      128
#define XB_XCNT(j)  (256  + 64 * (j))
#define XB_XSUB(j)  (1280 + 64 * (j))
#define XB_XGEN(j)  (2304 + 64 * (j))
#define XB_TOP      3328
#define XB_TOPGEN   3392
#define XCD_BAR_WORDS 3456
#define XB_SPIN_CAP (1u << 22)
DI unsigned xb_ld(unsigned* p) { return __hip_atomic_load(p, __ATOMIC_RELAXED, __HIP_MEMORY_SCOPE_AGENT); }
DI unsigned xb_add(unsigned* p, unsigned v) { return __hip_atomic_fetch_add(p, v, __ATOMIC_RELAXED, __HIP_MEMORY_SCOPE_AGENT); }
DI unsigned xb_xcc_id() { return (unsigned)__builtin_amdgcn_s_getreg((3 << 11) | 20) & 0xFu; }
#define XB_SPIN(cond, bar) do { unsigned _sp = 0; while (cond) { __builtin_amdgcn_s_sleep(1); \
    if ((++_sp & 255u) == 0u) { if (xb_ld(&(bar)[XB_TMO])) break; if (_sp > XB_SPIN_CAP) { atomicAdd(&(bar)[XB_TMO], 1u); break; } } } } while (0)
struct XcdBarrier { unsigned* bar; unsigned x; volatile LAS unsigned* st; };
DI XcdBarrier xcd_barrier_post(unsigned* bar, volatile LAS unsigned* st) {
  XcdBarrier b; b.bar = bar; b.x = xb_xcc_id(); b.st = st;
  if (get_tid() == 0) (void)xb_add(&bar[XB_XCNT(b.x)], 1u);
  return b;
}
DI void xcd_barrier_complete(unsigned* bar, unsigned x, unsigned& nloc, unsigned& nx) {
  const unsigned G = gridDim.x * gridDim.y * gridDim.z;
  unsigned sum, cnt, mine, sp = 0u;
  for (;;) {
    sum = 0u; cnt = 0u; mine = 0u;
#pragma unroll
    for (unsigned j = 0; j < 16; ++j) { const unsigned c = xb_ld(&bar[XB_XCNT(j)]); sum += c; cnt += (c > 0u) ? 1u : 0u; mine = (j == x) ? c : mine; }
    if (sum == G) break;
    __builtin_amdgcn_s_sleep(1);
    if ((++sp & 255u) == 0u) { if (xb_ld(&bar[XB_TMO])) break; if (sp > XB_SPIN_CAP) { atomicAdd(&bar[XB_TMO], 1u); break; } }
  }
  nloc = mine > 0u ? mine : 1u; nx = cnt > 0u ? cnt : 1u;
}
DI void xcd_barrier(const XcdBarrier& b) {
  asm volatile("s_waitcnt vmcnt(0)" ::: "memory");
  __syncthreads();
  if (get_tid() == 0) {
    unsigned* bar = b.bar;
    __builtin_amdgcn_s_waitcnt(0);
    unsigned nloc = b.st[0], nx = b.st[1];
    if (nloc == 0u) { xcd_barrier_complete(bar, b.x, nloc, nx); b.st[0] = nloc; b.st[1] = nx; }
    const unsigned old = xb_add(&bar[XB_XSUB(b.x)], 1u);
    const unsigned gen = old / nloc;
    if (old + 1u == (gen + 1u) * nloc) {
      __builtin_amdgcn_fence(__ATOMIC_RELEASE, "agent");
      asm volatile("s_waitcnt vmcnt(0)" ::: "memory");
      const unsigned og = xb_add(&bar[XB_TOP], 1u);
      const unsigned tg = og / nx;
      if (og + 1u == (tg + 1u) * nx) xb_add(&bar[XB_TOPGEN], 1u);
      else XB_SPIN(xb_ld(&bar[XB_TOPGEN]) == tg, bar);
      __builtin_amdgcn_fence(__ATOMIC_ACQUIRE, "agent");
      xb_add(&bar[XB_XGEN(b.x)], 1u);
      asm volatile("s_waitcnt vmcnt(0)" ::: "memory");
    } else {
      XB_SPIN(xb_ld(&bar[XB_XGEN(b.x)]) == gen, bar);
      __builtin_amdgcn_fence(__ATOMIC_ACQUIRE, "agent");
      asm volatile("s_waitcnt vmcnt(0)" ::: "memory");
    }
  }
  __syncthreads();
}

__global__ void __launch_bounds__(NTHR) mega(Params p, int ph_lo, int ph_hi, int coop) {
  extern __shared__ __attribute__((aligned(16))) char smem[];
  cg::grid_group grid = cg::this_grid();
  volatile LAS unsigned* xst = (volatile LAS unsigned*)(smem + SMEM_BYTES - 16);
  if (get_tid() == 0) { xst[0] = 0u; xst[1] = 0u; }
  __syncthreads();
  const XcdBarrier xb = xcd_barrier_post((unsigned*)(p.ws + OFF_BAR), xst);
  int ph = 0;
  if (ph_hi < 0) grid.sync();
  if (ph >= ph_lo && ph < ph_hi) { prep_phase(p, smem); if (coop && ph + 1 < ph_hi) xcd_barrier(xb); }
  ++ph;
  for (int l = 0; l < 4; ++l) {
    for (int st = 0; st < 12; ++st) {
      if (st == 4 && l >= 2) continue;
      if (st == 11 && l != 1) continue;
      if (st == 2 || st == 7 || st == 10) continue;
      if (ph >= ph_lo && ph < ph_hi) {
        char* wsl = launder_ptr(p.ws);
        char* wb = layer_w(wsl, l);
        char* mb = wb + 2 * (SZ_WGU + SZ_WD);
        const u16* XB = (const u16*)(wsl + OFF_XB);
        const u16* HB = (const u16*)(wsl + OFF_H);
        int kind = 0;
        const u16* A = XB; const u16* Bt = nullptr; int N = D, K = D, mode = EPI_RESID; float coef = 1.f; int lni = 0;
        switch (st) {
          case 0: Bt = (const u16*)wb; N = 2 * F; mode = EPI_GATEUP; break;
          case 1: A = HB; Bt = (const u16*)(wb + SZ_WGU); K = F; coef = 0.5f; lni = l * 3; break;
          case 2: kind = 1; lni = l * 3; break;
          case 3: Bt = (const u16*)mb; if (l < 2) { N = 2048; mode = EPI_NSA_IN; } else { mode = EPI_DIFF_Q; } break;
          case 4: kind = 2; break;
          case 5: kind = (l < 2) ? 3 : 4; break;
          case 6: A = (const u16*)(wsl + (l < 2 ? OFF_PROJ : OFF_QR)); Bt = (const u16*)(mb + (l < 2 ? 4194304 : 2097152)); lni = l * 3 + 1; break;
          case 7: kind = 1; lni = l * 3 + 1; break;
          case 8: Bt = (const u16*)(wb + SZ_WGU + SZ_WD); N = 2 * F; mode = EPI_GATEUP; break;
          case 9: A = HB; Bt = (const u16*)(wb + SZ_WGU + SZ_WD + SZ_WGU); K = F; coef = 0.5f; lni = l * 3 + 2; break;
          case 10: kind = 1; lni = l * 3 + 2; break;
          default: Bt = (const u16*)(wsl + OFF_WKV); N = 2048; mode = EPI_DIFF_KV; break;
        }
        if (kind == 0) gemm_phase(p, smem, A, Bt, N, K, mode, coef, lni, p.in[7] + (size_t)lni * D, p.in[8] + (size_t)lni * D);
        else if (kind == 2) compress_phase(p, smem, l);
        else if (kind == 3) nsa_attn_phase(p, smem);
        else diff_attn_phase(p, smem, l - 2);
        if (coop && ph + 1 < ph_hi) xcd_barrier(xb);
      }
      ++ph;
    }
  }
}

extern "C" void kernel_launch(void* const* d_in, const int* in_sizes, int n_in, void* d_out, int out_size, void* d_ws,
                              size_t ws_size, hipStream_t stream) {
  if (n_in < 27 || ws_size < WS_NEED) { fprintf(stderr, "bad args: n_in %d ws %zu need %zu\n", n_in, ws_size, (size_t)WS_NEED); return; }
  Params p{};
  for (int i = 0; i < 27; ++i) p.in[i] = (const float*)d_in[i];
  p.out = (float*)d_out;
  p.ws = (char*)d_ws;
  static int grid_blocks = 0;
  (void)hipFuncSetAttribute((const void*)mega, hipFuncAttributeMaxDynamicSharedMemorySize, SMEM_BYTES);
  if (!grid_blocks) {
    int dev = 0, cus = 0, per_cu = 0;
    (void)hipGetDevice(&dev);
    (void)hipDeviceGetAttribute(&cus, hipDeviceAttributeMultiprocessorCount, dev);
    (void)hipOccupancyMaxActiveBlocksPerMultiprocessor(&per_cu, mega, NTHR, SMEM_BYTES);
    if (per_cu < 1) per_cu = 1;
    grid_blocks = cus;
    if (grid_blocks % 8) grid_blocks -= grid_blocks % 8;
  }
  (void)hipMemsetAsync((char*)d_ws + OFF_BAR, 0, 16384 + 32768, stream);
  int lo = 0, hi = 1000, coop = 1;
  void* args[] = {&p, &lo, &hi, &coop};
  hipError_t e = hipLaunchCooperativeKernel((const void*)mega, dim3(grid_blocks), dim3(NTHR), args, SMEM_BYTES, stream);
  if (e != hipSuccess) fprintf(stderr, "cooperative launch failed: %s (grid %d)\n", hipGetErrorString(e), grid_blocks);
}
```

```cpp
#include <hip/hip_runtime.h>
#include <hip/hip_cooperative_groups.h>
#include <cstdio>
namespace cg = cooperative_groups;

#define DI __device__ __forceinline__
typedef unsigned short u16;
typedef unsigned long long u64;
using bf16x8 = __attribute__((ext_vector_type(8))) short;
using s16x4 = __attribute__((ext_vector_type(4))) short;
using f32x4 = __attribute__((ext_vector_type(4))) float;
using f32x16 = __attribute__((ext_vector_type(16))) float;
using f32x2 = __attribute__((ext_vector_type(2))) float;
using bf16v2 = __attribute__((ext_vector_type(2))) __bf16;

constexpr int NB = 8, S = 4096, M = NB * S, D = 1024, F = 2816;
constexpr int NTHR = 512;
constexpr int SMEM_BYTES = 155648;
constexpr float ALPHA = 1.681792830507429f;
constexpr float NEGF = -1e30f;

constexpr size_t OFF_XB = 0;
constexpr size_t OFF_H = 67108864;
constexpr size_t OFF_KV = OFF_H + 184549376;
constexpr size_t OFF_W = OFF_KV + 134217728;
constexpr size_t SZ_WGU = 11534336, SZ_WD = 5767168;
constexpr size_t LW_A = 41943040, LW_B = 38797312;
constexpr size_t OFF_WKV = OFF_W + 2 * LW_B;
constexpr size_t OFF_SEG = OFF_WKV + 4194304;
constexpr size_t SZ_SEG = 8388608;
constexpr size_t OFF_GATES = OFF_SEG + 6 * SZ_SEG;
constexpr size_t OFF_KCMP = OFF_GATES + 6291456;
constexpr size_t OFF_VCMPT = OFF_KCMP + 524288;
constexpr size_t OFF_ROPE = OFF_VCMPT + 524288;
constexpr size_t OFF_B1P = OFF_ROPE + 262144;
constexpr size_t OFF_BAR = OFF_B1P + 4096;
constexpr size_t OFF_CNT = OFF_BAR + 16384;
constexpr size_t OFF_SLOTS = OFF_CNT + 32768;
constexpr size_t WS_NEED = OFF_SLOTS + 1048576;
constexpr size_t OFF_PROJ = OFF_H;
constexpr size_t OFF_QR = OFF_H + 67108864;
constexpr size_t OFF_PARK = OFF_H + 134217728;
constexpr size_t OFF_KD = OFF_KV;
constexpr size_t OFF_VD = OFF_KV + 67108864;

struct Params {
  const float* in[27];
  float* out;
  char* ws;
};

struct Params;
typedef __attribute__((address_space(1))) char gchar_t;
DI char* launder_ptr(char* w) { gchar_t* g = (gchar_t*)w; asm volatile("" : "+s"(g)); return (char*)g; }
DI int get_tid() { int t = threadIdx.x; asm volatile("" : "+v"(t)); return t; }
DI float shx(float v, int mask, int lane) { return __int_as_float(__builtin_amdgcn_ds_bpermute((lane ^ mask) << 2, __float_as_int(v))); }
DI u16 f2bf(float x) { return __builtin_bit_cast(u16, (__bf16)x); }
DI unsigned pack2(float a, float b) {
  f32x2 v = {a, b};
  return __builtin_bit_cast(unsigned, __builtin_convertvector(v, bf16v2));
}
DI float bf2f(u16 v) { return __uint_as_float(((unsigned)v) << 16); }
DI f32x16 mfma32(bf16x8 a, bf16x8 b, f32x16 c) { return __builtin_amdgcn_mfma_f32_32x32x16_bf16(a, b, c, 0, 0, 0); }

DI char* layer_w(char* ws, int l) { return l < 2 ? ws + OFF_KV + (size_t)l * LW_A : ws + OFF_W + (size_t)(l - 2) * LW_B; }

struct Task { const float* src; u16* dst; int K, Nsrc, Ndst, mode; };
DI Task get_task(const Params& p, int task) {
  Task t; t.src = nullptr; t.dst = nullptr; t.K = 0; t.Nsrc = 0; t.Ndst = 0; t.mode = 0;
  if (task == 40) { t.src = p.in[19]; t.dst = (u16*)(p.ws + OFF_WKV); t.K = 1024; t.Nsrc = 2048; t.Ndst = 2048; return t; }
  int l = task / 10, k = task % 10;
  char* wb = layer_w(p.ws, l);
  if (k < 6) {
    int f2 = k / 3, kk = k % 3;
    const float* src = p.in[1 + f2 * 3 + kk];
    if (kk < 2) { t.src = src + (size_t)l * D * F; t.dst = (u16*)(wb + f2 * (SZ_WGU + SZ_WD)); t.K = D; t.Nsrc = F; t.Ndst = F; t.mode = 1 + kk; }
    else { t.src = src + (size_t)l * F * D; t.dst = (u16*)(wb + f2 * (SZ_WGU + SZ_WD) + SZ_WGU); t.K = F; t.Nsrc = D; t.Ndst = D; }
    return t;
  }
  char* mb = wb + 2 * (SZ_WGU + SZ_WD);
  if (l < 2) {
    if (k == 6) { t.src = p.in[9] + (size_t)l * D * 1840; t.dst = (u16*)mb; t.K = D; t.Nsrc = 1840; t.Ndst = 2048; }
    else if (k == 7) { t.src = p.in[18] + (size_t)l * D * D; t.dst = (u16*)(mb + 4194304); t.K = D; t.Nsrc = D; t.Ndst = D; }
    else if (k == 8) { t.src = p.in[11] + (size_t)l * 2048 * 128; t.dst = (u16*)(mb + 4194304 + 2097152); t.K = 2048; t.Nsrc = 128; t.Ndst = 128; }
    else { t.src = p.in[15] + (size_t)l * 2048 * 128; t.dst = (u16*)(mb + 4194304 + 2097152 + 524288); t.K = 2048; t.Nsrc = 128; t.Ndst = 128; }
  } else {
    int j = l - 2;
    if (k == 6) { t.src = p.in[20] + (size_t)j * D * D; t.dst = (u16*)mb; t.K = D; t.Nsrc = D; t.Ndst = D; }
    else if (k == 7) { t.src = p.in[26] + (size_t)j * D * D; t.dst = (u16*)(mb + 2097152); t.K = D; t.Nsrc = D; t.Ndst = D; }
  }
  return t;
}

DI void prep_phase(const Params& p, char* smem) {
  const int tid = get_tid();
  float* T = (float*)smem;
  {
    for (int gt = blockIdx.x; gt < 5056; gt += gridDim.x) {
      int task, tile;
      if (gt >= 4928) { task = 40; tile = gt - 4928; }
      else {
        int l, r;
        if (gt < 2560) { l = gt / 1280; r = gt - l * 1280; } else { l = 2 + (gt - 2560) / 1184; r = (gt - 2560) % 1184; }
        if (r < 1056) { task = l * 10 + r / 176; tile = r % 176; }
        else {
          r -= 1056;
          if (l < 2) { if (r < 128) { task = l * 10 + 6; tile = r; } else if (r < 192) { task = l * 10 + 7; tile = r - 128; } else if (r < 208) { task = l * 10 + 8; tile = r - 192; } else { task = l * 10 + 9; tile = r - 208; } }
          else { if (r < 64) { task = l * 10 + 6; tile = r; } else { task = l * 10 + 7; tile = r - 64; } }
        }
      }
      Task t = get_task(p, task);
      const int nkt = t.K / 256;
      const int k0 = (tile % nkt) * 256, n0 = (tile / nkt) * 64;
      __syncthreads();
      float4 v[8];
#pragma unroll
      for (int e = 0; e < 8; ++e) {
        int idx = tid + e * 512, kk = idx >> 4, n4 = (idx & 15) * 4;
        v[e] = (n0 + n4 < t.Nsrc) ? *(const float4*)(t.src + (size_t)(k0 + kk) * t.Nsrc + n0 + n4) : make_float4(0.f, 0.f, 0.f, 0.f);
      }
#pragma unroll
      for (int e = 0; e < 8; ++e) {
        int idx = tid + e * 512, kk = idx >> 4, n4 = (idx & 15) * 4;
        T[(n4 + 0) * 257 + kk] = v[e].x; T[(n4 + 1) * 257 + kk] = v[e].y; T[(n4 + 2) * 257 + kk] = v[e].z; T[(n4 + 3) * 257 + kk] = v[e].w;
      }
      __syncthreads();
      const int nn = tid >> 3;
      int n = n0 + nn;
      int drow = t.mode == 0 ? n : ((n >> 7) * 256 + (t.mode - 1) * 128 + (n & 127));
#pragma unroll
      for (int j = 0; j < 4; ++j) {
        const int kc = (tid & 7) * 8 + j * 64;
        const float* tp = T + nn * 257 + kc;
        uint4 o;
        o.x = pack2(tp[0], tp[1]); o.y = pack2(tp[2], tp[3]); o.z = pack2(tp[4], tp[5]); o.w = pack2(tp[6], tp[7]);
        *(uint4*)(t.dst + (size_t)drow * t.K + k0 + kc) = o;
      }
    }
  }
  {
    const float4* xs = (const float4*)p.in[0];
    uint4* xb = (uint4*)(p.ws + OFF_XB);
    u16* lo = (u16*)p.out;
    const size_t n8 = (size_t)M * D / 8;
    const size_t stride = (size_t)gridDim.x * NTHR;
    for (size_t i = (size_t)blockIdx.x * NTHR + tid; i < n8; i += 4 * stride) {
      float4 va[4], vb[4];
#pragma unroll
      for (int j = 0; j < 4; ++j) { va[j] = xs[2 * (i + j * stride)]; vb[j] = xs[2 * (i + j * stride) + 1]; }
#pragma unroll
      for (int j = 0; j < 4; ++j) {
        const size_t e = i + j * stride;
        uint4 o; o.x = pack2(va[j].x, va[j].y); o.y = pack2(va[j].z, va[j].w); o.z = pack2(vb[j].x, vb[j].y); o.w = pack2(vb[j].z, vb[j].w);
        xb[e] = o;
        uint4 lw;
        lw.x = ((__float_as_uint(va[j].x) - (o.x << 16)) & 0xffffu) | ((__float_as_uint(va[j].y) - (o.x & 0xffff0000u)) << 16);
        lw.y = ((__float_as_uint(va[j].z) - (o.y << 16)) & 0xffffu) | ((__float_as_uint(va[j].w) - (o.y & 0xffff0000u)) << 16);
        lw.z = ((__float_as_uint(vb[j].x) - (o.z << 16)) & 0xffffu) | ((__float_as_uint(vb[j].y) - (o.z & 0xffff0000u)) << 16);
        lw.w = ((__float_as_uint(vb[j].z) - (o.w << 16)) & 0xffffu) | ((__float_as_uint(vb[j].w) - (o.w & 0xffff0000u)) << 16);
        const size_t row = e >> 7, c8 = e & 127;
        *(uint4*)(lo + row * 2048 + 1024 + c8 * 8) = lw;
      }
    }
  }
  {
    float2* rt = (float2*)(p.ws + OFF_ROPE);
    for (int i = blockIdx.x * NTHR + tid; i < 4096 * 8; i += gridDim.x * NTHR) {
      int pos = i >> 3, k = i & 7;
      float inv = (float)pow(500000.0, -(double)k / 8.0);
      float ang = (float)pos * inv;
      rt[i] = make_float2((float)cos((double)ang), (float)sin((double)ang));
    }
  }
  if (blockIdx.x < 4 && tid < 128) {
    int l = blockIdx.x >> 1, kv = blockIdx.x & 1;
    const float* pos = p.in[kv ? 14 : 10] + (size_t)l * 2048;
    const float* w1 = p.in[kv ? 15 : 11] + (size_t)l * 2048 * 128;
    const float* b1 = p.in[kv ? 16 : 12] + (size_t)l * 128;
    float acc = b1[tid];
    for (int i = 0; i < 2048; ++i) acc += pos[i] * w1[(size_t)i * 128 + tid];
    ((float*)(p.ws + OFF_B1P))[(l * 2 + kv) * 128 + tid] = acc;
  }
}

#define LAS __attribute__((address_space(3)))
constexpr int BM = 256, BK = 64, HALF = 128, HTB = HALF * BK * 2;

DI int lds_byte(int r, int c) {
  const int st = (r >> 4) * 2 + (c >> 5), rr = r & 15, cc = c & 31, ob = rr * 64 + cc * 2;
  return st * 1024 + (ob ^ (((ob >> 9) & 1) << 5));
}
DI void stage_rc(int b, int& R, int& C) {
  const int st = b / 1024, sb = b % 1024, swz = sb ^ (((sb >> 9) & 1) << 5);
  R = (st >> 1) * 16 + swz / 64; C = (st & 1) * 32 + (swz % 64) / 2;
}
DI int perm32(int rho) { const int n = rho >> 4, i = rho & 15; return 8 * (i >> 2) + 4 * n + (i & 3); }

enum { EPI_GATEUP = 0, EPI_RESID = 1, EPI_NSA_IN = 2, EPI_DIFF_Q = 3, EPI_DIFF_KV = 4 };

DI bool unit_next(int i, int nM, int nN, int& pm, int& pn) {
  const int nwg = nM * nN;
  const long L = (long)i * gridDim.x + blockIdx.x;
  if (L >= nwg) return false;
  int wgid = (int)L;
  { const int q = nwg / 8, r = nwg % 8, xcd = wgid % 8, off = wgid / 8; wgid = (xcd < r ? xcd * (q + 1) : r * (q + 1) + (xcd - r) * q) + off; }
  const int nig = 8 * nN, gid = wgid / nig, fm = gid * 8, gsz = (nM - fm) < 8 ? (nM - fm) : 8;
  pm = fm + ((wgid % nig) % gsz); pn = (wgid % nig) / gsz;
  return true;
}

DI void rope8(float* v, int fq, int pos, const float* rt, int lane) {
  float o[8];
#pragma unroll
  for (int i = 0; i < 8; ++i) o[i] = shx(v[i], 16, lane);
  if (fq < 2) {
    const float4* r4 = (const float4*)(rt + pos * 16);
#pragma unroll
    for (int i = 0; i < 4; ++i) {
      float4 cs = r4[i];
      float a0 = v[2 * i], a1 = v[2 * i + 1];
      if (fq == 0) { v[2 * i] = a0 * cs.x - o[2 * i] * cs.y; v[2 * i + 1] = a1 * cs.z - o[2 * i + 1] * cs.w; }
      else { v[2 * i] = o[2 * i] * cs.y + a0 * cs.x; v[2 * i + 1] = o[2 * i + 1] * cs.w + a1 * cs.z; }
    }
  }
}
DI uint4 pack8(const float* v) {
  uint4 o; o.x = pack2(v[0], v[1]); o.y = pack2(v[2], v[3]); o.z = pack2(v[4], v[5]); o.w = pack2(v[6], v[7]);
  return o;
}

DI void gemm_epi(const Params& p, int mode, float coef, const f32x4 (&acc)[2][2][4][2], int pm, int pn, int wr, int wc, int fr, int fq) {
  char* ws = launder_ptr(p.ws);
  const float* rt = (const float*)(ws + OFF_ROPE);
#pragma unroll
  for (int ai = 0; ai < 2; ++ai)
#pragma unroll
    for (int m = 0; m < 4; ++m) {
      const int row = pm * BM + ai * HALF + wr * 64 + m * 16 + fr;
      const int b = row >> 12, s = row & 4095;
      if (mode == EPI_GATEUP) {
        float v[8];
#pragma unroll
        for (int n = 0; n < 2; ++n)
#pragma unroll
          for (int e = 0; e < 4; ++e) {
            float gv = acc[ai][0][m][n][e], uv = acc[ai][1][m][n][e];
            v[n * 4 + e] = gv * uv * __builtin_amdgcn_rcpf(1.f + __builtin_amdgcn_exp2f(-1.4426950408889634f * gv));
          }
        *(uint4*)((u16*)(ws + OFF_H) + (size_t)row * F + pn * 128 + wc * 32 + 8 * fq) = pack8(v);
      } else if (mode == EPI_RESID) {
#pragma unroll
        for (int bj = 0; bj < 2; ++bj)
#pragma unroll
          for (int n = 0; n < 2; ++n) {
            float4* xp = (float4*)(p.out + (size_t)row * D + pn * BM + bj * HALF + wc * 32 + 16 * n + 4 * fq);
            float4 x = *xp; f32x4 a = acc[ai][bj][m][n];
            x.x = ALPHA * x.x + coef * a[0]; x.y = ALPHA * x.y + coef * a[1]; x.z = ALPHA * x.z + coef * a[2]; x.w = ALPHA * x.w + coef * a[3];
            *xp = x;
          }
      } else {
#pragma unroll
        for (int bj = 0; bj < 2; ++bj) {
          const int cb = pn * BM + bj * HALF + wc * 32, c = cb + 8 * fq;
          const bool head0 = (wc & 1) == 0;
          float v[8];
#pragma unroll
          for (int e = 0; e < 4; ++e) { v[e] = acc[ai][bj][m][0][e]; v[4 + e] = acc[ai][bj][m][1][e]; }
          if (mode == EPI_NSA_IN) {
            if (cb < 1024) {
#pragma unroll
              for (int e = 0; e < 8; ++e) v[e] *= 0.18033688011112042f;
              *(uint4*)((u16*)(ws + OFF_PROJ) + (size_t)row * D + c) = pack8(v);
              if (head0) rope8(v, fq, s, rt, fq * 16 + fr);
              *(uint4*)((u16*)(ws + OFF_QR) + (size_t)row * D + c) = pack8(v);
            } else if (cb < 1792) {
              const int seg = (cb - 1024) >> 7, g = ((cb - 1024) >> 6) & 1, d = c & 63;
              if (head0 && (seg == 2 || seg == 4)) rope8(v, fq, s, rt, fq * 16 + fr);
              *(uint4*)((u16*)(ws + OFF_SEG + (size_t)seg * SZ_SEG) + ((size_t)(b * 2 + g) * S + s) * 64 + d) = pack8(v);
            } else if (c < 1840) {
              float4* gp = (float4*)((float*)(ws + OFF_GATES) + (size_t)row * 48 + (c - 1792));
              gp[0] = make_float4(v[0], v[1], v[2], v[3]); gp[1] = make_float4(v[4], v[5], v[6], v[7]);
            }
          } else if (mode == EPI_DIFF_Q) {
#pragma unroll
            for (int e = 0; e < 8; ++e) v[e] *= 0.18033688011112042f;
            if (head0) rope8(v, fq, s, rt, fq * 16 + fr);
            *(uint4*)((u16*)(ws + OFF_PROJ) + (size_t)row * D + c) = pack8(v);
          } else {
            if (cb < 1024) {
              const int which = cb >> 9, hd = (cb >> 6) & 7, d = c & 63;
              if (head0) rope8(v, fq, s, rt, fq * 16 + fr);
              *(uint4*)((u16*)(ws + OFF_KD) + ((size_t)((b * 2 + which) * 8 + hd) * S + s) * 64 + d) = pack8(v);
            } else {
              const int e0 = c - 1024, hd = e0 >> 7, dv = e0 & 127;
              *(uint4*)((u16*)(ws + OFF_VD) + ((size_t)(b * 8 + hd) * S + s) * 128 + dv) = pack8(v);
            }
          }
        }
      }
    }
}


DI void fused_ln_epi(const Params& p, char* smem, float coef, f32x4 (&acc)[2][2][4][2], int pm, int pn, int wr, int wc, int fr, int fq,
                     int tid, int lnk, const float* g, const float* bt) {
  const int lane = fq * 16 + fr;
  char* ws = launder_ptr(p.ws); float* xout = (float*)launder_ptr((char*)p.out);
  u16* xb = (u16*)(ws + OFF_XB);
  u16* xlo = (u16*)xout;
  float2* P = (float2*)smem;
  float2* Sx = P + 1024;
  u64* slots = (u64*)(ws + OFF_SLOTS);
  unsigned* cnt = (unsigned*)(ws + OFF_CNT);
  int rl0 = wr * 64 + fr;
  asm volatile("" : "+v"(rl0));
  const int coff = pn * BM + wc * 32 + 8 * fq;
#pragma unroll
  for (int ai = 0; ai < 2; ++ai) {
    uint4 hreg[4][2], lreg[4][2];
#pragma unroll
    for (int m = 0; m < 4; ++m) {
      const size_t roff = (size_t)(pm * BM + rl0 + ai * HALF + m * 16);
#pragma unroll
      for (int bj = 0; bj < 2; ++bj) {
        hreg[m][bj] = *(const uint4*)(xb + roff * D + coff + bj * HALF);
        lreg[m][bj] = *(const uint4*)(xlo + roff * 2048 + 1024 + coff + bj * HALF);
      }
    }
#pragma unroll
    for (int m = 0; m < 4; ++m) {
      int rl = rl0 + ai * HALF + m * 16;
      asm volatile("" : "+v"(rl));
      float s = 0.f, q = 0.f;
#pragma unroll
      for (int bj = 0; bj < 2; ++bj) {
        const uint4 h8 = hreg[m][bj], l8 = lreg[m][bj];
        const unsigned hw[4] = {h8.x, h8.y, h8.z, h8.w}, lw[4] = {l8.x, l8.y, l8.z, l8.w};
#pragma unroll
        for (int n = 0; n < 2; ++n) {
          float4 x;
          x.x = __uint_as_float((hw[2 * n] << 16) + (unsigned)(int)(short)(lw[2 * n] & 0xffffu));
          x.y = __uint_as_float((hw[2 * n] & 0xffff0000u) + (unsigned)((int)lw[2 * n] >> 16));
          x.z = __uint_as_float((hw[2 * n + 1] << 16) + (unsigned)(int)(short)(lw[2 * n + 1] & 0xffffu));
          x.w = __uint_as_float((hw[2 * n + 1] & 0xffff0000u) + (unsigned)((int)lw[2 * n + 1] >> 16));
          f32x4 a = acc[ai][bj][m][n];
          a[0] = ALPHA * x.x + coef * a[0]; a[1] = ALPHA * x.y + coef * a[1]; a[2] = ALPHA * x.z + coef * a[2]; a[3] = ALPHA * x.w + coef * a[3];
          acc[ai][bj][m][n] = a;
          s += (a[0] + a[1]) + (a[2] + a[3]);
          q += (a[0] * a[0] + a[1] * a[1]) + (a[2] * a[2] + a[3] * a[3]);
        }
      }
      s += shx(s, 16, lane); q += shx(q, 16, lane);
      s += shx(s, 32, lane); q += shx(q, 32, lane);
      if (fq == 0) P[rl * 4 + wc] = make_float2(s, q);
    }
  }
  float4 gq[2][2], bq2[2][2];
#pragma unroll
  for (int bj = 0; bj < 2; ++bj) {
    const int c = pn * BM + bj * HALF + wc * 32 + 8 * fq;
    gq[bj][0] = *(const float4*)(g + c); gq[bj][1] = *(const float4*)(g + c + 4);
    bq2[bj][0] = *(const float4*)(bt + c); bq2[bj][1] = *(const float4*)(bt + c + 4);
  }
  __syncthreads();
  if (tid < 256) {
    const float2 a0 = P[tid * 4], a1 = P[tid * 4 + 1], a2 = P[tid * 4 + 2], a3 = P[tid * 4 + 3];
    const float s = (a0.x + a1.x) + (a2.x + a3.x), q = (a0.y + a1.y) + (a2.y + a3.y);
    const u64 bits = ((u64)__float_as_uint(q) << 32) | (u64)__float_as_uint(s);
    __hip_atomic_store(slots + ((size_t)(pm * 4 + pn) * 256 + tid), bits, __ATOMIC_RELAXED, __HIP_MEMORY_SCOPE_AGENT);
  }
  asm volatile("s_waitcnt vmcnt(0)" ::: "memory");
  __syncthreads();
  if (tid == 0) {
    unsigned* c = cnt + pm * 64;
    (void)__hip_atomic_fetch_add(c, 1u, __ATOMIC_RELAXED, __HIP_MEMORY_SCOPE_AGENT);
    const unsigned need = 4u * (unsigned)(lnk + 1);
    unsigned sp = 0;
    while (__hip_atomic_load(c, __ATOMIC_RELAXED, __HIP_MEMORY_SCOPE_AGENT) < need) {
      __builtin_amdgcn_s_sleep(1);
      if (++sp > (1u << 24)) break;
    }
  }
  __syncthreads();
  if (tid < 256) {
    float s = 0.f, q = 0.f;
#pragma unroll
    for (int j = 0; j < 4; ++j) {
      const u64 bits = __hip_atomic_load(slots + ((size_t)(pm * 4 + j) * 256 + tid), __ATOMIC_RELAXED, __HIP_MEMORY_SCOPE_AGENT);
      s += __uint_as_float((unsigned)bits); q += __uint_as_float((unsigned)(bits >> 32));
    }
    const float mean = s * (1.f / D);
    const float var = fmaxf(q * (1.f / D) - mean * mean, 0.f);
    Sx[tid] = make_float2(mean, rsqrtf(var + 1e-5f));
  }
  __syncthreads();
#pragma unroll
  for (int bj = 0; bj < 2; ++bj) {
    const int c = pn * BM + bj * HALF + wc * 32 + 8 * fq;
    const float4 g0 = gq[bj][0], g1 = gq[bj][1];
    const float4 b0 = bq2[bj][0], b1 = bq2[bj][1];
#pragma unroll
    for (int ai = 0; ai < 2; ++ai)
#pragma unroll
      for (int m = 0; m < 4; ++m) {
        int rl = rl0 + ai * HALF + m * 16;
        asm volatile("" : "+v"(rl));
        const float2 ms = Sx[rl];
        const f32x4 a = acc[ai][bj][m][0], bq = acc[ai][bj][m][1];
        float v[8];
        v[0] = (a[0] - ms.x) * ms.y * g0.x + b0.x; v[1] = (a[1] - ms.x) * ms.y * g0.y + b0.y;
        v[2] = (a[2] - ms.x) * ms.y * g0.z + b0.z; v[3] = (a[3] - ms.x) * ms.y * g0.w + b0.w;
        v[4] = (bq[0] - ms.x) * ms.y * g1.x + b1.x; v[5] = (bq[1] - ms.x) * ms.y * g1.y + b1.y;
        v[6] = (bq[2] - ms.x) * ms.y * g1.z + b1.z; v[7] = (bq[3] - ms.x) * ms.y * g1.w + b1.w;
        const size_t roff = (size_t)(pm * BM + rl);
        if (lnk == 11) {
          float* xo = xout + roff * D + c;
          *(float4*)xo = make_float4(v[0], v[1], v[2], v[3]);
          *(float4*)(xo + 4) = make_float4(v[4], v[5], v[6], v[7]);
        } else {
          const uint4 h8 = pack8(v);
          *(uint4*)(xb + roff * D + c) = h8;
          uint4 l8;
          l8.x = ((__float_as_uint(v[0]) - (h8.x << 16)) & 0xffffu) | ((__float_as_uint(v[1]) - (h8.x & 0xffff0000u)) << 16);
          l8.y = ((__float_as_uint(v[2]) - (h8.y << 16)) & 0xffffu) | ((__float_as_uint(v[3]) - (h8.y & 0xffff0000u)) << 16);
          l8.z = ((__float_as_uint(v[4]) - (h8.z << 16)) & 0xffffu) | ((__float_as_uint(v[5]) - (h8.z & 0xffff0000u)) << 16);
          l8.w = ((__float_as_uint(v[6]) - (h8.w << 16)) & 0xffffu) | ((__float_as_uint(v[7]) - (h8.w & 0xffff0000u)) << 16);
          *(uint4*)(xlo + roff * 2048 + 1024 + c) = l8;
        }
      }
  }
  __syncthreads();
}

DI void gemm_phase(const Params& p, char* smem, const u16* Ag, const u16* Btg, int N, int K, int mode, float coef, int lnk, const float* lng, const float* lnb) {
  LAS unsigned char* lds = (LAS unsigned char*)smem;
  const int tid = get_tid(), wid = __builtin_amdgcn_readfirstlane(tid >> 6), lane = tid & 63, wr = wid >> 2, wc = wid & 3, fr = lane & 15, fq = lane >> 4;
  const int nt = K / BK, nM = M / BM, nN = N / BM;
  const bool perm = true;
  const bool single = (mode == EPI_RESID);
  unsigned voffA[2], voffB[2];
#pragma unroll
  for (int i = 0; i < 2; ++i) {
    int R, C; stage_rc(tid * 16 + i * 8192, R, C);
    const int Rb = perm ? ((R & ~31) + perm32(R & 31)) : R;
    voffA[i] = (unsigned)(R * K + C) * 2u; voffB[i] = (unsigned)(Rb * K + C) * 2u;
  }
  const size_t kstep = (size_t)(BK * 2);
  const size_t hstep = (size_t)HALF * K * 2;
  const size_t tstep = 2 * hstep;
  const unsigned ldsw = (unsigned)wid * 1024u;
  const int aoff = lds_byte(wr * 64 + fr, fq * 8), boff = lds_byte(wc * 32 + fr, fq * 8);
#define G_SA(b, h) (((b) * 2 + (h)) * HTB)
#define G_SB(b, h) ((4 + (b) * 2 + (h)) * HTB)
#define G_STAGE(bufoff, gbase, voff) do { _Pragma("unroll") for (int _i = 0; _i < 2; ++_i) \
    __builtin_amdgcn_global_load_lds((const unsigned*)((const char*)(gbase) + (voff)[_i]), (LAS unsigned*)(lds + (bufoff) + ldsw + _i * 8192), 16, 0, 0); } while (0)
#define G_LDA(dst, b, h) do { _Pragma("unroll") for (int m = 0; m < 4; ++m) _Pragma("unroll") for (int k = 0; k < 2; ++k) dst[m][k] = *(const LAS bf16x8*)(lds + G_SA(b, h) + aoff + m * 2048 + k * 1024); } while (0)
#define G_LDB(dst, b, h) do { _Pragma("unroll") for (int n = 0; n < 2; ++n) _Pragma("unroll") for (int k = 0; k < 2; ++k) dst[n][k] = *(const LAS bf16x8*)(lds + G_SB(b, h) + boff + n * 2048 + k * 1024); } while (0)
#define G_MMA(ai, bj, At, Bt) do { __builtin_amdgcn_s_setprio(1); _Pragma("unroll") for (int m = 0; m < 4; ++m) _Pragma("unroll") for (int n = 0; n < 2; ++n) _Pragma("unroll") for (int k = 0; k < 2; ++k) \
    acc[ai][bj][m][n] = __builtin_amdgcn_mfma_f32_16x16x32_bf16(Bt[n][k], At[m][k], acc[ai][bj][m][n], 0, 0, 0); __builtin_amdgcn_s_setprio(0); } while (0)
#define G_WAIT_V(n) asm volatile("s_waitcnt vmcnt(" #n ")" ::: "memory")
#define G_WAIT_L(n) asm volatile("s_waitcnt lgkmcnt(" #n ")" ::: "memory")
#define G_BAR __builtin_amdgcn_s_barrier()
#define G_SCHED __builtin_amdgcn_sched_barrier(0)
  int cpm, cpn, npm = 0, npn = 0, ui = 0;
  f32x4 acc[2][2][4][2];
  bf16x8 At[4][2], B0[2][2], B1[2][2];
  for (int ubase = 0;; ++ubase) {
  if (!unit_next(ubase, nM, nN, cpm, cpn)) break;
  ui = ubase;
#pragma unroll
  for (int a = 0; a < 2; ++a)
#pragma unroll
    for (int b = 0; b < 2; ++b)
#pragma unroll
      for (int m = 0; m < 4; ++m)
#pragma unroll
        for (int n = 0; n < 2; ++n) acc[a][b][m][n] = (f32x4){0.f, 0.f, 0.f, 0.f};
  const char* cA = (const char*)Ag + (size_t)cpm * tstep; const char* cB = (const char*)Btg + (size_t)cpn * tstep;
  G_STAGE(G_SB(0, 0), cB, voffB); G_STAGE(G_SA(0, 0), cA, voffA); G_STAGE(G_SB(0, 1), cB + hstep, voffB); G_STAGE(G_SA(0, 1), cA + hstep, voffA);
  if (wr == 1) G_BAR;
  G_WAIT_V(4); G_BAR;
  G_STAGE(G_SB(1, 0), cB + kstep, voffB); G_STAGE(G_SA(1, 0), cA + kstep, voffA); G_STAGE(G_SB(1, 1), cB + hstep + kstep, voffB);
  G_WAIT_V(6); G_BAR;
  for (;;) {
    const bool has_next = unit_next(ui + 1, nM, nN, npm, npn);
    const char* nA = has_next ? (const char*)Ag + (size_t)npm * tstep : cA; const char* nB = has_next ? (const char*)Btg + (size_t)npn * tstep : cB;
    for (int t = 0; t < nt; t += 2) {
      const bool last = (t == nt - 2);
      const char* a1 = cA + (size_t)(t + 1) * kstep;
      const char* a2 = last ? nA : cA + (size_t)(t + 2) * kstep; const char* b2 = last ? nB : cB + (size_t)(t + 2) * kstep;
      const char* a3 = a2 + kstep; const char* b3 = b2 + kstep;
      G_LDB(B0, 0, 0); G_SCHED; G_LDA(At, 0, 0); G_STAGE(G_SA(1, 1), a1 + hstep, voffA);
      G_WAIT_L(8); G_BAR; G_WAIT_L(0); G_MMA(0, 0, At, B0); G_BAR; G_SCHED;
      G_LDB(B1, 0, 1); G_STAGE(G_SB(0, 0), b2, voffB);
      G_BAR; G_WAIT_L(0); G_MMA(0, 1, At, B1); G_BAR;
      G_LDA(At, 0, 1); G_STAGE(G_SA(0, 0), a2, voffA);
      G_BAR; G_WAIT_L(0); G_MMA(1, 0, At, B0); G_BAR; G_SCHED;
      G_STAGE(G_SB(0, 1), b2 + hstep, voffB);
      G_WAIT_V(6); G_BAR; G_MMA(1, 1, At, B1); G_BAR;
      G_LDB(B0, 1, 0); G_SCHED; G_LDA(At, 1, 0); G_STAGE(G_SA(0, 1), a2 + hstep, voffA);
      G_WAIT_L(8); G_BAR; G_WAIT_L(0); G_MMA(0, 0, At, B0); G_BAR; G_SCHED;
      G_LDB(B1, 1, 1); G_STAGE(G_SB(1, 0), b3, voffB);
      G_BAR; G_WAIT_L(0); G_MMA(0, 1, At, B1); G_BAR;
      G_LDA(At, 1, 1); G_STAGE(G_SA(1, 0), a3, voffA);
      G_BAR; G_WAIT_L(0); G_MMA(1, 0, At, B0); G_BAR; G_SCHED;
      G_STAGE(G_SB(1, 1), b3 + hstep, voffB);
      G_WAIT_V(6); G_BAR; G_MMA(1, 1, At, B1); G_BAR;
    }
    if (!single) {
      gemm_epi(p, mode, coef, acc, cpm, cpn, wr, wc, fr, fq);
      if (!has_next) break;
    } else {
      if (!has_next) G_WAIT_V(0);
      if (wr == 0) G_BAR;
      if (!has_next) G_BAR;
      fused_ln_epi(p, smem + 131072, coef, acc, cpm, cpn, wr, wc, fr, fq, tid, lnk, lng, lnb);
      if (!has_next) break;
      if (wr == 1) G_BAR;
    }
#pragma unroll
    for (int a = 0; a < 2; ++a)
#pragma unroll
      for (int b = 0; b < 2; ++b)
#pragma unroll
        for (int m = 0; m < 4; ++m)
#pragma unroll
          for (int n = 0; n < 2; ++n) acc[a][b][m][n] = (f32x4){0.f, 0.f, 0.f, 0.f};
    cpm = npm; cpn = npn; cA = nA; cB = nB; ++ui;
  }
  if (!single) {
    G_WAIT_V(0);
    if (wr == 0) G_BAR;
    G_BAR;
  }
  break;
  }
#undef G_SA
#undef G_SB
#undef G_STAGE
#undef G_LDA
#undef G_LDB
#undef G_MMA
}

DI float gelu_tanh(float x) {
  float u = 0.7978845608028654f * (x + 0.044715f * x * x * x);
  return 0.5f * x * (1.f + tanhf(u));
}

DI void compress_phase(const Params& p, char* smem, int l) {
  const int tid = get_tid(), w = tid >> 6, lane = tid & 63, fr = lane & 15, fq = lane >> 4;
  float* hid = (float*)smem;
  char* ws = launder_ptr(p.ws);
  char* mb = layer_w(ws, l) + 2 * (SZ_WGU + SZ_WD);
  for (int item = blockIdx.x; item < 512; item += gridDim.x) {
    const int kv = item & 1, ct = (item >> 1) & 15, bg = item >> 5;
    const u16* src = (const u16*)(ws + OFF_SEG + (size_t)kv * SZ_SEG) + (size_t)bg * S * 64;
    const u16* w1t = (const u16*)(mb + 4194304 + 2097152 + (size_t)kv * 524288);
    const float* w2 = p.in[kv ? 17 : 13] + (size_t)l * 128 * 64;
    const float* b1p = (const float*)(ws + OFF_B1P) + (l * 2 + kv) * 128;
    const int c0 = ct * 16;
    int cr = c0 + fr; if (cr > 254) cr = 254;
    const u16* ap = src + (size_t)cr * 16 * 64 + fq * 8;
    const u16* bp = w1t + (size_t)(w * 16 + fr) * 2048 + fq * 8;
    f32x4 acc = {0.f, 0.f, 0.f, 0.f};
#pragma unroll 16
    for (int kk = 0; kk < 64; ++kk) {
      bf16x8 a = *(const bf16x8*)(ap + kk * 32);
      bf16x8 bb = *(const bf16x8*)(bp + kk * 32);
      acc = __builtin_amdgcn_mfma_f32_16x16x32_bf16(a, bb, acc, 0, 0, 0);
    }
    __syncthreads();
#pragma unroll
    for (int j = 0; j < 4; ++j) {
      int col = w * 16 + fr;
      hid[(fq * 4 + j) * 128 + col] = gelu_tanh(acc[j] + b1p[col]);
    }
    __syncthreads();
#pragma unroll
    for (int e = 0; e < 2; ++e) {
      int o = tid + e * 512, r = o >> 6, d = o & 63;
      float s = 0.f;
      for (int k = 0; k < 128; ++k) s += hid[r * 128 + k] * w2[k * 64 + d];
      int c = c0 + r;
      if (c < 255) {
        if (kv == 0) ((u16*)(ws + OFF_KCMP))[((size_t)bg * 256 + c) * 64 + d] = f2bf(s);
        else ((u16*)(ws + OFF_VCMPT))[((size_t)bg * 256 + c) * 64 + d] = f2bf(s);
      }
    }
  }
}

template <int KS>
DI f32x16 qk_tile(const u16* Ksub, const bf16x8* qf, int ql, int h, float init = 0.f) {
  f32x16 s;
#pragma unroll
  for (int i = 0; i < 16; ++i) s[i] = init;
#pragma unroll
  for (int ks = 0; ks < 4; ++ks) {
    bf16x8 a = *(const bf16x8*)(Ksub + ql * KS + ks * 16 + h * 8);
    s = mfma32(a, qf[ks], s);
  }
  return s;
}
template <int KS>
DI f32x16 qk_tile_lds(const u16* Ksub, const u16* Qsub, int ql, int h, float init) {
  f32x16 s;
#pragma unroll
  for (int i = 0; i < 16; ++i) s[i] = init;
#pragma unroll
  for (int ks = 0; ks < 4; ++ks) {
    bf16x8 a = *(const bf16x8*)(Ksub + ql * KS + ks * 16 + h * 8);
    bf16x8 b = *(const bf16x8*)(Qsub + ql * KS + ks * 16 + h * 8);
    s = mfma32(a, b, s);
  }
  return s;
}
DI s16x4 tr_read(const u16* ptr) { return __builtin_amdgcn_ds_read_tr16_b64_v4i16((LAS s16x4*)ptr); }
template <int NMB, int VS>
DI void pv_tile(const u16* vsub, const bf16x8* pf, f32x16* O, int lane) {
  const int l16 = lane & 15, q = l16 >> 2, pp = l16 & 3, blk = (lane >> 4) & 1, h = lane >> 5;
  const u16* base = vsub + (4 * h + q) * VS + 16 * blk + 4 * pp;
#pragma unroll
  for (int mb = 0; mb < NMB; ++mb)
#pragma unroll
    for (int s2 = 0; s2 < 2; ++s2) {
      s16x4 lo = tr_read(base + (16 * s2) * VS + mb * 32);
      s16x4 hi = tr_read(base + (16 * s2 + 8) * VS + mb * 32);
      bf16x8 a = __builtin_shufflevector(lo, hi, 0, 1, 2, 3, 4, 5, 6, 7);
      O[mb] = mfma32(a, pf[s2], O[mb]);
    }
}
template <int VS>
DI void pv_load(const u16* vsub, bf16x8* vf, int lane) {
  const int l16 = lane & 15, q = l16 >> 2, pp = l16 & 3, blk = (lane >> 4) & 1, h = lane >> 5;
  const u16* base = vsub + (4 * h + q) * VS + 16 * blk + 4 * pp;
#pragma unroll
  for (int mb = 0; mb < 2; ++mb)
#pragma unroll
    for (int s2 = 0; s2 < 2; ++s2) {
      s16x4 lo = tr_read(base + (16 * s2) * VS + mb * 32);
      s16x4 hi = tr_read(base + (16 * s2 + 8) * VS + mb * 32);
      vf[mb * 2 + s2] = __builtin_shufflevector(lo, hi, 0, 1, 2, 3, 4, 5, 6, 7);
    }
}
DI void pv_mma(const bf16x8* vf, const bf16x8* pf, f32x16* O) {
#pragma unroll
  for (int mb = 0; mb < 2; ++mb)
#pragma unroll
    for (int s2 = 0; s2 < 2; ++s2) O[mb] = mfma32(vf[mb * 2 + s2], pf[s2], O[mb]);
}
template <int KS>
DI void k_load8(const u16* Kt, bf16x8* kf, int ql, int h) {
#pragma unroll
  for (int sub = 0; sub < 2; ++sub)
#pragma unroll
    for (int ks = 0; ks < 4; ++ks) kf[sub * 4 + ks] = *(const bf16x8*)(Kt + (sub * 32 + ql) * KS + ks * 16 + h * 8);
}
DI f32x16 qk_mma(const bf16x8* kf, const bf16x8* qf, float init) {
  f32x16 s;
#pragma unroll
  for (int i = 0; i < 16; ++i) s[i] = init;
#pragma unroll
  for (int ks = 0; ks < 4; ++ks) s = mfma32(kf[ks], qf[ks], s);
  return s;
}
template <int VS>
DI void v_load8(const u16* Vt, bf16x8* vf, int lane) {
  const int l16 = lane & 15, q = l16 >> 2, pp = l16 & 3, blk = (lane >> 4) & 1, h = lane >> 5;
  const u16* base = Vt + (4 * h + q) * VS + 16 * blk + 4 * pp;
#pragma unroll
  for (int sub = 0; sub < 2; ++sub)
#pragma unroll
    for (int mb = 0; mb < 2; ++mb)
#pragma unroll
      for (int s2 = 0; s2 < 2; ++s2) {
        s16x4 lo = tr_read(base + (sub * 32 + 16 * s2) * VS + mb * 32);
        s16x4 hi = tr_read(base + (sub * 32 + 16 * s2 + 8) * VS + mb * 32);
        vf[sub * 4 + mb * 2 + s2] = __builtin_shufflevector(lo, hi, 0, 1, 2, 3, 4, 5, 6, 7);
      }
}
DI void pv_mma8(const bf16x8* vf, const bf16x8* pf, f32x16* O) {
#pragma unroll
  for (int sub = 0; sub < 2; ++sub)
#pragma unroll
    for (int mb = 0; mb < 2; ++mb)
#pragma unroll
      for (int s2 = 0; s2 < 2; ++s2) O[mb] = mfma32(vf[sub * 4 + mb * 2 + s2], pf[sub * 2 + s2], O[mb]);
}
constexpr float NINF = -__builtin_inff();
template <bool MASK>
DI bool softmax_step(f32x16& s, int kbase, int lo, int hi, float& m, float& l, float& alpha, bf16x8* pf, int lane) {
  if (MASK) {
#pragma unroll
    for (int i = 0; i < 16; ++i) {
      int kp = kbase + (i & 3) + 8 * (i >> 2);
      s[i] = ((kp > lo) && (kp <= hi)) ? s[i] : NINF;
    }
  }
  float mx = fmaxf(fmaxf(s[0], s[1]), s[2]);
#pragma unroll
  for (int i = 3; i < 15; i += 2) mx = fmaxf(fmaxf(mx, s[i]), s[i + 1]);
  mx = fmaxf(mx, s[15]);
  const bool need = __any(mx > 8.f);
  alpha = 1.f;
  if (need) {
    mx = fmaxf(mx, shx(mx, 32, lane));
    const float d = fmaxf(mx, 0.f);
    alpha = __builtin_amdgcn_exp2f(-d);
    l *= alpha;
    m += d;
#pragma unroll
    for (int i = 0; i < 16; ++i) s[i] -= d;
  }
  float rs = 0.f;
#pragma unroll
  for (int i = 0; i < 16; ++i) {
    float pv = __builtin_amdgcn_exp2f(s[i]);
    s[i] = pv; rs += pv;
  }
  l += rs;
#pragma unroll
  for (int s2 = 0; s2 < 2; ++s2) {
    unsigned u[4];
#pragma unroll
    for (int j = 0; j < 4; ++j) u[j] = pack2(s[8 * s2 + 2 * j], s[8 * s2 + 2 * j + 1]);
    pf[s2] = __builtin_bit_cast(bf16x8, *(uint4*)u);
  }
  return need;
}

template <bool MASK>
DI bool softmax_step64(f32x16& s0, f32x16& s1, int kbase, int lo, int hi, float& m, float& l, float& alpha, bf16x8* pf, int lane) {
  if (MASK) {
#pragma unroll
    for (int i = 0; i < 16; ++i) {
      int kp = kbase + (i & 3) + 8 * (i >> 2);
      s0[i] = ((kp > lo) && (kp <= hi)) ? s0[i] : NINF;
      s1[i] = ((kp + 32 > lo) && (kp + 32 <= hi)) ? s1[i] : NINF;
    }
  }
  float mx = fmaxf(s0[0], s1[0]);
#pragma unroll
  for (int i = 1; i < 16; ++i) mx = fmaxf(fmaxf(mx, s0[i]), s1[i]);
  const bool need = __any(mx > 8.f);
  alpha = 1.f;
  if (need) {
    mx = fmaxf(mx, shx(mx, 32, lane));
    const float d = fmaxf(mx, 0.f);
    alpha = __builtin_amdgcn_exp2f(-d);
    l *= alpha;
    m += d;
#pragma unroll
    for (int i = 0; i < 16; ++i) { s0[i] -= d; s1[i] -= d; }
  }
  float rs0 = 0.f, rs1 = 0.f;
#pragma unroll
  for (int i = 0; i < 16; ++i) {
    float p0 = __builtin_amdgcn_exp2f(s0[i]), p1 = __builtin_amdgcn_exp2f(s1[i]);
    s0[i] = p0; s1[i] = p1; rs0 += p0; rs1 += p1;
  }
  l += rs0 + rs1;
#pragma unroll
  for (int s2 = 0; s2 < 2; ++s2) {
    unsigned u[4], v[4];
#pragma unroll
    for (int j = 0; j < 4; ++j) { u[j] = pack2(s0[8 * s2 + 2 * j], s0[8 * s2 + 2 * j + 1]); v[j] = pack2(s1[8 * s2 + 2 * j], s1[8 * s2 + 2 * j + 1]); }
    pf[s2] = __builtin_bit_cast(bf16x8, *(uint4*)u);
    pf[2 + s2] = __builtin_bit_cast(bf16x8, *(uint4*)v);
  }
  return need;
}

constexpr int KST = 72, VST = 96, VDS = 160;

DI void nsa_load_q(const u16* qbase, long row, int hq, int h, bf16x8* qf) {
#pragma unroll
  for (int ks = 0; ks < 4; ++ks) qf[ks] = *(const bf16x8*)(qbase + row * D + hq * 64 + ks * 16 + h * 8);
}

DI void nsa_attn_phase(const Params& p, char* smem) {
  const int tid0 = get_tid();
  u16* Kb = (u16*)smem;
  u16* Vb = Kb + 2 * 64 * KST;
  u16* Kc = Vb + 2 * 64 * VST;
  u16* Vc = Kc + 256 * KST;
  unsigned* imp = (unsigned*)(Vc + 256 * VST);
  u64* sel = (u64*)(imp + 32 * 65);
  unsigned* uni = (unsigned*)(sel + 32);
  char* ws = launder_ptr(p.ws);
  const u16* KS_g = (const u16*)(ws + OFF_SEG + 2 * SZ_SEG);
  const u16* VS_g = (const u16*)(ws + OFF_SEG + 3 * SZ_SEG);
  const u16* KW_g = (const u16*)(ws + OFF_SEG + 4 * SZ_SEG);
  const u16* VW_g = (const u16*)(ws + OFF_SEG + 5 * SZ_SEG);
  const float* gates = (const float*)(ws + OFF_GATES);
  u16* Oout = (u16*)(ws + OFF_PROJ);

  for (int item = blockIdx.x; item < 2048; item += gridDim.x) {
    const int rnd = item >> 8, j256 = item & 255;
    int tid = tid0; asm volatile("" : "+v"(tid));
    const int w = tid >> 6, lane = tid & 63, ql = lane & 31, h = lane >> 5;
    const int bg = j256 & 15, k16 = j256 >> 4;
    const int tile = rnd * 16 + ((rnd & 1) ? 15 - k16 : k16);
    const int b = bg >> 1, g = bg & 1;
    const int t0 = tile * 32, t = t0 + ql, hq = g * 8 + w;
    const long row = (long)b * S + t;
    const int cur = t0 >> 6;

    __syncthreads();
    const int tidi = tid;
    const int ntc = (t0 >> 9) + 1, nc = ntc * 32;
    for (int i = tidi; i < 32 * 65; i += NTHR) imp[i] = 0;
    if (tidi < 2) uni[tidi] = 0;
    bf16x8 qf[4];
    nsa_load_q((const u16*)(ws + OFF_PROJ), row, hq, h, qf);
    const int lr = tid >> 3, lch = tid & 7;
    uint4 kreg, vreg;
    const float gr0 = gates[row * 48 + hq], gr1 = gates[row * 48 + 16 + hq], gr2 = gates[row * 48 + 32 + hq];
    const float g0 = __builtin_amdgcn_rcpf(1.f + __expf(-gr0)), g1 = __builtin_amdgcn_rcpf(1.f + __expf(-gr1)), g2 = __builtin_amdgcn_rcpf(1.f + __expf(-gr2));
    {
      const u16* kcg = (const u16*)(ws + OFF_KCMP) + (size_t)bg * 256 * 64;
      const u16* vcg = (const u16*)(ws + OFF_VCMPT) + (size_t)bg * 256 * 64;
      uint4 kc4[4], vc4[4];
#pragma unroll
      for (int j = 0; j < 4; ++j) {
        const int i = tidi + j * NTHR;
        kc4[j] = *(const uint4*)(kcg + (i >> 3) * 64 + (i & 7) * 8); vc4[j] = *(const uint4*)(vcg + (i >> 3) * 64 + (i & 7) * 8);
      }
#pragma unroll
      for (int j = 0; j < 4; ++j) {
        const int i = tidi + j * NTHR;
        if (i < nc * 8) { *(uint4*)(Kc + (i >> 3) * KST + (i & 7) * 8) = kc4[j]; *(uint4*)(Vc + (i >> 3) * VST + (i & 7) * 8) = vc4[j]; }
      }
    }
    __syncthreads();

    f32x16 O[2];
    unsigned outp[16];
    bf16x8 pf[4];
    const int cmaxq = (t >= 31) ? ((t - 31) >> 4) : -1;
    float m = NEGF, l = 0.f;
    for (int ct = 0; ct < ntc; ++ct) {
      f32x16 s = qk_tile<KST>(Kc + ct * 32 * KST, qf, ql, h);
      float mx = NEGF;
#pragma unroll
      for (int i = 0; i < 16; ++i) {
        int c = ct * 32 + 4 * h + (i & 3) + 8 * (i >> 2);
        s[i] = (c <= cmaxq) ? s[i] : NEGF;
        mx = fmaxf(mx, s[i]);
      }
      mx = fmaxf(mx, shx(mx, 32, lane));
      const float mn = fmaxf(m, mx);
      float rs = 0.f;
#pragma unroll
      for (int i = 0; i < 16; ++i) rs += (s[i] > -1e29f) ? __builtin_amdgcn_exp2f(s[i] - mn) : 0.f;
      rs += shx(rs, 32, lane);
      l = l * __builtin_amdgcn_exp2f(m - mn) + rs;
      m = mn;
    }
    const float invl = (l > 0.f) ? 1.f / l : 0.f;
#pragma unroll
    for (int mb = 0; mb < 2; ++mb)
#pragma unroll
      for (int i = 0; i < 16; ++i) O[mb][i] = 0.f;
    for (int ct = 0; ct < ntc; ++ct) {
      f32x16 s = qk_tile<KST>(Kc + ct * 32 * KST, qf, ql, h);
#pragma unroll
      for (int i = 0; i < 16; ++i) {
        int c = ct * 32 + 4 * h + (i & 3) + 8 * (i >> 2);
        s[i] = (c <= cmaxq) ? __builtin_amdgcn_exp2f(s[i] - m) * invl : 0.f;
      }
#pragma unroll
      for (int a = 0; a < 4; ++a) {
        int n = ct * 8 + 2 * a + h;
        float mainv = s[4 * a] + s[4 * a + 1] + s[4 * a + 2] + 0.5f * s[4 * a + 3];
        float carry = 0.5f * s[4 * a + 3];
        unsigned um = (unsigned)(mainv * 16777216.f + 0.5f), uc = (unsigned)(carry * 16777216.f + 0.5f);
        if (um) atomicAdd(&imp[ql * 65 + n], um);
        if (uc && n < 63) atomicAdd(&imp[ql * 65 + n + 1], uc);
      }
#pragma unroll
      for (int s2 = 0; s2 < 2; ++s2) {
        unsigned u[4];
#pragma unroll
        for (int j = 0; j < 4; ++j) u[j] = pack2(s[8 * s2 + 2 * j], s[8 * s2 + 2 * j + 1]);
        pf[s2] = __builtin_bit_cast(bf16x8, *(uint4*)u);
      }
      pv_tile<2, VST>(Vc + ct * 32 * VST, pf, O, lane);
    }
#pragma unroll
    for (int mb = 0; mb < 2; ++mb)
#pragma unroll
      for (int i = 0; i < 16; i += 2) outp[mb * 8 + (i >> 1)] = pack2(g0 * O[mb][i], g0 * O[mb][i + 1]);
    __syncthreads();
    for (int qq = 0; qq < 4; ++qq) {
      const int q = w * 4 + qq;
      unsigned v = imp[q * 65 + lane];
      const bool valid = lane <= cur;
      const bool forced = (lane == 0) || (lane == cur) || (lane == cur - 1);
      if (forced) v += (1u << 30);
      int rank = 0;
      for (int mth = 0; mth <= cur; ++mth) {
        unsigned vm = __builtin_amdgcn_readlane(v, mth);
        rank += (vm > v || (vm == v && mth < lane)) ? 1 : 0;
      }
      u64 msk = __ballot(valid && rank < 16);
      if (lane == 0) { sel[q] = msk; atomicOr(&uni[0], (unsigned)msk); atomicOr(&uni[1], (unsigned)(msk >> 32)); }
    }
    __syncthreads();
    const u64 selq = sel[ql];
    const u64 unim = ((u64)uni[1] << 32) | uni[0];
    nsa_load_q((const u16*)(ws + OFF_QR), row, hq, h, qf);

    for (int br = 1; br <= 2; ++br) {
      const u16* Kg = (br == 1 ? KS_g : KW_g) + (size_t)bg * S * 64;
      const u16* Vg = (br == 1 ? VS_g : VW_g) + (size_t)bg * S * 64;
      u64 tm;
      if (br == 1) tm = unim;
      else {
        int first = (t0 - 512) >> 6; if (first < 0) first = 0;
        tm = (~0ull >> (63 - cur)) & (~0ull << first);
      }
      m = 0.f; l = 0.f;
#pragma unroll
      for (int mb = 0; mb < 2; ++mb)
#pragma unroll
        for (int i = 0; i < 16; ++i) O[mb][i] = 0.f;
#define NSA_LD(KP, VP, nt) do { kreg = *(const uint4*)((KP) + (size_t)((nt) * 64 + lr) * 64 + lch * 8); \
                               vreg = *(const uint4*)((VP) + (size_t)((nt) * 64 + lr) * 64 + lch * 8); } while (0)
#define NSA_ST(bb) do { *(uint4*)(Kb + (bb) * 64 * KST + lr * KST + lch * 8) = kreg; *(uint4*)(Vb + (bb) * 64 * VST + lr * VST + lch * 8) = vreg; } while (0)
      int buf = 0;
      int n = __builtin_ctzll(tm);
      tm &= tm - 1;
      if (br == 1) NSA_LD(Kg, Vg, n);
      NSA_ST(0);
      int n1 = -1;
      if (tm) { n1 = __builtin_ctzll(tm); tm &= tm - 1; NSA_LD(Kg, Vg, n1); }
      bool wpre = false;
      __syncthreads();
      for (;;) {
        int n2 = -1;
        if (n1 >= 0) {
          NSA_ST(buf ^ 1);
          if (tm) { n2 = __builtin_ctzll(tm); tm &= tm - 1; NSA_LD(Kg, Vg, n2); }
        }
        if (br == 1 && n2 < 0 && !wpre) {
          int wf = (t0 - 512) >> 6; if (wf < 0) wf = 0;
          NSA_LD(KW_g + (size_t)bg * S * 64, VW_g + (size_t)bg * S * 64, wf);
          wpre = true;
        }
        const u16* Kt = Kb + buf * 64 * KST;
        const u16* Vt = Vb + buf * 64 * VST;
        int lo, hi = t;
        const bool lsel = (selq >> n) & 1;
        lo = (br == 1) ? -1 : t - 512;
        {
          const int kp0 = n * 64;
          const float init = (br == 2 || lsel) ? -m : NINF;
          bf16x8 fr8[8];
          k_load8<KST>(Kt, fr8, ql, h);
          f32x16 s0 = qk_mma(fr8, qf, init);
          f32x16 s1 = qk_mma(fr8 + 4, qf, init);
          pv_load<VST>(Vt, fr8, lane);
          float alpha; bool need;
          const bool interior = (kp0 + 63 <= t0) && (br == 1 || kp0 > t0 + 31 - 512);
          if (!interior) need = softmax_step64<true>(s0, s1, kp0 + 4 * h, lo, hi, m, l, alpha, pf, lane);
          else need = softmax_step64<false>(s0, s1, 0, 0, 0, m, l, alpha, pf, lane);
          if (need) {
#pragma unroll
            for (int mb = 0; mb < 2; ++mb)
#pragma unroll
              for (int i = 0; i < 16; ++i) O[mb][i] *= alpha;
          }
          pv_mma(fr8, pf, O);
          pv_load<VST>(Vt + 32 * VST, fr8 + 4, lane);
          pv_mma(fr8 + 4, pf + 2, O);
        }
        __syncthreads();
        if (n1 < 0) break;
        n = n1; n1 = n2; buf ^= 1;
      }
#undef NSA_LD
#undef NSA_ST
      l += shx(l, 32, lane);
      const float sc = (br == 1 ? g1 : g2) * ((l > 0.f) ? 1.f / l : 0.f);
#pragma unroll
      for (int mb = 0; mb < 2; ++mb)
#pragma unroll
        for (int i = 0; i < 16; i += 2) {
          const unsigned pk = outp[mb * 8 + (i >> 1)];
          const float a0 = sc * O[mb][i] + __uint_as_float(pk << 16), a1 = sc * O[mb][i + 1] + __uint_as_float(pk & 0xffff0000u);
          if (br == 1) outp[mb * 8 + (i >> 1)] = pack2(a0, a1);
          else { O[mb][i] = a0; O[mb][i + 1] = a1; }
        }
    }
#pragma unroll
    for (int mb = 0; mb < 2; ++mb)
#pragma unroll
      for (int a = 0; a < 4; ++a) {
        uint2 o; o.x = pack2(O[mb][4 * a], O[mb][4 * a + 1]); o.y = pack2(O[mb][4 * a + 2], O[mb][4 * a + 3]);
        *(uint2*)(Oout + row * D + hq * 64 + mb * 32 + 8 * a + 4 * h) = o;
      }
  }
}

DI void diff_attn_phase(const Params& p, char* smem, int j) {
  const int tid = get_tid(), w = tid >> 6, lane = tid & 63, ql = lane & 31, h = lane >> 5;
  char* ws = launder_ptr(p.ws);
  u16* K1b = (u16*)smem;
  u16* K2b = K1b + 2 * 64 * KST;
  u16* Vb = K2b + 2 * 64 * KST;
  u16* Qs = Vb + 2 * 64 * VDS + w * (2 * 32 * KST);
  const int layer = 2 + j;
  const float lambda_init = (layer == 2) ? 0.47071301834f : 0.55605820415f;
  float lam;
  {
    float a = p.in[21][j * 64 + lane] * p.in[22][j * 64 + lane];
    float c = p.in[23][j * 64 + lane] * p.in[24][j * 64 + lane];
#pragma unroll
    for (int o = 32; o > 0; o >>= 1) { a += shx(a, o, lane); c += shx(c, o, lane); }
    lam = expf(a) - expf(c) + lambda_init;
  }
  const u16* QD = (const u16*)(ws + OFF_PROJ);
  u16* Oout = (u16*)(ws + OFF_QR);
  const float* sg = p.in[25] + j * 128;

  for (int item = blockIdx.x; item < 1024; item += gridDim.x) {
    const int rnd = item >> 8, j256 = item & 255;
    const int bh = j256 & 63, kq = j256 >> 6;
    const int qb = (rnd == 0) ? kq : (rnd == 1) ? 15 - kq : (rnd == 2) ? 4 + kq : 11 - kq;
    const int b = bh >> 3, hd = bh & 7;
    const int t0 = qb * 256 + w * 32, t = t0 + ql;
    const long row = (long)b * S + t;
    const u16* K1g = (const u16*)(ws + OFF_KD) + ((size_t)((b * 2 + 0) * 8 + hd)) * S * 64;
    const u16* K2g = (const u16*)(ws + OFF_KD) + ((size_t)((b * 2 + 1) * 8 + hd)) * S * 64;
    const u16* Vg = (const u16*)(ws + OFF_VD) + ((size_t)(b * 8 + hd)) * S * 128;
#pragma unroll
    for (int ks = 0; ks < 4; ++ks) {
      bf16x8 qa = *(const bf16x8*)(QD + row * D + hd * 64 + ks * 16 + h * 8);
      bf16x8 qb2 = *(const bf16x8*)(QD + row * D + 512 + hd * 64 + ks * 16 + h * 8);
      *(bf16x8*)(Qs + ql * KST + ks * 16 + h * 8) = qa;
      *(bf16x8*)(Qs + 32 * KST + ql * KST + ks * 16 + h * 8) = qb2;
    }
    f32x16 O1[4], O2[4];
#pragma unroll
    for (int mb = 0; mb < 4; ++mb)
#pragma unroll
      for (int i = 0; i < 16; ++i) { O1[mb][i] = 0.f; O2[mb][i] = 0.f; }
    float m1 = 0.f, l1 = 0.f, m2 = 0.f, l2 = 0.f;
    const int ntile = (qb + 1) * 4;
    const int lr = tid >> 3, lch = tid & 7;
    uint4 k1r, k2r;
    __syncthreads();
    {
      k1r = *(const uint4*)(K1g + (size_t)lr * 64 + lch * 8);
      k2r = *(const uint4*)(K2g + (size_t)lr * 64 + lch * 8);
      *(uint4*)(K1b + lr * KST + lch * 8) = k1r;
      *(uint4*)(K2b + lr * KST + lch * 8) = k2r;
      k1r = *(const uint4*)(Vg + (size_t)lr * 128 + lch * 8);
      k2r = *(const uint4*)(Vg + (size_t)lr * 128 + 64 + lch * 8);
      *(uint4*)(Vb + lr * VDS + lch * 8) = k1r;
      *(uint4*)(Vb + lr * VDS + 64 + lch * 8) = k2r;
    }
    __syncthreads();
    int buf = 0;
    for (int n = 0; n < ntile; ++n) {
      const bool more = (n + 1 < ntile);
      if (more) {
        const int k0 = (n + 1) * 64;
        k1r = *(const uint4*)(K1g + (size_t)(k0 + lr) * 64 + lch * 8);
        k2r = *(const uint4*)(K2g + (size_t)(k0 + lr) * 64 + lch * 8);
      }
      const u16* K1t = K1b + buf * 64 * KST;
      const u16* K2t = K2b + buf * 64 * KST;
      const u16* Vt = Vb + buf * 64 * VDS;
#pragma unroll
      for (int sub = 0; sub < 2; ++sub) {
        if (sub == 1 && more) {
          const int nb = buf ^ 1, k0 = (n + 1) * 64;
          *(uint4*)(K1b + nb * 64 * KST + lr * KST + lch * 8) = k1r;
          *(uint4*)(K2b + nb * 64 * KST + lr * KST + lch * 8) = k2r;
          k1r = *(const uint4*)(Vg + (size_t)(k0 + lr) * 128 + lch * 8);
          k2r = *(const uint4*)(Vg + (size_t)(k0 + lr) * 128 + 64 + lch * 8);
        }
        const int kp0 = n * 64 + sub * 32;
        if (kp0 > t0 + 31) continue;
        bf16x8 pf1[2], pf2[2];
        {
          f32x16 sA = qk_tile_lds<KST>(K1t + sub * 32 * KST, Qs, ql, h, -m1);
          f32x16 sB = qk_tile_lds<KST>(K2t + sub * 32 * KST, Qs + 32 * KST, ql, h, -m2);
          float alpha1, alpha2; bool need1, need2;
          if (kp0 + 31 <= t0) {
            need1 = softmax_step<false>(sA, 0, 0, 0, m1, l1, alpha1, pf1, lane);
            need2 = softmax_step<false>(sB, 0, 0, 0, m2, l2, alpha2, pf2, lane);
          } else {
            need1 = softmax_step<true>(sA, kp0 + 4 * h, -1, t, m1, l1, alpha1, pf1, lane);
            need2 = softmax_step<true>(sB, kp0 + 4 * h, -1, t, m2, l2, alpha2, pf2, lane);
          }
          if (need1 || need2) {
#pragma unroll
            for (int mb = 0; mb < 4; ++mb)
#pragma unroll
              for (int i = 0; i < 16; ++i) { O1[mb][i] *= alpha1; O2[mb][i] *= alpha2; }
          }
        }
        {
          const int l16 = lane & 15, tq = l16 >> 2, tp = l16 & 3, blk = (lane >> 4) & 1;
          const u16* vbase = Vt + (sub * 32 + 4 * h + tq) * VDS + 16 * blk + 4 * tp;
#pragma unroll
          for (int mb = 0; mb < 4; ++mb)
#pragma unroll
            for (int s2 = 0; s2 < 2; ++s2) {
              s16x4 lo = tr_read(vbase + (16 * s2) * VDS + mb * 32);
              s16x4 hi = tr_read(vbase + (16 * s2 + 8) * VDS + mb * 32);
              bf16x8 a = __builtin_shufflevector(lo, hi, 0, 1, 2, 3, 4, 5, 6, 7);
              O1[mb] = mfma32(a, pf1[s2], O1[mb]);
              O2[mb] = mfma32(a, pf2[s2], O2[mb]);
            }
        }
      }
      if (more) {
        const int nb = buf ^ 1;
        *(uint4*)(Vb + nb * 64 * VDS + lr * VDS + lch * 8) = k1r;
        *(uint4*)(Vb + nb * 64 * VDS + lr * VDS + 64 + lch * 8) = k2r;
      }
      __syncthreads();
      buf ^= 1;
    }
    l1 += shx(l1, 32, lane); l2 += shx(l2, 32, lane);
    const float i1 = 1.f / l1, i2 = lam / l2;
    float ss = 0.f;
#pragma unroll
    for (int mb = 0; mb < 4; ++mb)
#pragma unroll
      for (int i = 0; i < 16; ++i) { float o = O1[mb][i] * i1 - O2[mb][i] * i2; O1[mb][i] = o; ss += o * o; }
    ss += shx(ss, 32, lane);
    const float rn = rsqrtf(ss * (1.f / 128.f) + 1e-5f) * (1.f - lambda_init);
#pragma unroll
    for (int mb = 0; mb < 4; ++mb)
#pragma unroll
      for (int a = 0; a < 4; ++a) {
        const int dv = mb * 32 + 8 * a + 4 * h;
        float4 gg = *(const float4*)(sg + dv);
        uint2 o;
        o.x = pack2(O1[mb][4 * a] * rn * gg.x, O1[mb][4 * a + 1] * rn * gg.y);
        o.y = pack2(O1[mb][4 * a + 2] * rn * gg.z, O1[mb][4 * a + 3] * rn * gg.w);
        *(uint2*)(Oout + row * D + hd * 128 + dv) = o;
      }
  }
}


#define XB_TMO      128
#define XB_XCNT(j)  (256  + 64 * (j))
#define XB_XSUB(j)  (1280 + 64 * (j))
#define XB_XGEN(j)  (2304 + 64 * (j))
#define XB_TOP      3328
#define XB_TOPGEN   3392
#define XCD_BAR_WORDS 3456
#define XB_SPIN_CAP (1u << 22)
DI unsigned xb_ld(unsigned* p) { return __hip_atomic_load(p, __ATOMIC_RELAXED, __HIP_MEMORY_SCOPE_AGENT); }
DI unsigned xb_add(unsigned* p, unsigned v) { return __hip_atomic_fetch_add(p, v, __ATOMIC_RELAXED, __HIP_MEMORY_SCOPE_AGENT); }
DI unsigned xb_xcc_id() { return (unsigned)__builtin_amdgcn_s_getreg((3 << 11) | 20) & 0xFu; }
#define XB_SPIN(cond, bar) do { unsigned _sp = 0; while (cond) { __builtin_amdgcn_s_sleep(1); \
    if ((++_sp & 255u) == 0u) { if (xb_ld(&(bar)[XB_TMO])) break; if (_sp > XB_SPIN_CAP) { atomicAdd(&(bar)[XB_TMO], 1u); break; } } } } while (0)
struct XcdBarrier { unsigned* bar; unsigned x; volatile LAS unsigned* st; };
DI XcdBarrier xcd_barrier_post(unsigned* bar, volatile LAS unsigned* st) {
  XcdBarrier b; b.bar = bar; b.x = xb_xcc_id(); b.st = st;
  if (get_tid() == 0) (void)xb_add(&bar[XB_XCNT(b.x)], 1u);
  return b;
}
DI void xcd_barrier_complete(unsigned* bar, unsigned x, unsigned& nloc, unsigned& nx) {
  const unsigned G = gridDim.x * gridDim.y * gridDim.z;
  unsigned sum, cnt, mine, sp = 0u;
  for (;;) {
    sum = 0u; cnt = 0u; mine = 0u;
#pragma unroll
    for (unsigned j = 0; j < 16; ++j) { const unsigned c = xb_ld(&bar[XB_XCNT(j)]); sum += c; cnt += (c > 0u) ? 1u : 0u; mine = (j == x) ? c : mine; }
    if (sum == G) break;
    __builtin_amdgcn_s_sleep(1);
    if ((++sp & 255u) == 0u) { if (xb_ld(&bar[XB_TMO])) break; if (sp > XB_SPIN_CAP) { atomicAdd(&bar[XB_TMO], 1u); break; } }
  }
  nloc = mine > 0u ? mine : 1u; nx = cnt > 0u ? cnt : 1u;
}
DI void xcd_barrier(const XcdBarrier& b) {
  asm volatile("s_waitcnt vmcnt(0)" ::: "memory");
  __syncthreads();
  if (get_tid() == 0) {
    unsigned* bar = b.bar;
    __builtin_amdgcn_s_waitcnt(0);
    unsigned nloc = b.st[0], nx = b.st[1];
    if (nloc == 0u) { xcd_barrier_complete(bar, b.x, nloc, nx); b.st[0] = nloc; b.st[1] = nx; }
    const unsigned old = xb_add(&bar[XB_XSUB(b.x)], 1u);
    const unsigned gen = old / nloc;
    if (old + 1u == (gen + 1u) * nloc) {
      __builtin_amdgcn_fence(__ATOMIC_RELEASE, "agent");
      asm volatile("s_waitcnt vmcnt(0)" ::: "memory");
      const unsigned og = xb_add(&bar[XB_TOP], 1u);
      const unsigned tg = og / nx;
      if (og + 1u == (tg + 1u) * nx) xb_add(&bar[XB_TOPGEN], 1u);
      else XB_SPIN(xb_ld(&bar[XB_TOPGEN]) == tg, bar);
      __builtin_amdgcn_fence(__ATOMIC_ACQUIRE, "agent");
      xb_add(&bar[XB_XGEN(b.x)], 1u);
      asm volatile("s_waitcnt vmcnt(0)" ::: "memory");
    } else {
      XB_SPIN(xb_ld(&bar[XB_XGEN(b.x)]) == gen, bar);
      __builtin_amdgcn_fence(__ATOMIC_ACQUIRE, "agent");
      asm volatile("s_waitcnt vmcnt(0)" ::: "memory");
    }
  }
  __syncthreads();
}

__global__ void __launch_bounds__(NTHR) mega(Params p, int ph_lo, int ph_hi, int coop) {
  extern __shared__ __attribute__((aligned(16))) char smem[];
  cg::grid_group grid = cg::this_grid();
  volatile LAS unsigned* xst = (volatile LAS unsigned*)(smem + SMEM_BYTES - 16);
  if (get_tid() == 0) { xst[0] = 0u; xst[1] = 0u; }
  __syncthreads();
  const XcdBarrier xb = xcd_barrier_post((unsigned*)(p.ws + OFF_BAR), xst);
  int ph = 0;
  if (ph_hi < 0) grid.sync();
  if (ph >= ph_lo && ph < ph_hi) { prep_phase(p, smem); if (coop && ph + 1 < ph_hi) xcd_barrier(xb); }
  ++ph;
  for (int l = 0; l < 4; ++l) {
    for (int st = 0; st < 12; ++st) {
      if (st == 4 && l >= 2) continue;
      if (st == 11 && l != 1) continue;
      if (st == 2 || st == 7 || st == 10) continue;
      if (ph >= ph_lo && ph < ph_hi) {
        char* wsl = launder_ptr(p.ws);
        char* wb = layer_w(wsl, l);
        char* mb = wb + 2 * (SZ_WGU + SZ_WD);
        const u16* XB = (const u16*)(wsl + OFF_XB);
        const u16* HB = (const u16*)(wsl + OFF_H);
        int kind = 0;
        const u16* A = XB; const u16* Bt = nullptr; int N = D, K = D, mode = EPI_RESID; float coef = 1.f; int lni = 0;
        switch (st) {
          case 0: Bt = (const u16*)wb; N = 2 * F; mode = EPI_GATEUP; break;
          case 1: A = HB; Bt = (const u16*)(wb + SZ_WGU); K = F; coef = 0.5f; lni = l * 3; break;
          case 2: kind = 1; lni = l * 3; break;
          case 3: Bt = (const u16*)mb; if (l < 2) { N = 2048; mode = EPI_NSA_IN; } else { mode = EPI_DIFF_Q; } break;
          case 4: kind = 2; break;
          case 5: kind = (l < 2) ? 3 : 4; break;
          case 6: A = (const u16*)(wsl + (l < 2 ? OFF_PROJ : OFF_QR)); Bt = (const u16*)(mb + (l < 2 ? 4194304 : 2097152)); lni = l * 3 + 1; break;
          case 7: kind = 1; lni = l * 3 + 1; break;
          case 8: Bt = (const u16*)(wb + SZ_WGU + SZ_WD); N = 2 * F; mode = EPI_GATEUP; break;
          case 9: A = HB; Bt = (const u16*)(wb + SZ_WGU + SZ_WD + SZ_WGU); K = F; coef = 0.5f; lni = l * 3 + 2; break;
          case 10: kind = 1; lni = l * 3 + 2; break;
          default: Bt = (const u16*)(wsl + OFF_WKV); N = 2048; mode = EPI_DIFF_KV; break;
        }
        if (kind == 0) gemm_phase(p, smem, A, Bt, N, K, mode, coef, lni, p.in[7] + (size_t)lni * D, p.in[8] + (size_t)lni * D);
        else if (kind == 2) compress_phase(p, smem, l);
        else if (kind == 3) nsa_attn_phase(p, smem);
        else diff_attn_phase(p, smem, l - 2);
        if (coop && ph + 1 < ph_hi) xcd_barrier(xb);
      }
      ++ph;
    }
  }
}

extern "C" void kernel_launch(void* const* d_in, const int* in_sizes, int n_in, void* d_out, int out_size, void* d_ws,
                              size_t ws_size, hipStream_t stream) {
  if (n_in < 27 || ws_size < WS_NEED) { fprintf(stderr, "bad args: n_in %d ws %zu need %zu\n", n_in, ws_size, (size_t)WS_NEED); return; }
  Params p{};
  for (int i = 0; i < 27; ++i) p.in[i] = (const float*)d_in[i];
  p.out = (float*)d_out;
  p.ws = (char*)d_ws;
  static int grid_blocks = 0;
  (void)hipFuncSetAttribute((const void*)mega, hipFuncAttributeMaxDynamicSharedMemorySize, SMEM_BYTES);
  if (!grid_blocks) {
    int dev = 0, cus = 0, per_cu = 0;
    (void)hipGetDevice(&dev);
    (void)hipDeviceGetAttribute(&cus, hipDeviceAttributeMultiprocessorCount, dev);
    (void)hipOccupancyMaxActiveBlocksPerMultiprocessor(&per_cu, mega, NTHR, SMEM_BYTES);
    if (per_cu < 1) per_cu = 1;
    grid_blocks = cus;
    if (grid_blocks % 8) grid_blocks -= grid_blocks % 8;
  }
  (void)hipMemsetAsync((char*)d_ws + OFF_BAR, 0, 16384 + 32768, stream);
  int lo = 0, hi = 1000, coop = 1;
  void* args[] = {&p, &lo, &hi, &coop};
  hipError_t e = hipLaunchCooperativeKernel((const void*)mega, dim3(grid_blocks), dim3(NTHR), args, SMEM_BYTES, stream);
  if (e != hipSuccess) fprintf(stderr, "cooperative launch failed: %s (grid %d)\n", hipGetErrorString(e), grid_blocks);
}
```

```cpp
#include <hip/hip_runtime.h>
#include <hip/hip_cooperative_groups.h>
#include <cstdio>
namespace cg = cooperative_groups;

#define DI __device__ __forceinline__
typedef unsigned short u16;
typedef unsigned long long u64;
using bf16x8 = __attribute__((ext_vector_type(8))) short;
using s16x4 = __attribute__((ext_vector_type(4))) short;
using f32x4 = __attribute__((ext_vector_type(4))) float;
using f32x16 = __attribute__((ext_vector_type(16))) float;
using f32x2 = __attribute__((ext_vector_type(2))) float;
using bf16v2 = __attribute__((ext_vector_type(2))) __bf16;

constexpr int NB = 8, S = 4096, M = NB * S, D = 1024, F = 2816;
constexpr int NTHR = 512;
constexpr int SMEM_BYTES = 155648;
constexpr float ALPHA = 1.681792830507429f;
constexpr float NEGF = -1e30f;

constexpr size_t OFF_XB = 0;
constexpr size_t OFF_H = 67108864;
constexpr size_t OFF_KV = OFF_H + 184549376;
constexpr size_t OFF_W = OFF_KV + 134217728;
constexpr size_t SZ_WGU = 11534336, SZ_WD = 5767168;
constexpr size_t LW_A = 41943040, LW_B = 38797312;
constexpr size_t OFF_WKV = OFF_W + 2 * LW_B;
constexpr size_t OFF_SEG = OFF_WKV + 4194304;
constexpr size_t SZ_SEG = 8388608;
constexpr size_t OFF_GATES = OFF_SEG + 6 * SZ_SEG;
constexpr size_t OFF_KCMP = OFF_GATES + 6291456;
constexpr size_t OFF_VCMPT = OFF_KCMP + 524288;
constexpr size_t OFF_ROPE = OFF_VCMPT + 524288;
constexpr size_t OFF_B1P = OFF_ROPE + 262144;
constexpr size_t OFF_BAR = OFF_B1P + 4096;
constexpr size_t OFF_CNT = OFF_BAR + 16384;
constexpr size_t OFF_SLOTS = OFF_CNT + 32768;
constexpr size_t WS_NEED = OFF_SLOTS + 1048576;
constexpr size_t OFF_PROJ = OFF_H;
constexpr size_t OFF_QR = OFF_H + 67108864;
constexpr size_t OFF_PARK = OFF_H + 134217728;
constexpr size_t OFF_KD = OFF_KV;
constexpr size_t OFF_VD = OFF_KV + 67108864;

struct Params {
  const float* in[27];
  float* out;
  char* ws;
};

struct Params;
typedef __attribute__((address_space(1))) char gchar_t;
DI char* launder_ptr(char* w) { gchar_t* g = (gchar_t*)w; asm volatile("" : "+s"(g)); return (char*)g; }
DI int get_tid() { int t = threadIdx.x; asm volatile("" : "+v"(t)); return t; }
DI float shx(float v, int mask, int lane) { return __int_as_float(__builtin_amdgcn_ds_bpermute((lane ^ mask) << 2, __float_as_int(v))); }
DI u16 f2bf(float x) { return __builtin_bit_cast(u16, (__bf16)x); }
DI unsigned pack2(float a, float b) {
  f32x2 v = {a, b};
  return __builtin_bit_cast(unsigned, __builtin_convertvector(v, bf16v2));
}
DI float bf2f(u16 v) { return __uint_as_float(((unsigned)v) << 16); }
DI f32x16 mfma32(bf16x8 a, bf16x8 b, f32x16 c) { return __builtin_amdgcn_mfma_f32_32x32x16_bf16(a, b, c, 0, 0, 0); }

DI char* layer_w(char* ws, int l) { return l < 2 ? ws + OFF_KV + (size_t)l * LW_A : ws + OFF_W + (size_t)(l - 2) * LW_B; }

struct Task { const float* src; u16* dst; int K, Nsrc, Ndst, mode; };
DI Task get_task(const Params& p, int task) {
  Task t; t.src = nullptr; t.dst = nullptr; t.K = 0; t.Nsrc = 0; t.Ndst = 0; t.mode = 0;
  if (task == 40) { t.src = p.in[19]; t.dst = (u16*)(p.ws + OFF_WKV); t.K = 1024; t.Nsrc = 2048; t.Ndst = 2048; return t; }
  int l = task / 10, k = task % 10;
  char* wb = layer_w(p.ws, l);
  if (k < 6) {
    int f2 = k / 3, kk = k % 3;
    const float* src = p.in[1 + f2 * 3 + kk];
    if (kk < 2) { t.src = src + (size_t)l * D * F; t.dst = (u16*)(wb + f2 * (SZ_WGU + SZ_WD)); t.K = D; t.Nsrc = F; t.Ndst = F; t.mode = 1 + kk; }
    else { t.src = src + (size_t)l * F * D; t.dst = (u16*)(wb + f2 * (SZ_WGU + SZ_WD) + SZ_WGU); t.K = F; t.Nsrc = D; t.Ndst = D; }
    return t;
  }
  char* mb = wb + 2 * (SZ_WGU + SZ_WD);
  if (l < 2) {
    if (k == 6) { t.src = p.in[9] + (size_t)l * D * 1840; t.dst = (u16*)mb; t.K = D; t.Nsrc = 1840; t.Ndst = 2048; }
    else if (k == 7) { t.src = p.in[18] + (size_t)l * D * D; t.dst = (u16*)(mb + 4194304); t.K = D; t.Nsrc = D; t.Ndst = D; }
    else if (k == 8) { t.src = p.in[11] + (size_t)l * 2048 * 128; t.dst = (u16*)(mb + 4194304 + 2097152); t.K = 2048; t.Nsrc = 128; t.Ndst = 128; }
    else { t.src = p.in[15] + (size_t)l * 2048 * 128; t.dst = (u16*)(mb + 4194304 + 2097152 + 524288); t.K = 2048; t.Nsrc = 128; t.Ndst = 128; }
  } else {
    int j = l - 2;
    if (k == 6) { t.src = p.in[20] + (size_t)j * D * D; t.dst = (u16*)mb; t.K = D; t.Nsrc = D; t.Ndst = D; }
    else if (k == 7) { t.src = p.in[26] + (size_t)j * D * D; t.dst = (u16*)(mb + 2097152); t.K = D; t.Nsrc = D; t.Ndst = D; }
  }
  return t;
}

DI void prep_phase(const Params& p, char* smem) {
  const int tid = get_tid();
  float* T = (float*)smem;
  {
    for (int gt = blockIdx.x; gt < 5056; gt += gridDim.x) {
      int task, tile;
      if (gt >= 4928) { task = 40; tile = gt - 4928; }
      else {
        int l, r;
        if (gt < 2560) { l = gt / 1280; r = gt - l * 1280; } else { l = 2 + (gt - 2560) / 1184; r = (gt - 2560) % 1184; }
        if (r < 1056) { task = l * 10 + r / 176; tile = r % 176; }
        else {
          r -= 1056;
          if (l < 2) { if (r < 128) { task = l * 10 + 6; tile = r; } else if (r < 192) { task = l * 10 + 7; tile = r - 128; } else if (r < 208) { task = l * 10 + 8; tile = r - 192; } else { task = l * 10 + 9; tile = r - 208; } }
          else { if (r < 64) { task = l * 10 + 6; tile = r; } else { task = l * 10 + 7; tile = r - 64; } }
        }
      }
      Task t = get_task(p, task);
      const int nkt = t.K / 256;
      const int k0 = (tile % nkt) * 256, n0 = (tile / nkt) * 64;
      __syncthreads();
      float4 v[8];
#pragma unroll
      for (int e = 0; e < 8; ++e) {
        int idx = tid + e * 512, kk = idx >> 4, n4 = (idx & 15) * 4;
        v[e] = (n0 + n4 < t.Nsrc) ? *(const float4*)(t.src + (size_t)(k0 + kk) * t.Nsrc + n0 + n4) : make_float4(0.f, 0.f, 0.f, 0.f);
      }
#pragma unroll
      for (int e = 0; e < 8; ++e) {
        int idx = tid + e * 512, kk = idx >> 4, n4 = (idx & 15) * 4;
        T[(n4 + 0) * 257 + kk] = v[e].x; T[(n4 + 1) * 257 + kk] = v[e].y; T[(n4 + 2) * 257 + kk] = v[e].z; T[(n4 + 3) * 257 + kk] = v[e].w;
      }
      __syncthreads();
      const int nn = tid >> 3;
      int n = n0 + nn;
      int drow = t.mode == 0 ? n : ((n >> 7) * 256 + (t.mode - 1) * 128 + (n & 127));
#pragma unroll
      for (int j = 0; j < 4; ++j) {
        const int kc = (tid & 7) * 8 + j * 64;
        const float* tp = T + nn * 257 + kc;
        uint4 o;
        o.x = pack2(tp[0], tp[1]); o.y = pack2(tp[2], tp[3]); o.z = pack2(tp[4], tp[5]); o.w = pack2(tp[6], tp[7]);
        *(uint4*)(t.dst + (size_t)drow * t.K + k0 + kc) = o;
      }
    }
  }
  {
    const float4* xs = (const float4*)p.in[0];
    uint4* xb = (uint4*)(p.ws + OFF_XB);
    u16* lo = (u16*)p.out;
    const size_t n8 = (size_t)M * D / 8;
    const size_t stride = (size_t)gridDim.x * NTHR;
    for (size_t i = (size_t)blockIdx.x * NTHR + tid; i < n8; i += 4 * stride) {
      float4 va[4], vb[4];
#pragma unroll
      for (int j = 0; j < 4; ++j) { va[j] = xs[2 * (i + j * stride)]; vb[j] = xs[2 * (i + j * stride) + 1]; }
#pragma unroll
      for (int j = 0; j < 4; ++j) {
        const size_t e = i + j * stride;
        uint4 o; o.x = pack2(va[j].x, va[j].y); o.y = pack2(va[j].z, va[j].w); o.z = pack2(vb[j].x, vb[j].y); o.w = pack2(vb[j].z, vb[j].w);
        xb[e] = o;
        uint4 lw;
        lw.x = ((__float_as_uint(va[j].x) - (o.x << 16)) & 0xffffu) | ((__float_as_uint(va[j].y) - (o.x & 0xffff0000u)) << 16);
        lw.y = ((__float_as_uint(va[j].z) - (o.y << 16)) & 0xffffu) | ((__float_as_uint(va[j].w) - (o.y & 0xffff0000u)) << 16);
        lw.z = ((__float_as_uint(vb[j].x) - (o.z << 16)) & 0xffffu) | ((__float_as_uint(vb[j].y) - (o.z & 0xffff0000u)) << 16);
        lw.w = ((__float_as_uint(vb[j].z) - (o.w << 16)) & 0xffffu) | ((__float_as_uint(vb[j].w) - (o.w & 0xffff0000u)) << 16);
        const size_t row = e >> 7, c8 = e & 127;
        *(uint4*)(lo + row * 2048 + 1024 + c8 * 8) = lw;
      }
    }
  }
  {
    float2* rt = (float2*)(p.ws + OFF_ROPE);
    for (int i = blockIdx.x * NTHR + tid; i < 4096 * 8; i += gridDim.x * NTHR) {
      int pos = i >> 3, k = i & 7;
      float inv = (float)pow(500000.0, -(double)k / 8.0);
      float ang = (float)pos * inv;
      rt[i] = make_float2((float)cos((double)ang), (float)sin((double)ang));
    }
  }
  if (blockIdx.x < 4 && tid < 128) {
    int l = blockIdx.x >> 1, kv = blockIdx.x & 1;
    const float* pos = p.in[kv ? 14 : 10] + (size_t)l * 2048;
    const float* w1 = p.in[kv ? 15 : 11] + (size_t)l * 2048 * 128;
    const float* b1 = p.in[kv ? 16 : 12] + (size_t)l * 128;
    float acc = b1[tid];
    for (int i = 0; i < 2048; ++i) acc += pos[i] * w1[(size_t)i * 128 + tid];
    ((float*)(p.ws + OFF_B1P))[(l * 2 + kv) * 128 + tid] = acc;
  }
}

#define LAS __attribute__((address_space(3)))
constexpr int BM = 256, BK = 64, HALF = 128, HTB = HALF * BK * 2;

DI int lds_byte(int r, int c) {
  const int st = (r >> 4) * 2 + (c >> 5), rr = r & 15, cc = c & 31, ob = rr * 64 + cc * 2;
  return st * 1024 + (ob ^ (((ob >> 9) & 1) << 5));
}
DI void stage_rc(int b, int& R, int& C) {
  const int st = b / 1024, sb = b % 1024, swz = sb ^ (((sb >> 9) & 1) << 5);
  R = (st >> 1) * 16 + swz / 64; C = (st & 1) * 32 + (swz % 64) / 2;
}
DI int perm32(int rho) { const int n = rho >> 4, i = rho & 15; return 8 * (i >> 2) + 4 * n + (i & 3); }

enum { EPI_GATEUP = 0, EPI_RESID = 1, EPI_NSA_IN = 2, EPI_DIFF_Q = 3, EPI_DIFF_KV = 4 };

DI bool unit_next(int i, int nM, int nN, int& pm, int& pn) {
  const int nwg = nM * nN;
  const long L = (long)i * gridDim.x + blockIdx.x;
  if (L >= nwg) return false;
  int wgid = (int)L;
  { const int q = nwg / 8, r = nwg % 8, xcd = wgid % 8, off = wgid / 8; wgid = (xcd < r ? xcd * (q + 1) : r * (q + 1) + (xcd - r) * q) + off; }
  const int nig = 8 * nN, gid = wgid / nig, fm = gid * 8, gsz = (nM - fm) < 8 ? (nM - fm) : 8;
  pm = fm + ((wgid % nig) % gsz); pn = (wgid % nig) / gsz;
  return true;
}

DI void rope8(float* v, int fq, int pos, const float* rt, int lane) {
  float o[8];
#pragma unroll
  for (int i = 0; i < 8; ++i) o[i] = shx(v[i], 16, lane);
  if (fq < 2) {
    const float4* r4 = (const float4*)(rt + pos * 16);
#pragma unroll
    for (int i = 0; i < 4; ++i) {
      float4 cs = r4[i];
      float a0 = v[2 * i], a1 = v[2 * i + 1];
      if (fq == 0) { v[2 * i] = a0 * cs.x - o[2 * i] * cs.y; v[2 * i + 1] = a1 * cs.z - o[2 * i + 1] * cs.w; }
      else { v[2 * i] = o[2 * i] * cs.y + a0 * cs.x; v[2 * i + 1] = o[2 * i + 1] * cs.w + a1 * cs.z; }
    }
  }
}
DI uint4 pack8(const float* v) {
  uint4 o; o.x = pack2(v[0], v[1]); o.y = pack2(v[2], v[3]); o.z = pack2(v[4], v[5]); o.w = pack2(v[6], v[7]);
  return o;
}

DI void gemm_epi(const Params& p, int mode, float coef, const f32x4 (&acc)[2][2][4][2], int pm, int pn, int wr, int wc, int fr, int fq) {
  char* ws = launder_ptr(p.ws);
  const float* rt = (const float*)(ws + OFF_ROPE);
#pragma unroll
  for (int ai = 0; ai < 2; ++ai)
#pragma unroll
    for (int m = 0; m < 4; ++m) {
      const int row = pm * BM + ai * HALF + wr * 64 + m * 16 + fr;
      const int b = row >> 12, s = row & 4095;
      if (mode == EPI_GATEUP) {
        float v[8];
#pragma unroll
        for (int n = 0; n < 2; ++n)
#pragma unroll
          for (int e = 0; e < 4; ++e) {
            float gv = acc[ai][0][m][n][e], uv = acc[ai][1][m][n][e];
            v[n * 4 + e] = gv * uv * __builtin_amdgcn_rcpf(1.f + __builtin_amdgcn_exp2f(-1.4426950408889634f * gv));
          }
        *(uint4*)((u16*)(ws + OFF_H) + (size_t)row * F + pn * 128 + wc * 32 + 8 * fq) = pack8(v);
      } else if (mode == EPI_RESID) {
#pragma unroll
        for (int bj = 0; bj < 2; ++bj)
#pragma unroll
          for (int n = 0; n < 2; ++n) {
            float4* xp = (float4*)(p.out + (size_t)row * D + pn * BM + bj * HALF + wc * 32 + 16 * n + 4 * fq);
            float4 x = *xp; f32x4 a = acc[ai][bj][m][n];
            x.x = ALPHA * x.x + coef * a[0]; x.y = ALPHA * x.y + coef * a[1]; x.z = ALPHA * x.z + coef * a[2]; x.w = ALPHA * x.w + coef * a[3];
            *xp = x;
          }
      } else {
#pragma unroll
        for (int bj = 0; bj < 2; ++bj) {
          const int cb = pn * BM + bj * HALF + wc * 32, c = cb + 8 * fq;
          const bool head0 = (wc & 1) == 0;
          float v[8];
#pragma unroll
          for (int e = 0; e < 4; ++e) { v[e] = acc[ai][bj][m][0][e]; v[4 + e] = acc[ai][bj][m][1][e]; }
          if (mode == EPI_NSA_IN) {
            if (cb < 1024) {
#pragma unroll
              for (int e = 0; e < 8; ++e) v[e] *= 0.18033688011112042f;
              *(uint4*)((u16*)(ws + OFF_PROJ) + (size_t)row * D + c) = pack8(v);
              if (head0) rope8(v, fq, s, rt, fq * 16 + fr);
              *(uint4*)((u16*)(ws + OFF_QR) + (size_t)row * D + c) = pack8(v);
            } else if (cb < 1792) {
              const int seg = (cb - 1024) >> 7, g = ((cb - 1024) >> 6) & 1, d = c & 63;
              if (head0 && (seg == 2 || seg == 4)) rope8(v, fq, s, rt, fq * 16 + fr);
              *(uint4*)((u16*)(ws + OFF_SEG + (size_t)seg * SZ_SEG) + ((size_t)(b * 2 + g) * S + s) * 64 + d) = pack8(v);
            } else if (c < 1840) {
              float4* gp = (float4*)((float*)(ws + OFF_GATES) + (size_t)row * 48 + (c - 1792));
              gp[0] = make_float4(v[0], v[1], v[2], v[3]); gp[1] = make_float4(v[4], v[5], v[6], v[7]);
            }
          } else if (mode == EPI_DIFF_Q) {
#pragma unroll
            for (int e = 0; e < 8; ++e) v[e] *= 0.18033688011112042f;
            if (head0) rope8(v, fq, s, rt, fq * 16 + fr);
            *(uint4*)((u16*)(ws + OFF_PROJ) + (size_t)row * D + c) = pack8(v);
          } else {
            if (cb < 1024) {
              const int which = cb >> 9, hd = (cb >> 6) & 7, d = c & 63;
              if (head0) rope8(v, fq, s, rt, fq * 16 + fr);
              *(uint4*)((u16*)(ws + OFF_KD) + ((size_t)((b * 2 + which) * 8 + hd) * S + s) * 64 + d) = pack8(v);
            } else {
              const int e0 = c - 1024, hd = e0 >> 7, dv = e0 & 127;
              *(uint4*)((u16*)(ws + OFF_VD) + ((size_t)(b * 8 + hd) * S + s) * 128 + dv) = pack8(v);
            }
          }
        }
      }
    }
}


DI void fused_ln_epi(const Params& p, char* smem, float coef, f32x4 (&acc)[2][2][4][2], int pm, int pn, int wr, int wc, int fr, int fq,
                     int tid, int lnk, const float* g, const float* bt) {
  const int lane = fq * 16 + fr;
  char* ws = launder_ptr(p.ws); float* xout = (float*)launder_ptr((char*)p.out);
  u16* xb = (u16*)(ws + OFF_XB);
  u16* xlo = (u16*)xout;
  float2* P = (float2*)smem;
  float2* Sx = P + 1024;
  u64* slots = (u64*)(ws + OFF_SLOTS);
  unsigned* cnt = (unsigned*)(ws + OFF_CNT);
  int rl0 = wr * 64 + fr;
  asm volatile("" : "+v"(rl0));
  const int coff = pn * BM + wc * 32 + 8 * fq;
#pragma unroll
  for (int ai = 0; ai < 2; ++ai) {
    uint4 hreg[4][2], lreg[4][2];
#pragma unroll
    for (int m = 0; m < 4; ++m) {
      const size_t roff = (size_t)(pm * BM + rl0 + ai * HALF + m * 16);
#pragma unroll
      for (int bj = 0; bj < 2; ++bj) {
        hreg[m][bj] = *(const uint4*)(xb + roff * D + coff + bj * HALF);
        lreg[m][bj] = *(const uint4*)(xlo + roff * 2048 + 1024 + coff + bj * HALF);
      }
    }
#pragma unroll
    for (int m = 0; m < 4; ++m) {
      int rl = rl0 + ai * HALF + m * 16;
      asm volatile("" : "+v"(rl));
      float s = 0.f, q = 0.f;
#pragma unroll
      for (int bj = 0; bj < 2; ++bj) {
        const uint4 h8 = hreg[m][bj], l8 = lreg[m][bj];
        const unsigned hw[4] = {h8.x, h8.y, h8.z, h8.w}, lw[4] = {l8.x, l8.y, l8.z, l8.w};
#pragma unroll
        for (int n = 0; n < 2; ++n) {
          float4 x;
          x.x = __uint_as_float((hw[2 * n] << 16) + (unsigned)(int)(short)(lw[2 * n] & 0xffffu));
          x.y = __uint_as_float((hw[2 * n] & 0xffff0000u) + (unsigned)((int)lw[2 * n] >> 16));
          x.z = __uint_as_float((hw[2 * n + 1] << 16) + (unsigned)(int)(short)(lw[2 * n + 1] & 0xffffu));
          x.w = __uint_as_float((hw[2 * n + 1] & 0xffff0000u) + (unsigned)((int)lw[2 * n + 1] >> 16));
          f32x4 a = acc[ai][bj][m][n];
          a[0] = ALPHA * x.x + coef * a[0]; a[1] = ALPHA * x.y + coef * a[1]; a[2] = ALPHA * x.z + coef * a[2]; a[3] = ALPHA * x.w + coef * a[3];
          acc[ai][bj][m][n] = a;
          s += (a[0] + a[1]) + (a[2] + a[3]);
          q += (a[0] * a[0] + a[1] * a[1]) + (a[2] * a[2] + a[3] * a[3]);
        }
      }
      s += shx(s, 16, lane); q += shx(q, 16, lane);
      s += shx(s, 32, lane); q += shx(q, 32, lane);
      if (fq == 0) P[rl * 4 + wc] = make_float2(s, q);
    }
  }
  float4 gq[2][2], bq2[2][2];
#pragma unroll
  for (int bj = 0; bj < 2; ++bj) {
    const int c = pn * BM + bj * HALF + wc * 32 + 8 * fq;
    gq[bj][0] = *(const float4*)(g + c); gq[bj][1] = *(const float4*)(g + c + 4);
    bq2[bj][0] = *(const float4*)(bt + c); bq2[bj][1] = *(const float4*)(bt + c + 4);
  }
  __syncthreads();
  if (tid < 256) {
    const float2 a0 = P[tid * 4], a1 = P[tid * 4 + 1], a2 = P[tid * 4 + 2], a3 = P[tid * 4 + 3];
    const float s = (a0.x + a1.x) + (a2.x + a3.x), q = (a0.y + a1.y) + (a2.y + a3.y);
    const u64 bits = ((u64)__float_as_uint(q) << 32) | (u64)__float_as_uint(s);
    __hip_atomic_store(slots + ((size_t)(pm * 4 + pn) * 256 + tid), bits, __ATOMIC_RELAXED, __HIP_MEMORY_SCOPE_AGENT);
  }
  asm volatile("s_waitcnt vmcnt(0)" ::: "memory");
  __syncthreads();
  if (tid == 0) {
    unsigned* c = cnt + pm * 64;
    (void)__hip_atomic_fetch_add(c, 1u, __ATOMIC_RELAXED, __HIP_MEMORY_SCOPE_AGENT);
    const unsigned need = 4u * (unsigned)(lnk + 1);
    unsigned sp = 0;
    while (__hip_atomic_load(c, __ATOMIC_RELAXED, __HIP_MEMORY_SCOPE_AGENT) < need) {
      __builtin_amdgcn_s_sleep(1);
      if (++sp > (1u << 24)) break;
    }
  }
  __syncthreads();
  if (tid < 256) {
    float s = 0.f, q = 0.f;
#pragma unroll
    for (int j = 0; j < 4; ++j) {
      const u64 bits = __hip_atomic_load(slots + ((size_t)(pm * 4 + j) * 256 + tid), __ATOMIC_RELAXED, __HIP_MEMORY_SCOPE_AGENT);
      s += __uint_as_float((unsigned)bits); q += __uint_as_float((unsigned)(bits >> 32));
    }
    const float mean = s * (1.f / D);
    const float var = fmaxf(q * (1.f / D) - mean * mean, 0.f);
    Sx[tid] = make_float2(mean, rsqrtf(var + 1e-5f));
  }
  __syncthreads();
#pragma unroll
  for (int bj = 0; bj < 2; ++bj) {
    const int c = pn * BM + bj * HALF + wc * 32 + 8 * fq;
    const float4 g0 = gq[bj][0], g1 = gq[bj][1];
    const float4 b0 = bq2[bj][0], b1 = bq2[bj][1];
#pragma unroll
    for (int ai = 0; ai < 2; ++ai)
#pragma unroll
      for (int m = 0; m < 4; ++m) {
        int rl = rl0 + ai * HALF + m * 16;
        asm volatile("" : "+v"(rl));
        const float2 ms = Sx[rl];
        const f32x4 a = acc[ai][bj][m][0], bq = acc[ai][bj][m][1];
        float v[8];
        v[0] = (a[0] - ms.x) * ms.y * g0.x + b0.x; v[1] = (a[1] - ms.x) * ms.y * g0.y + b0.y;
        v[2] = (a[2] - ms.x) * ms.y * g0.z + b0.z; v[3] = (a[3] - ms.x) * ms.y * g0.w + b0.w;
        v[4] = (bq[0] - ms.x) * ms.y * g1.x + b1.x; v[5] = (bq[1] - ms.x) * ms.y * g1.y + b1.y;
        v[6] = (bq[2] - ms.x) * ms.y * g1.z + b1.z; v[7] = (bq[3] - ms.x) * ms.y * g1.w + b1.w;
        const size_t roff = (size_t)(pm * BM + rl);
        if (lnk == 11) {
          float* xo = xout + roff * D + c;
          *(float4*)xo = make_float4(v[0], v[1], v[2], v[3]);
          *(float4*)(xo + 4) = make_float4(v[4], v[5], v[6], v[7]);
        } else {
          const uint4 h8 = pack8(v);
          *(uint4*)(xb + roff * D + c) = h8;
          uint4 l8;
          l8.x = ((__float_as_uint(v[0]) - (h8.x << 16)) & 0xffffu) | ((__float_as_uint(v[1]) - (h8.x & 0xffff0000u)) << 16);
          l8.y = ((__float_as_uint(v[2]) - (h8.y << 16)) & 0xffffu) | ((__float_as_uint(v[3]) - (h8.y & 0xffff0000u)) << 16);
          l8.z = ((__float_as_uint(v[4]) - (h8.z << 16)) & 0xffffu) | ((__float_as_uint(v[5]) - (h8.z & 0xffff0000u)) << 16);
          l8.w = ((__float_as_uint(v[6]) - (h8.w << 16)) & 0xffffu) | ((__float_as_uint(v[7]) - (h8.w & 0xffff0000u)) << 16);
          *(uint4*)(xlo + roff * 2048 + 1024 + c) = l8;
        }
      }
  }
  __syncthreads();
}

DI void gemm_phase(const Params& p, char* smem, const u16* Ag, const u16* Btg, int N, int K, int mode, float coef, int lnk, const float* lng, const float* lnb) {
  LAS unsigned char* lds = (LAS unsigned char*)smem;
  const int tid = get_tid(), wid = __builtin_amdgcn_readfirstlane(tid >> 6), lane = tid & 63, wr = wid >> 2, wc = wid & 3, fr = lane & 15, fq = lane >> 4;
  const int nt = K / BK, nM = M / BM, nN = N / BM;
  const bool perm = true;
  const bool single = (mode == EPI_RESID);
  unsigned voffA[2], voffB[2];
#pragma unroll
  for (int i = 0; i < 2; ++i) {
    int R, C; stage_rc(tid * 16 + i * 8192, R, C);
    const int Rb = perm ? ((R & ~31) + perm32(R & 31)) : R;
    voffA[i] = (unsigned)(R * K + C) * 2u; voffB[i] = (unsigned)(Rb * K + C) * 2u;
  }
  const size_t kstep = (size_t)(BK * 2);
  const size_t hstep = (size_t)HALF * K * 2;
  const size_t tstep = 2 * hstep;
  const unsigned ldsw = (unsigned)wid * 1024u;
  const int aoff = lds_byte(wr * 64 + fr, fq * 8), boff = lds_byte(wc * 32 + fr, fq * 8);
#define G_SA(b, h) (((b) * 2 + (h)) * HTB)
#define G_SB(b, h) ((4 + (b) * 2 + (h)) * HTB)
#define G_STAGE(bufoff, gbase, voff) do { _Pragma("unroll") for (int _i = 0; _i < 2; ++_i) \
    __builtin_amdgcn_global_load_lds((const unsigned*)((const char*)(gbase) + (voff)[_i]), (LAS unsigned*)(lds + (bufoff) + ldsw + _i * 8192), 16, 0, 0); } while (0)
#define G_LDA(dst, b, h) do { _Pragma("unroll") for (int m = 0; m < 4; ++m) _Pragma("unroll") for (int k = 0; k < 2; ++k) dst[m][k] = *(const LAS bf16x8*)(lds + G_SA(b, h) + aoff + m * 2048 + k * 1024); } while (0)
#define G_LDB(dst, b, h) do { _Pragma("unroll") for (int n = 0; n < 2; ++n) _Pragma("unroll") for (int k = 0; k < 2; ++k) dst[n][k] = *(const LAS bf16x8*)(lds + G_SB(b, h) + boff + n * 2048 + k * 1024); } while (0)
#define G_MMA(ai, bj, At, Bt) do { __builtin_amdgcn_s_setprio(1); _Pragma("unroll") for (int m = 0; m < 4; ++m) _Pragma("unroll") for (int n = 0; n < 2; ++n) _Pragma("unroll") for (int k = 0; k < 2; ++k) \
    acc[ai][bj][m][n] = __builtin_amdgcn_mfma_f32_16x16x32_bf16(Bt[n][k], At[m][k], acc[ai][bj][m][n], 0, 0, 0); __builtin_amdgcn_s_setprio(0); } while (0)
#define G_WAIT_V(n) asm volatile("s_waitcnt vmcnt(" #n ")" ::: "memory")
#define G_WAIT_L(n) asm volatile("s_waitcnt lgkmcnt(" #n ")" ::: "memory")
#define G_BAR __builtin_amdgcn_s_barrier()
#define G_SCHED __builtin_amdgcn_sched_barrier(0)
  int cpm, cpn, npm = 0, npn = 0, ui = 0;
  f32x4 acc[2][2][4][2];
  bf16x8 At[4][2], B0[2][2], B1[2][2];
  for (int ubase = 0;; ++ubase) {
  if (!unit_next(ubase, nM, nN, cpm, cpn)) break;
  ui = ubase;
#pragma unroll
  for (int a = 0; a < 2; ++a)
#pragma unroll
    for (int b = 0; b < 2; ++b)
#pragma unroll
      for (int m = 0; m < 4; ++m)
#pragma unroll
        for (int n = 0; n < 2; ++n) acc[a][b][m][n] = (f32x4){0.f, 0.f, 0.f, 0.f};
  const char* cA = (const char*)Ag + (size_t)cpm * tstep; const char* cB = (const char*)Btg + (size_t)cpn * tstep;
  G_STAGE(G_SB(0, 0), cB, voffB); G_STAGE(G_SA(0, 0), cA, voffA); G_STAGE(G_SB(0, 1), cB + hstep, voffB); G_STAGE(G_SA(0, 1), cA + hstep, voffA);
  if (wr == 1) G_BAR;
  G_WAIT_V(4); G_BAR;
  G_STAGE(G_SB(1, 0), cB + kstep, voffB); G_STAGE(G_SA(1, 0), cA + kstep, voffA); G_STAGE(G_SB(1, 1), cB + hstep + kstep, voffB);
  G_WAIT_V(6); G_BAR;
  for (;;) {
    const bool has_next = unit_next(ui + 1, nM, nN, npm, npn);
    const char* nA = has_next ? (const char*)Ag + (size_t)npm * tstep : cA; const char* nB = has_next ? (const char*)Btg + (size_t)npn * tstep : cB;
    for (int t = 0; t < nt; t += 2) {
      const bool last = (t == nt - 2);
      const char* a1 = cA + (size_t)(t + 1) * kstep;
      const char* a2 = last ? nA : cA + (size_t)(t + 2) * kstep; const char* b2 = last ? nB : cB + (size_t)(t + 2) * kstep;
      const char* a3 = a2 + kstep; const char* b3 = b2 + kstep;
      G_LDB(B0, 0, 0); G_SCHED; G_LDA(At, 0, 0); G_STAGE(G_SA(1, 1), a1 + hstep, voffA);
      G_WAIT_L(8); G_BAR; G_WAIT_L(0); G_MMA(0, 0, At, B0); G_BAR; G_SCHED;
      G_LDB(B1, 0, 1); G_STAGE(G_SB(0, 0), b2, voffB);
      G_BAR; G_WAIT_L(0); G_MMA(0, 1, At, B1); G_BAR;
      G_LDA(At, 0, 1); G_STAGE(G_SA(0, 0), a2, voffA);
      G_BAR; G_WAIT_L(0); G_MMA(1, 0, At, B0); G_BAR; G_SCHED;
      G_STAGE(G_SB(0, 1), b2 + hstep, voffB);
      G_WAIT_V(6); G_BAR; G_MMA(1, 1, At, B1); G_BAR;
      G_LDB(B0, 1, 0); G_SCHED; G_LDA(At, 1, 0); G_STAGE(G_SA(0, 1), a2 + hstep, voffA);
      G_WAIT_L(8); G_BAR; G_WAIT_L(0); G_MMA(0, 0, At, B0); G_BAR; G_SCHED;
      G_LDB(B1, 1, 1); G_STAGE(G_SB(1, 0), b3, voffB);
      G_BAR; G_WAIT_L(0); G_MMA(0, 1, At, B1); G_BAR;
      G_LDA(At, 1, 1); G_STAGE(G_SA(1, 0), a3, voffA);
      G_BAR; G_WAIT_L(0); G_MMA(1, 0, At, B0); G_BAR; G_SCHED;
      G_STAGE(G_SB(1, 1), b3 + hstep, voffB);
      G_WAIT_V(6); G_BAR; G_MMA(1, 1, At, B1); G_BAR;
    }
    if (!single) {
      gemm_epi(p, mode, coef, acc, cpm, cpn, wr, wc, fr, fq);
      if (!has_next) break;
    } else {
      if (!has_next) G_WAIT_V(0);
      if (wr == 0) G_BAR;
      if (!has_next) G_BAR;
      fused_ln_epi(p, smem + 131072, coef, acc, cpm, cpn, wr, wc, fr, fq, tid, lnk, lng, lnb);
      if (!has_next) break;
      if (wr == 1) G_BAR;
    }
#pragma unroll
    for (int a = 0; a < 2; ++a)
#pragma unroll
      for (int b = 0; b < 2; ++b)
#pragma unroll
        for (int m = 0; m < 4; ++m)
#pragma unroll
          for (int n = 0; n < 2; ++n) acc[a][b][m][n] = (f32x4){0.f, 0.f, 0.f, 0.f};
    cpm = npm; cpn = npn; cA = nA; cB = nB; ++ui;
  }
  if (!single) {
    G_WAIT_V(0);
    if (wr == 0) G_BAR;
    G_BAR;
  }
  break;
  }
#undef G_SA
#undef G_SB
#undef G_STAGE
#undef G_LDA
#undef G_LDB
#undef G_MMA
}

DI float gelu_tanh(float x) {
  float u = 0.7978845608028654f * (x + 0.044715f * x * x * x);
  return 0.5f * x * (1.f + tanhf(u));
}

DI void compress_phase(const Params& p, char* smem, int l) {
  const int tid = get_tid(), w = tid >> 6, lane = tid & 63, fr = lane & 15, fq = lane >> 4;
  float* hid = (float*)smem;
  char* ws = launder_ptr(p.ws);
  char* mb = layer_w(ws, l) + 2 * (SZ_WGU + SZ_WD);
  for (int item = blockIdx.x; item < 512; item += gridDim.x) {
    const int kv = item & 1, ct = (item >> 1) & 15, bg = item >> 5;
    const u16* src = (const u16*)(ws + OFF_SEG + (size_t)kv * SZ_SEG) + (size_t)bg * S * 64;
    const u16* w1t = (const u16*)(mb + 4194304 + 2097152 + (size_t)kv * 524288);
    const float* w2 = p.in[kv ? 17 : 13] + (size_t)l * 128 * 64;
    const float* b1p = (const float*)(ws + OFF_B1P) + (l * 2 + kv) * 128;
    const int c0 = ct * 16;
    int cr = c0 + fr; if (cr > 254) cr = 254;
    const u16* ap = src + (size_t)cr * 16 * 64 + fq * 8;
    const u16* bp = w1t + (size_t)(w * 16 + fr) * 2048 + fq * 8;
    f32x4 acc = {0.f, 0.f, 0.f, 0.f};
#pragma unroll 16
    for (int kk = 0; kk < 64; ++kk) {
      bf16x8 a = *(const bf16x8*)(ap + kk * 32);
      bf16x8 bb = *(const bf16x8*)(bp + kk * 32);
      acc = __builtin_amdgcn_mfma_f32_16x16x32_bf16(a, bb, acc, 0, 0, 0);
    }
    __syncthreads();
#pragma unroll
    for (int j = 0; j < 4; ++j) {
      int col = w * 16 + fr;
      hid[(fq * 4 + j) * 128 + col] = gelu_tanh(acc[j] + b1p[col]);
    }
    __syncthreads();
#pragma unroll
    for (int e = 0; e < 2; ++e) {
      int o = tid + e * 512, r = o >> 6, d = o & 63;
      float s = 0.f;
      for (int k = 0; k < 128; ++k) s += hid[r * 128 + k] * w2[k * 64 + d];
      int c = c0 + r;
      if (c < 255) {
        if (kv == 0) ((u16*)(ws + OFF_KCMP))[((size_t)bg * 256 + c) * 64 + d] = f2bf(s);
        else ((u16*)(ws + OFF_VCMPT))[((size_t)bg * 256 + c) * 64 + d] = f2bf(s);
      }
    }
  }
}

template <int KS>
DI f32x16 qk_tile(const u16* Ksub, const bf16x8* qf, int ql, int h, float init = 0.f) {
  f32x16 s;
#pragma unroll
  for (int i = 0; i < 16; ++i) s[i] = init;
#pragma unroll
  for (int ks = 0; ks < 4; ++ks) {
    bf16x8 a = *(const bf16x8*)(Ksub + ql * KS + ks * 16 + h * 8);
    s = mfma32(a, qf[ks], s);
  }
  return s;
}
template <int KS>
DI f32x16 qk_tile_lds(const u16* Ksub, const u16* Qsub, int ql, int h, float init) {
  f32x16 s;
#pragma unroll
  for (int i = 0; i < 16; ++i) s[i] = init;
#pragma unroll
  for (int ks = 0; ks < 4; ++ks) {
    bf16x8 a = *(const bf16x8*)(Ksub + ql * KS + ks * 16 + h * 8);
    bf16x8 b = *(const bf16x8*)(Qsub + ql * KS + ks * 16 + h * 8);
    s = mfma32(a, b, s);
  }
  return s;
}
DI s16x4 tr_read(const u16* ptr) { return __builtin_amdgcn_ds_read_tr16_b64_v4i16((LAS s16x4*)ptr); }
template <int NMB, int VS>
DI void pv_tile(const u16* vsub, const bf16x8* pf, f32x16* O, int lane) {
  const int l16 = lane & 15, q = l16 >> 2, pp = l16 & 3, blk = (lane >> 4) & 1, h = lane >> 5;
  const u16* base = vsub + (4 * h + q) * VS + 16 * blk + 4 * pp;
#pragma unroll
  for (int mb = 0; mb < NMB; ++mb)
#pragma unroll
    for (int s2 = 0; s2 < 2; ++s2) {
      s16x4 lo = tr_read(base + (16 * s2) * VS + mb * 32);
      s16x4 hi = tr_read(base + (16 * s2 + 8) * VS + mb * 32);
      bf16x8 a = __builtin_shufflevector(lo, hi, 0, 1, 2, 3, 4, 5, 6, 7);
      O[mb] = mfma32(a, pf[s2], O[mb]);
    }
}
template <int VS>
DI void pv_load(const u16* vsub, bf16x8* vf, int lane) {
  const int l16 = lane & 15, q = l16 >> 2, pp = l16 & 3, blk = (lane >> 4) & 1, h = lane >> 5;
  const u16* base = vsub + (4 * h + q) * VS + 16 * blk + 4 * pp;
#pragma unroll
  for (int mb = 0; mb < 2; ++mb)
#pragma unroll
    for (int s2 = 0; s2 < 2; ++s2) {
      s16x4 lo = tr_read(base + (16 * s2) * VS + mb * 32);
      s16x4 hi = tr_read(base + (16 * s2 + 8) * VS + mb * 32);
      vf[mb * 2 + s2] = __builtin_shufflevector(lo, hi, 0, 1, 2, 3, 4, 5, 6, 7);
    }
}
DI void pv_mma(const bf16x8* vf, const bf16x8* pf, f32x16* O) {
#pragma unroll
  for (int mb = 0; mb < 2; ++mb)
#pragma unroll
    for (int s2 = 0; s2 < 2; ++s2) O[mb] = mfma32(vf[mb * 2 + s2], pf[s2], O[mb]);
}
template <int KS>
DI void k_load8(const u16* Kt, bf16x8* kf, int ql, int h) {
#pragma unroll
  for (int sub = 0; sub < 2; ++sub)
#pragma unroll
    for (int ks = 0; ks < 4; ++ks) kf[sub * 4 + ks] = *(const bf16x8*)(Kt + (sub * 32 + ql) * KS + ks * 16 + h * 8);
}
DI f32x16 qk_mma(const bf16x8* kf, const bf16x8* qf, float init) {
  f32x16 s;
#pragma unroll
  for (int i = 0; i < 16; ++i) s[i] = init;
#pragma unroll
  for (int ks = 0; ks < 4; ++ks) s = mfma32(kf[ks], qf[ks], s);
  return s;
}
template <int VS>
DI void v_load8(const u16* Vt, bf16x8* vf, int lane) {
  const int l16 = lane & 15, q = l16 >> 2, pp = l16 & 3, blk = (lane >> 4) & 1, h = lane >> 5;
  const u16* base = Vt + (4 * h + q) * VS + 16 * blk + 4 * pp;
#pragma unroll
  for (int sub = 0; sub < 2; ++sub)
#pragma unroll
    for (int mb = 0; mb < 2; ++mb)
#pragma unroll
      for (int s2 = 0; s2 < 2; ++s2) {
        s16x4 lo = tr_read(base + (sub * 32 + 16 * s2) * VS + mb * 32);
        s16x4 hi = tr_read(base + (sub * 32 + 16 * s2 + 8) * VS + mb * 32);
        vf[sub * 4 + mb * 2 + s2] = __builtin_shufflevector(lo, hi, 0, 1, 2, 3, 4, 5, 6, 7);
      }
}
DI void pv_mma8(const bf16x8* vf, const bf16x8* pf, f32x16* O) {
#pragma unroll
  for (int sub = 0; sub < 2; ++sub)
#pragma unroll
    for (int mb = 0; mb < 2; ++mb)
#pragma unroll
      for (int s2 = 0; s2 < 2; ++s2) O[mb] = mfma32(vf[sub * 4 + mb * 2 + s2], pf[sub * 2 + s2], O[mb]);
}
constexpr float NINF = -__builtin_inff();
template <bool MASK>
DI bool softmax_step(f32x16& s, int kbase, int lo, int hi, float& m, float& l, float& alpha, bf16x8* pf, int lane) {
  if (MASK) {
#pragma unroll
    for (int i = 0; i < 16; ++i) {
      int kp = kbase + (i & 3) + 8 * (i >> 2);
      s[i] = ((kp > lo) && (kp <= hi)) ? s[i] : NINF;
    }
  }
  float mx = fmaxf(fmaxf(s[0], s[1]), s[2]);
#pragma unroll
  for (int i = 3; i < 15; i += 2) mx = fmaxf(fmaxf(mx, s[i]), s[i + 1]);
  mx = fmaxf(mx, s[15]);
  const bool need = __any(mx > 8.f);
  alpha = 1.f;
  if (need) {
    mx = fmaxf(mx, shx(mx, 32, lane));
    const float d = fmaxf(mx, 0.f);
    alpha = __builtin_amdgcn_exp2f(-d);
    l *= alpha;
    m += d;
#pragma unroll
    for (int i = 0; i < 16; ++i) s[i] -= d;
  }
  float rs = 0.f;
#pragma unroll
  for (int i = 0; i < 16; ++i) {
    float pv = __builtin_amdgcn_exp2f(s[i]);
    s[i] = pv; rs += pv;
  }
  l += rs;
#pragma unroll
  for (int s2 = 0; s2 < 2; ++s2) {
    unsigned u[4];
#pragma unroll
    for (int j = 0; j < 4; ++j) u[j] = pack2(s[8 * s2 + 2 * j], s[8 * s2 + 2 * j + 1]);
    pf[s2] = __builtin_bit_cast(bf16x8, *(uint4*)u);
  }
  return need;
}

template <bool MASK>
DI bool softmax_step64(f32x16& s0, f32x16& s1, int kbase, int lo, int hi, float& m, float& l, float& alpha, bf16x8* pf, int lane) {
  if (MASK) {
#pragma unroll
    for (int i = 0; i < 16; ++i) {
      int kp = kbase + (i & 3) + 8 * (i >> 2);
      s0[i] = ((kp > lo) && (kp <= hi)) ? s0[i] : NINF;
      s1[i] = ((kp + 32 > lo) && (kp + 32 <= hi)) ? s1[i] : NINF;
    }
  }
  float mx = fmaxf(s0[0], s1[0]);
#pragma unroll
  for (int i = 1; i < 16; ++i) mx = fmaxf(fmaxf(mx, s0[i]), s1[i]);
  const bool need = __any(mx > 8.f);
  alpha = 1.f;
  if (need) {
    mx = fmaxf(mx, shx(mx, 32, lane));
    const float d = fmaxf(mx, 0.f);
    alpha = __builtin_amdgcn_exp2f(-d);
    l *= alpha;
    m += d;
#pragma unroll
    for (int i = 0; i < 16; ++i) { s0[i] -= d; s1[i] -= d; }
  }
  float rs0 = 0.f, rs1 = 0.f;
#pragma unroll
  for (int i = 0; i < 16; ++i) {
    float p0 = __builtin_amdgcn_exp2f(s0[i]), p1 = __builtin_amdgcn_exp2f(s1[i]);
    s0[i] = p0; s1[i] = p1; rs0 += p0; rs1 += p1;
  }
  l += rs0 + rs1;
#pragma unroll
  for (int s2 = 0; s2 < 2; ++s2) {
    unsigned u[4], v[4];
#pragma unroll
    for (int j = 0; j < 4; ++j) { u[j] = pack2(s0[8 * s2 + 2 * j], s0[8 * s2 + 2 * j + 1]); v[j] = pack2(s1[8 * s2 + 2 * j], s1[8 * s2 + 2 * j + 1]); }
    pf[s2] = __builtin_bit_cast(bf16x8, *(uint4*)u);
    pf[2 + s2] = __builtin_bit_cast(bf16x8, *(uint4*)v);
  }
  return need;
}

constexpr int KST = 72, VST = 96, VDS = 160;

DI void nsa_load_q(const u16* qbase, long row, int hq, int h, bf16x8* qf) {
#pragma unroll
  for (int ks = 0; ks < 4; ++ks) qf[ks] = *(const bf16x8*)(qbase + row * D + hq * 64 + ks * 16 + h * 8);
}

DI void nsa_attn_phase(const Params& p, char* smem) {
  const int tid0 = get_tid();
  u16* Kb = (u16*)smem;
  u16* Vb = Kb + 2 * 64 * KST;
  u16* Kc = Vb + 2 * 64 * VST;
  u16* Vc = Kc + 256 * KST;
  unsigned* imp = (unsigned*)(Vc + 256 * VST);
  u64* sel = (u64*)(imp + 32 * 65);
  unsigned* uni = (unsigned*)(sel + 32);
  char* ws = launder_ptr(p.ws);
  const u16* KS_g = (const u16*)(ws + OFF_SEG + 2 * SZ_SEG);
  const u16* VS_g = (const u16*)(ws + OFF_SEG + 3 * SZ_SEG);
  const u16* KW_g = (const u16*)(ws + OFF_SEG + 4 * SZ_SEG);
  const u16* VW_g = (const u16*)(ws + OFF_SEG + 5 * SZ_SEG);
  const float* gates = (const float*)(ws + OFF_GATES);
  u16* Oout = (u16*)(ws + OFF_PROJ);

  for (int item = blockIdx.x; item < 2048; item += gridDim.x) {
    const int rnd = item >> 8, j256 = item & 255;
    int tid = tid0; asm volatile("" : "+v"(tid));
    const int w = tid >> 6, lane = tid & 63, ql = lane & 31, h = lane >> 5;
    const int bg = j256 & 15, k16 = j256 >> 4;
    const int tile = rnd * 16 + ((rnd & 1) ? 15 - k16 : k16);
    const int b = bg >> 1, g = bg & 1;
    const int t0 = tile * 32, t = t0 + ql, hq = g * 8 + w;
    const long row = (long)b * S + t;
    const int cur = t0 >> 6;

    __syncthreads();
    const int tidi = tid;
    const int ntc = (t0 >> 9) + 1, nc = ntc * 32;
    for (int i = tidi; i < 32 * 65; i += NTHR) imp[i] = 0;
    if (tidi < 2) uni[tidi] = 0;
    bf16x8 qf[4];
    nsa_load_q((const u16*)(ws + OFF_PROJ), row, hq, h, qf);
    const int lr = tid >> 3, lch = tid & 7;
    uint4 kreg, vreg;
    const float gr0 = gates[row * 48 + hq], gr1 = gates[row * 48 + 16 + hq], gr2 = gates[row * 48 + 32 + hq];
    const float g0 = __builtin_amdgcn_rcpf(1.f + __expf(-gr0)), g1 = __builtin_amdgcn_rcpf(1.f + __expf(-gr1)), g2 = __builtin_amdgcn_rcpf(1.f + __expf(-gr2));
    {
      const u16* kcg = (const u16*)(ws + OFF_KCMP) + (size_t)bg * 256 * 64;
      const u16* vcg = (const u16*)(ws + OFF_VCMPT) + (size_t)bg * 256 * 64;
      uint4 kc4[4], vc4[4];
#pragma unroll
      for (int j = 0; j < 4; ++j) {
        const int i = tidi + j * NTHR;
        kc4[j] = *(const uint4*)(kcg + (i >> 3) * 64 + (i & 7) * 8); vc4[j] = *(const uint4*)(vcg + (i >> 3) * 64 + (i & 7) * 8);
      }
#pragma unroll
      for (int j = 0; j < 4; ++j) {
        const int i = tidi + j * NTHR;
        if (i < nc * 8) { *(uint4*)(Kc + (i >> 3) * KST + (i & 7) * 8) = kc4[j]; *(uint4*)(Vc + (i >> 3) * VST + (i & 7) * 8) = vc4[j]; }
      }
    }
    __syncthreads();

    f32x16 O[2];
    unsigned outp[16];
    bf16x8 pf[4];
    const int cmaxq = (t >= 31) ? ((t - 31) >> 4) : -1;
    float m = NEGF, l = 0.f;
    for (int ct = 0; ct < ntc; ++ct) {
      f32x16 s = qk_tile<KST>(Kc + ct * 32 * KST, qf, ql, h);
      float mx = NEGF;
#pragma unroll
      for (int i = 0; i < 16; ++i) {
        int c = ct * 32 + 4 * h + (i & 3) + 8 * (i >> 2);
        s[i] = (c <= cmaxq) ? s[i] : NEGF;
        mx = fmaxf(mx, s[i]);
      }
      mx = fmaxf(mx, shx(mx, 32, lane));
      const float mn = fmaxf(m, mx);
      float rs = 0.f;
#pragma unroll
      for (int i = 0; i < 16; ++i) rs += (s[i] > -1e29f) ? __builtin_amdgcn_exp2f(s[i] - mn) : 0.f;
      rs += shx(rs, 32, lane);
      l = l * __builtin_amdgcn_exp2f(m - mn) + rs;
      m = mn;
    }
    const float invl = (l > 0.f) ? 1.f / l : 0.f;
#pragma unroll
    for (int mb = 0; mb < 2; ++mb)
#pragma unroll
      for (int i = 0; i < 16; ++i) O[mb][i] = 0.f;
    for (int ct = 0; ct < ntc; ++ct) {
      f32x16 s = qk_tile<KST>(Kc + ct * 32 * KST, qf, ql, h);
#pragma unroll
      for (int i = 0; i < 16; ++i) {
        int c = ct * 32 + 4 * h + (i & 3) + 8 * (i >> 2);
        s[i] = (c <= cmaxq) ? __builtin_amdgcn_exp2f(s[i] - m) * invl : 0.f;
      }
#pragma unroll
      for (int a = 0; a < 4; ++a) {
        int n = ct * 8 + 2 * a + h;
        float mainv = s[4 * a] + s[4 * a + 1] + s[4 * a + 2] + 0.5f * s[4 * a + 3];
        float carry = 0.5f * s[4 * a + 3];
        unsigned um = (unsigned)(mainv * 16777216.f + 0.5f), uc = (unsigned)(carry * 16777216.f + 0.5f);
        if (um) atomicAdd(&imp[ql * 65 + n], um);
        if (uc && n < 63) atomicAdd(&imp[ql * 65 + n + 1], uc);
      }
#pragma unroll
      for (int s2 = 0; s2 < 2; ++s2) {
        unsigned u[4];
#pragma unroll
        for (int j = 0; j < 4; ++j) u[j] = pack2(s[8 * s2 + 2 * j], s[8 * s2 + 2 * j + 1]);
        pf[s2] = __builtin_bit_cast(bf16x8, *(uint4*)u);
      }
      pv_tile<2, VST>(Vc + ct * 32 * VST, pf, O, lane);
    }
#pragma unroll
    for (int mb = 0; mb < 2; ++mb)
#pragma unroll
      for (int i = 0; i < 16; i += 2) outp[mb * 8 + (i >> 1)] = pack2(g0 * O[mb][i], g0 * O[mb][i + 1]);
    __syncthreads();
    for (int qq = 0; qq < 4; ++qq) {
      const int q = w * 4 + qq;
      unsigned v = imp[q * 65 + lane];
      const bool valid = lane <= cur;
      const bool forced = (lane == 0) || (lane == cur) || (lane == cur - 1);
      if (forced) v += (1u << 30);
      int rank = 0;
      for (int mth = 0; mth <= cur; ++mth) {
        unsigned vm = __builtin_amdgcn_readlane(v, mth);
        rank += (vm > v || (vm == v && mth < lane)) ? 1 : 0;
      }
      u64 msk = __ballot(valid && rank < 16);
      if (lane == 0) { sel[q] = msk; atomicOr(&uni[0], (unsigned)msk); atomicOr(&uni[1], (unsigned)(msk >> 32)); }
    }
    __syncthreads();
    const u64 selq = sel[ql];
    const u64 unim = ((u64)uni[1] << 32) | uni[0];
    nsa_load_q((const u16*)(ws + OFF_QR), row, hq, h, qf);

    for (int br = 1; br <= 2; ++br) {
      const u16* Kg = (br == 1 ? KS_g : KW_g) + (size_t)bg * S * 64;
      const u16* Vg = (br == 1 ? VS_g : VW_g) + (size_t)bg * S * 64;
      u64 tm;
      if (br == 1) tm = unim;
      else {
        int first = (t0 - 512) >> 6; if (first < 0) first = 0;
        tm = (~0ull >> (63 - cur)) & (~0ull << first);
      }
      m = 0.f; l = 0.f;
#pragma unroll
      for (int mb = 0; mb < 2; ++mb)
#pragma unroll
        for (int i = 0; i < 16; ++i) O[mb][i] = 0.f;
#define NSA_LD(KP, VP, nt) do { kreg = *(const uint4*)((KP) + (size_t)((nt) * 64 + lr) * 64 + lch * 8); \
                               vreg = *(const uint4*)((VP) + (size_t)((nt) * 64 + lr) * 64 + lch * 8); } while (0)
#define NSA_ST(bb) do { *(uint4*)(Kb + (bb) * 64 * KST + lr * KST + lch * 8) = kreg; *(uint4*)(Vb + (bb) * 64 * VST + lr * VST + lch * 8) = vreg; } while (0)
      int buf = 0;
      int n = __builtin_ctzll(tm);
      tm &= tm - 1;
      if (br == 1) NSA_LD(Kg, Vg, n);
      NSA_ST(0);
      int n1 = -1;
      if (tm) { n1 = __builtin_ctzll(tm); tm &= tm - 1; NSA_LD(Kg, Vg, n1); }
      bool wpre = false;
      __syncthreads();
      for (;;) {
        int n2 = -1;
        if (n1 >= 0) {
          NSA_ST(buf ^ 1);
          if (tm) { n2 = __builtin_ctzll(tm); tm &= tm - 1; NSA_LD(Kg, Vg, n2); }
        }
        if (br == 1 && n2 < 0 && !wpre) {
          int wf = (t0 - 512) >> 6; if (wf < 0) wf = 0;
          NSA_LD(KW_g + (size_t)bg * S * 64, VW_g + (size_t)bg * S * 64, wf);
          wpre = true;
        }
        const u16* Kt = Kb + buf * 64 * KST;
        const u16* Vt = Vb + buf * 64 * VST;
        int lo, hi = t;
        const bool lsel = (selq >> n) & 1;
        lo = (br == 1) ? -1 : t - 512;
        {
          const int kp0 = n * 64;
          const float init = (br == 2 || lsel) ? -m : NINF;
          bf16x8 fr8[8];
          k_load8<KST>(Kt, fr8, ql, h);
          f32x16 s0 = qk_mma(fr8, qf, init);
          f32x16 s1 = qk_mma(fr8 + 4, qf, init);
          pv_load<VST>(Vt, fr8, lane);
          float alpha; bool need;
          const bool interior = (kp0 + 63 <= t0) && (br == 1 || kp0 > t0 + 31 - 512);
          if (!interior) need = softmax_step64<true>(s0, s1, kp0 + 4 * h, lo, hi, m, l, alpha, pf, lane);
          else need = softmax_step64<false>(s0, s1, 0, 0, 0, m, l, alpha, pf, lane);
          if (need) {
#pragma unroll
            for (int mb = 0; mb < 2; ++mb)
#pragma unroll
              for (int i = 0; i < 16; ++i) O[mb][i] *= alpha;
          }
          pv_mma(fr8, pf, O);
          pv_load<VST>(Vt + 32 * VST, fr8 + 4, lane);
          pv_mma(fr8 + 4, pf + 2, O);
        }
        __syncthreads();
        if (n1 < 0) break;
        n = n1; n1 = n2; buf ^= 1;
      }
#undef NSA_LD
#undef NSA_ST
      l += shx(l, 32, lane);
      const float sc = (br == 1 ? g1 : g2) * ((l > 0.f) ? 1.f / l : 0.f);
#pragma unroll
      for (int mb = 0; mb < 2; ++mb)
#pragma unroll
        for (int i = 0; i < 16; i += 2) {
          const unsigned pk = outp[mb * 8 + (i >> 1)];
          const float a0 = sc * O[mb][i] + __uint_as_float(pk << 16), a1 = sc * O[mb][i + 1] + __uint_as_float(pk & 0xffff0000u);
          if (br == 1) outp[mb * 8 + (i >> 1)] = pack2(a0, a1);
          else { O[mb][i] = a0; O[mb][i + 1] = a1; }
        }
    }
#pragma unroll
    for (int mb = 0; mb < 2; ++mb)
#pragma unroll
      for (int a = 0; a < 4; ++a) {
        uint2 o; o.x = pack2(O[mb][4 * a], O[mb][4 * a + 1]); o.y = pack2(O[mb][4 * a + 2], O[mb][4 * a + 3]);
        *(uint2*)(Oout + row * D + hq * 64 + mb * 32 + 8 * a + 4 * h) = o;
      }
  }
}

DI void diff_attn_phase(const Params& p, char* smem, int j) {
  const int tid = get_tid(), w = tid >> 6, lane = tid & 63, ql = lane & 31, h = lane >> 5;
  char* ws = launder_ptr(p.ws);
  u16* K1b = (u16*)smem;
  u16* K2b = K1b + 2 * 64 * KST;
  u16* Vb = K2b + 2 * 64 * KST;
  u16* Qs = Vb + 2 * 64 * VDS + w * (2 * 32 * KST);
  const int layer = 2 + j;
  const float lambda_init = (layer == 2) ? 0.47071301834f : 0.55605820415f;
  float lam;
  {
    float a = p.in[21][j * 64 + lane] * p.in[22][j * 64 + lane];
    float c = p.in[23][j * 64 + lane] * p.in[24][j * 64 + lane];
#pragma unroll
    for (int o = 32; o > 0; o >>= 1) { a += shx(a, o, lane); c += shx(c, o, lane); }
    lam = expf(a) - expf(c) + lambda_init;
  }
  const u16* QD = (const u16*)(ws + OFF_PROJ);
  u16* Oout = (u16*)(ws + OFF_QR);
  const float* sg = p.in[25] + j * 128;

  for (int item = blockIdx.x; item < 1024; item += gridDim.x) {
    const int rnd = item >> 8, j256 = item & 255;
    const int bh = j256 & 63, kq = j256 >> 6;
    const int qb = (rnd == 0) ? kq : (rnd == 1) ? 15 - kq : (rnd == 2) ? 4 + kq : 11 - kq;
    const int b = bh >> 3, hd = bh & 7;
    const int t0 = qb * 256 + w * 32, t = t0 + ql;
    const long row = (long)b * S + t;
    const u16* K1g = (const u16*)(ws + OFF_KD) + ((size_t)((b * 2 + 0) * 8 + hd)) * S * 64;
    const u16* K2g = (const u16*)(ws + OFF_KD) + ((size_t)((b * 2 + 1) * 8 + hd)) * S * 64;
    const u16* Vg = (const u16*)(ws + OFF_VD) + ((size_t)(b * 8 + hd)) * S * 128;
#pragma unroll
    for (int ks = 0; ks < 4; ++ks) {
      bf16x8 qa = *(const bf16x8*)(QD + row * D + hd * 64 + ks * 16 + h * 8);
      bf16x8 qb2 = *(const bf16x8*)(QD + row * D + 512 + hd * 64 + ks * 16 + h * 8);
      *(bf16x8*)(Qs + ql * KST + ks * 16 + h * 8) = qa;
      *(bf16x8*)(Qs + 32 * KST + ql * KST + ks * 16 + h * 8) = qb2;
    }
    f32x16 O1[4], O2[4];
#pragma unroll
    for (int mb = 0; mb < 4; ++mb)
#pragma unroll
      for (int i = 0; i < 16; ++i) { O1[mb][i] = 0.f; O2[mb][i] = 0.f; }
    float m1 = 0.f, l1 = 0.f, m2 = 0.f, l2 = 0.f;
    const int ntile = (qb + 1) * 4;
    const int lr = tid >> 3, lch = tid & 7;
    uint4 k1r, k2r;
    __syncthreads();
    {
      k1r = *(const uint4*)(K1g + (size_t)lr * 64 + lch * 8);
      k2r = *(const uint4*)(K2g + (size_t)lr * 64 + lch * 8);
      *(uint4*)(K1b + lr * KST + lch * 8) = k1r;
      *(uint4*)(K2b + lr * KST + lch * 8) = k2r;
      k1r = *(const uint4*)(Vg + (size_t)lr * 128 + lch * 8);
      k2r = *(const uint4*)(Vg + (size_t)lr * 128 + 64 + lch * 8);
      *(uint4*)(Vb + lr * VDS + lch * 8) = k1r;
      *(uint4*)(Vb + lr * VDS + 64 + lch * 8) = k2r;
      if (ntile > 1) {
        k1r = *(const uint4*)(Vg + (size_t)(64 + lr) * 128 + lch * 8);
        k2r = *(const uint4*)(Vg + (size_t)(64 + lr) * 128 + 64 + lch * 8);
      }
    }
    __syncthreads();
    int buf = 0;
    for (int n = 0; n < ntile; ++n) {
      const bool more = (n + 1 < ntile);
      if (more) {
        const int nb = buf ^ 1, k0 = (n + 1) * 64;
        *(uint4*)(Vb + nb * 64 * VDS + lr * VDS + lch * 8) = k1r;
        *(uint4*)(Vb + nb * 64 * VDS + lr * VDS + 64 + lch * 8) = k2r;
        k1r = *(const uint4*)(K1g + (size_t)(k0 + lr) * 64 + lch * 8);
        k2r = *(const uint4*)(K2g + (size_t)(k0 + lr) * 64 + lch * 8);
      }
      const u16* K1t = K1b + buf * 64 * KST;
      const u16* K2t = K2b + buf * 64 * KST;
      const u16* Vt = Vb + buf * 64 * VDS;
#pragma unroll
      for (int sub = 0; sub < 2; ++sub) {
        if (sub == 1 && more) {
          const int nb = buf ^ 1, k0 = (n + 2) * 64;
          *(uint4*)(K1b + nb * 64 * KST + lr * KST + lch * 8) = k1r;
          *(uint4*)(K2b + nb * 64 * KST + lr * KST + lch * 8) = k2r;
          if (n + 2 < ntile) {
            k1r = *(const uint4*)(Vg + (size_t)(k0 + lr) * 128 + lch * 8);
            k2r = *(const uint4*)(Vg + (size_t)(k0 + lr) * 128 + 64 + lch * 8);
          }
        }
        const int kp0 = n * 64 + sub * 32;
        if (kp0 > t0 + 31) continue;
        bf16x8 pf1[2], pf2[2];
        {
          f32x16 sA = qk_tile_lds<KST>(K1t + sub * 32 * KST, Qs, ql, h, -m1);
          f32x16 sB = qk_tile_lds<KST>(K2t + sub * 32 * KST, Qs + 32 * KST, ql, h, -m2);
          float alpha1, alpha2; bool need1, need2;
          if (kp0 + 31 <= t0) {
            need1 = softmax_step<false>(sA, 0, 0, 0, m1, l1, alpha1, pf1, lane);
            need2 = softmax_step<false>(sB, 0, 0, 0, m2, l2, alpha2, pf2, lane);
          } else {
            need1 = softmax_step<true>(sA, kp0 + 4 * h, -1, t, m1, l1, alpha1, pf1, lane);
            need2 = softmax_step<true>(sB, kp0 + 4 * h, -1, t, m2, l2, alpha2, pf2, lane);
          }
          if (need1 || need2) {
#pragma unroll
            for (int mb = 0; mb < 4; ++mb)
#pragma unroll
              for (int i = 0; i < 16; ++i) { O1[mb][i] *= alpha1; O2[mb][i] *= alpha2; }
          }
        }
        {
          const int l16 = lane & 15, tq = l16 >> 2, tp = l16 & 3, blk = (lane >> 4) & 1;
          const u16* vbase = Vt + (sub * 32 + 4 * h + tq) * VDS + 16 * blk + 4 * tp;
#pragma unroll
          for (int mb = 0; mb < 4; ++mb)
#pragma unroll
            for (int s2 = 0; s2 < 2; ++s2) {
              s16x4 lo = tr_read(vbase + (16 * s2) * VDS + mb * 32);
              s16x4 hi = tr_read(vbase + (16 * s2 + 8) * VDS + mb * 32);
              bf16x8 a = __builtin_shufflevector(lo, hi, 0, 1, 2, 3, 4, 5, 6, 7);
              O1[mb] = mfma32(a, pf1[s2], O1[mb]);
              O2[mb] = mfma32(a, pf2[s2], O2[mb]);
            }
        }
      }
      __syncthreads();
      buf ^= 1;
    }
    l1 += shx(l1, 32, lane); l2 += shx(l2, 32, lane);
    const float i1 = 1.f / l1, i2 = lam / l2;
    float ss = 0.f;
#pragma unroll
    for (int mb = 0; mb < 4; ++mb)
#pragma unroll
      for (int i = 0; i < 16; ++i) { float o = O1[mb][i] * i1 - O2[mb][i] * i2; O1[mb][i] = o; ss += o * o; }
    ss += shx(ss, 32, lane);
    const float rn = rsqrtf(ss * (1.f / 128.f) + 1e-5f) * (1.f - lambda_init);
#pragma unroll
    for (int mb = 0; mb < 4; ++mb)
#pragma unroll
      for (int a = 0; a < 4; ++a) {
        const int dv = mb * 32 + 8 * a + 4 * h;
        float4 gg = *(const float4*)(sg + dv);
        uint2 o;
        o.x = pack2(O1[mb][4 * a] * rn * gg.x, O1[mb][4 * a + 1] * rn * gg.y);
        o.y = pack2(O1[mb][4 * a + 2] * rn * gg.z, O1[mb][4 * a + 3] * rn * gg.w);
        *(uint2*)(Oout + row * D + hd * 128 + dv) = o;
      }
  }
}


#define XB_TMO      128
#define XB_XCNT(j)  (256  + 64 * (j))
#define XB_XSUB(j)  (1280 + 64 * (j))
#define XB_XGEN(j)  (2304 + 64 * (j))
#define XB_TOP      3328
#define XB_TOPGEN   3392
#define XCD_BAR_WORDS 3456
#define XB_SPIN_CAP (1u << 22)
DI unsigned xb_ld(unsigned* p) { return __hip_atomic_load(p, __ATOMIC_RELAXED, __HIP_MEMORY_SCOPE_AGENT); }
DI unsigned xb_add(unsigned* p, unsigned v) { return __hip_atomic_fetch_add(p, v, __ATOMIC_RELAXED, __HIP_MEMORY_SCOPE_AGENT); }
DI unsigned xb_xcc_id() { return (unsigned)__builtin_amdgcn_s_getreg((3 << 11) | 20) & 0xFu; }
#define XB_SPIN(cond, bar) do { unsigned _sp = 0; while (cond) { __builtin_amdgcn_s_sleep(1); \
    if ((++_sp & 255u) == 0u) { if (xb_ld(&(bar)[XB_TMO])) break; if (_sp > XB_SPIN_CAP) { atomicAdd(&(bar)[XB_TMO], 1u); break; } } } } while (0)
struct XcdBarrier { unsigned* bar; unsigned x; volatile LAS unsigned* st; };
DI XcdBarrier xcd_barrier_post(unsigned* bar, volatile LAS unsigned* st) {
  XcdBarrier b; b.bar = bar; b.x = xb_xcc_id(); b.st = st;
  if (get_tid() == 0) (void)xb_add(&bar[XB_XCNT(b.x)], 1u);
  return b;
}
DI void xcd_barrier_complete(unsigned* bar, unsigned x, unsigned& nloc, unsigned& nx) {
  const unsigned G = gridDim.x * gridDim.y * gridDim.z;
  unsigned sum, cnt, mine, sp = 0u;
  for (;;) {
    sum = 0u; cnt = 0u; mine = 0u;
#pragma unroll
    for (unsigned j = 0; j < 16; ++j) { const unsigned c = xb_ld(&bar[XB_XCNT(j)]); sum += c; cnt += (c > 0u) ? 1u : 0u; mine = (j == x) ? c : mine; }
    if (sum == G) break;
    __builtin_amdgcn_s_sleep(1);
    if ((++sp & 255u) == 0u) { if (xb_ld(&bar[XB_TMO])) break; if (sp > XB_SPIN_CAP) { atomicAdd(&bar[XB_TMO], 1u); break; } }
  }
  nloc = mine > 0u ? mine : 1u; nx = cnt > 0u ? cnt : 1u;
}
DI void xcd_barrier(const XcdBarrier& b) {
  asm volatile("s_waitcnt vmcnt(0)" ::: "memory");
  __syncthreads();
  if (get_tid() == 0) {
    unsigned* bar = b.bar;
    __builtin_amdgcn_s_waitcnt(0);
    unsigned nloc = b.st[0], nx = b.st[1];
    if (nloc == 0u) { xcd_barrier_complete(bar, b.x, nloc, nx); b.st[0] = nloc; b.st[1] = nx; }
    const unsigned old = xb_add(&bar[XB_XSUB(b.x)], 1u);
    const unsigned gen = old / nloc;
    if (old + 1u == (gen + 1u) * nloc) {
      __builtin_amdgcn_fence(__ATOMIC_RELEASE, "agent");
      asm volatile("s_waitcnt vmcnt(0)" ::: "memory");
      const unsigned og = xb_add(&bar[XB_TOP], 1u);
      const unsigned tg = og / nx;
      if (og + 1u == (tg + 1u) * nx) xb_add(&bar[XB_TOPGEN], 1u);
      else XB_SPIN(xb_ld(&bar[XB_TOPGEN]) == tg, bar);
      __builtin_amdgcn_fence(__ATOMIC_ACQUIRE, "agent");
      xb_add(&bar[XB_XGEN(b.x)], 1u);
      asm volatile("s_waitcnt vmcnt(0)" ::: "memory");
    } else {
      XB_SPIN(xb_ld(&bar[XB_XGEN(b.x)]) == gen, bar);
      __builtin_amdgcn_fence(__ATOMIC_ACQUIRE, "agent");
      asm volatile("s_waitcnt vmcnt(0)" ::: "memory");
    }
  }
  __syncthreads();
}

__global__ void __launch_bounds__(NTHR) mega(Params p, int ph_lo, int ph_hi, int coop) {
  extern __shared__ __attribute__((aligned(16))) char smem[];
  cg::grid_group grid = cg::this_grid();
  volatile LAS unsigned* xst = (volatile LAS unsigned*)(smem + SMEM_BYTES - 16);
  if (get_tid() == 0) { xst[0] = 0u; xst[1] = 0u; }
  __syncthreads();
  const XcdBarrier xb = xcd_barrier_post((unsigned*)(p.ws + OFF_BAR), xst);
  int ph = 0;
  if (ph_hi < 0) grid.sync();
  if (ph >= ph_lo && ph < ph_hi) { prep_phase(p, smem); if (coop && ph + 1 < ph_hi) xcd_barrier(xb); }
  ++ph;
  for (int l = 0; l < 4; ++l) {
    for (int st = 0; st < 12; ++st) {
      if (st == 4 && l >= 2) continue;
      if (st == 11 && l != 1) continue;
      if (st == 2 || st == 7 || st == 10) continue;
      if (ph >= ph_lo && ph < ph_hi) {
        char* wsl = launder_ptr(p.ws);
        char* wb = layer_w(wsl, l);
        char* mb = wb + 2 * (SZ_WGU + SZ_WD);
        const u16* XB = (const u16*)(wsl + OFF_XB);
        const u16* HB = (const u16*)(wsl + OFF_H);
        int kind = 0;
        const u16* A = XB; const u16* Bt = nullptr; int N = D, K = D, mode = EPI_RESID; float coef = 1.f; int lni = 0;
        switch (st) {
          case 0: Bt = (const u16*)wb; N = 2 * F; mode = EPI_GATEUP; break;
          case 1: A = HB; Bt = (const u16*)(wb + SZ_WGU); K = F; coef = 0.5f; lni = l * 3; break;
          case 2: kind = 1; lni = l * 3; break;
          case 3: Bt = (const u16*)mb; if (l < 2) { N = 2048; mode = EPI_NSA_IN; } else { mode = EPI_DIFF_Q; } break;
          case 4: kind = 2; break;
          case 5: kind = (l < 2) ? 3 : 4; break;
          case 6: A = (const u16*)(wsl + (l < 2 ? OFF_PROJ : OFF_QR)); Bt = (const u16*)(mb + (l < 2 ? 4194304 : 2097152)); lni = l * 3 + 1; break;
          case 7: kind = 1; lni = l * 3 + 1; break;
          case 8: Bt = (const u16*)(wb + SZ_WGU + SZ_WD); N = 2 * F; mode = EPI_GATEUP; break;
          case 9: A = HB; Bt = (const u16*)(wb + SZ_WGU + SZ_WD + SZ_WGU); K = F; coef = 0.5f; lni = l * 3 + 2; break;
          case 10: kind = 1; lni = l * 3 + 2; break;
          default: Bt = (const u16*)(wsl + OFF_WKV); N = 2048; mode = EPI_DIFF_KV; break;
        }
        if (kind == 0) gemm_phase(p, smem, A, Bt, N, K, mode, coef, lni, p.in[7] + (size_t)lni * D, p.in[8] + (size_t)lni * D);
        else if (kind == 2) compress_phase(p, smem, l);
        else if (kind == 3) nsa_attn_phase(p, smem);
        else diff_attn_phase(p, smem, l - 2);
        if (coop && ph + 1 < ph_hi) xcd_barrier(xb);
      }
      ++ph;
    }
  }
}

extern "C" void kernel_launch(void* const* d_in, const int* in_sizes, int n_in, void* d_out, int out_size, void* d_ws,
                              size_t ws_size, hipStream_t stream) {
  if (n_in < 27 || ws_size < WS_NEED) { fprintf(stderr, "bad args: n_in %d ws %zu need %zu\n", n_in, ws_size, (size_t)WS_NEED); return; }
  Params p{};
  for (int i = 0; i < 27; ++i) p.in[i] = (const float*)d_in[i];
  p.out = (float*)d_out;
  p.ws = (char*)d_ws;
  static int grid_blocks = 0;
  (void)hipFuncSetAttribute((const void*)mega, hipFuncAttributeMaxDynamicSharedMemorySize, SMEM_BYTES);
  if (!grid_blocks) {
    int dev = 0, cus = 0, per_cu = 0;
    (void)hipGetDevice(&dev);
    (void)hipDeviceGetAttribute(&cus, hipDeviceAttributeMultiprocessorCount, dev);
    (void)hipOccupancyMaxActiveBlocksPerMultiprocessor(&per_cu, mega, NTHR, SMEM_BYTES);
    if (per_cu < 1) per_cu = 1;
    grid_blocks = cus;
    if (grid_blocks % 8) grid_blocks -= grid_blocks % 8;
  }
  (void)hipMemsetAsync((char*)d_ws + OFF_BAR, 0, 16384 + 32768, stream);
  int lo = 0, hi = 1000, coop = 1;
  void* args[] = {&p, &lo, &hi, &coop};
  hipError_t e = hipLaunchCooperativeKernel((const void*)mega, dim3(grid_blocks), dim3(NTHR), args, SMEM_BYTES, stream);
  if (e != hipSuccess) fprintf(stderr, "cooperative launch failed: %s (grid %d)\n", hipGetErrorString(e), grid_blocks);
}
```

```cpp
#include <hip/hip_runtime.h>
#include <hip/hip_cooperative_groups.h>
#include <cstdio>
namespace cg = cooperative_groups;

#define DI __device__ __forceinline__
typedef unsigned short u16;
typedef unsigned long long u64;
using bf16x8 = __attribute__((ext_vector_type(8))) short;
using s16x4 = __attribute__((ext_vector_type(4))) short;
using f32x4 = __attribute__((ext_vector_type(4))) float;
using f32x16 = __attribute__((ext_vector_type(16))) float;
using f32x2 = __attribute__((ext_vector_type(2))) float;
using bf16v2 = __attribute__((ext_vector_type(2))) __bf16;

constexpr int NB = 8, S = 4096, M = NB * S, D = 1024, F = 2816;
constexpr int NTHR = 512;
constexpr int SMEM_BYTES = 155648;
constexpr float ALPHA = 1.681792830507429f;
constexpr float NEGF = -1e30f;

constexpr size_t OFF_XB = 0;
constexpr size_t OFF_H = 67108864;
constexpr size_t OFF_KV = OFF_H + 184549376;
constexpr size_t OFF_W = OFF_KV + 134217728;
constexpr size_t SZ_WGU = 11534336, SZ_WD = 5767168;
constexpr size_t LW_A = 41943040, LW_B = 38797312;
constexpr size_t OFF_WKV = OFF_W + 2 * LW_B;
constexpr size_t OFF_SEG = OFF_WKV + 4194304;
constexpr size_t SZ_SEG = 8388608;
constexpr size_t OFF_GATES = OFF_SEG + 6 * SZ_SEG;
constexpr size_t OFF_KCMP = OFF_GATES + 6291456;
constexpr size_t OFF_VCMPT = OFF_KCMP + 524288;
constexpr size_t OFF_ROPE = OFF_VCMPT + 524288;
constexpr size_t OFF_B1P = OFF_ROPE + 262144;
constexpr size_t OFF_BAR = OFF_B1P + 4096;
constexpr size_t OFF_CNT = OFF_BAR + 16384;
constexpr size_t OFF_SLOTS = OFF_CNT + 32768;
constexpr size_t WS_NEED = OFF_SLOTS + 1048576;
constexpr size_t OFF_PROJ = OFF_H;
constexpr size_t OFF_QR = OFF_H + 67108864;
constexpr size_t OFF_PARK = OFF_H + 134217728;
constexpr size_t OFF_KD = OFF_KV;
constexpr size_t OFF_VD = OFF_KV + 67108864;

struct Params {
  const float* in[27];
  float* out;
  char* ws;
};

struct Params;
typedef __attribute__((address_space(1))) char gchar_t;
DI char* launder_ptr(char* w) { gchar_t* g = (gchar_t*)w; asm volatile("" : "+s"(g)); return (char*)g; }
DI int get_tid() { int t = threadIdx.x; asm volatile("" : "+v"(t)); return t; }
DI float shx(float v, int mask, int lane) { return __int_as_float(__builtin_amdgcn_ds_bpermute((lane ^ mask) << 2, __float_as_int(v))); }
DI u16 f2bf(float x) { return __builtin_bit_cast(u16, (__bf16)x); }
DI unsigned pack2(float a, float b) {
  f32x2 v = {a, b};
  return __builtin_bit_cast(unsigned, __builtin_convertvector(v, bf16v2));
}
DI float bf2f(u16 v) { return __uint_as_float(((unsigned)v) << 16); }
DI f32x16 mfma32(bf16x8 a, bf16x8 b, f32x16 c) { return __builtin_amdgcn_mfma_f32_32x32x16_bf16(a, b, c, 0, 0, 0); }

DI char* layer_w(char* ws, int l) { return l < 2 ? ws + OFF_KV + (size_t)l * LW_A : ws + OFF_W + (size_t)(l - 2) * LW_B; }

struct Task { const float* src; u16* dst; int K, Nsrc, Ndst, mode; };
DI Task get_task(const Params& p, int task) {
  Task t; t.src = nullptr; t.dst = nullptr; t.K = 0; t.Nsrc = 0; t.Ndst = 0; t.mode = 0;
  if (task == 40) { t.src = p.in[19]; t.dst = (u16*)(p.ws + OFF_WKV); t.K = 1024; t.Nsrc = 2048; t.Ndst = 2048; return t; }
  int l = task / 10, k = task % 10;
  char* wb = layer_w(p.ws, l);
  if (k < 6) {
    int f2 = k / 3, kk = k % 3;
    const float* src = p.in[1 + f2 * 3 + kk];
    if (kk < 2) { t.src = src + (size_t)l * D * F; t.dst = (u16*)(wb + f2 * (SZ_WGU + SZ_WD)); t.K = D; t.Nsrc = F; t.Ndst = F; t.mode = 1 + kk; }
    else { t.src = src + (size_t)l * F * D; t.dst = (u16*)(wb + f2 * (SZ_WGU + SZ_WD) + SZ_WGU); t.K = F; t.Nsrc = D; t.Ndst = D; }
    return t;
  }
  char* mb = wb + 2 * (SZ_WGU + SZ_WD);
  if (l < 2) {
    if (k == 6) { t.src = p.in[9] + (size_t)l * D * 1840; t.dst = (u16*)mb; t.K = D; t.Nsrc = 1840; t.Ndst = 2048; }
    else if (k == 7) { t.src = p.in[18] + (size_t)l * D * D; t.dst = (u16*)(mb + 4194304); t.K = D; t.Nsrc = D; t.Ndst = D; }
    else if (k == 8) { t.src = p.in[11] + (size_t)l * 2048 * 128; t.dst = (u16*)(mb + 4194304 + 2097152); t.K = 2048; t.Nsrc = 128; t.Ndst = 128; }
    else { t.src = p.in[15] + (size_t)l * 2048 * 128; t.dst = (u16*)(mb + 4194304 + 2097152 + 524288); t.K = 2048; t.Nsrc = 128; t.Ndst = 128; }
  } else {
    int j = l - 2;
    if (k == 6) { t.src = p.in[20] + (size_t)j * D * D; t.dst = (u16*)mb; t.K = D; t.Nsrc = D; t.Ndst = D; }
    else if (k == 7) { t.src = p.in[26] + (size_t)j * D * D; t.dst = (u16*)(mb + 2097152); t.K = D; t.Nsrc = D; t.Ndst = D; }
  }
  return t;
}

DI void prep_phase(const Params& p, char* smem) {
  const int tid = get_tid();
  float* T = (float*)smem;
  {
    for (int gt = blockIdx.x; gt < 5056; gt += gridDim.x) {
      int task, tile;
      if (gt >= 4928) { task = 40; tile = gt - 4928; }
      else {
        int l, r;
        if (gt < 2560) { l = gt / 1280; r = gt - l * 1280; } else { l = 2 + (gt - 2560) / 1184; r = (gt - 2560) % 1184; }
        if (r < 1056) { task = l * 10 + r / 176; tile = r % 176; }
        else {
          r -= 1056;
          if (l < 2) { if (r < 128) { task = l * 10 + 6; tile = r; } else if (r < 192) { task = l * 10 + 7; tile = r - 128; } else if (r < 208) { task = l * 10 + 8; tile = r - 192; } else { task = l * 10 + 9; tile = r - 208; } }
          else { if (r < 64) { task = l * 10 + 6; tile = r; } else { task = l * 10 + 7; tile = r - 64; } }
        }
      }
      Task t = get_task(p, task);
      const int nkt = t.K / 256;
      const int k0 = (tile % nkt) * 256, n0 = (tile / nkt) * 64;
      __syncthreads();
      float4 v[8];
#pragma unroll
      for (int e = 0; e < 8; ++e) {
        int idx = tid + e * 512, kk = idx >> 4, n4 = (idx & 15) * 4;
        v[e] = (n0 + n4 < t.Nsrc) ? *(const float4*)(t.src + (size_t)(k0 + kk) * t.Nsrc + n0 + n4) : make_float4(0.f, 0.f, 0.f, 0.f);
      }
#pragma unroll
      for (int e = 0; e < 8; ++e) {
        int idx = tid + e * 512, kk = idx >> 4, n4 = (idx & 15) * 4;
        T[(n4 + 0) * 257 + kk] = v[e].x; T[(n4 + 1) * 257 + kk] = v[e].y; T[(n4 + 2) * 257 + kk] = v[e].z; T[(n4 + 3) * 257 + kk] = v[e].w;
      }
      __syncthreads();
      const int nn = tid >> 3;
      int n = n0 + nn;
      int drow = t.mode == 0 ? n : ((n >> 7) * 256 + (t.mode - 1) * 128 + (n & 127));
#pragma unroll
      for (int j = 0; j < 4; ++j) {
        const int kc = (tid & 7) * 8 + j * 64;
        const float* tp = T + nn * 257 + kc;
        uint4 o;
        o.x = pack2(tp[0], tp[1]); o.y = pack2(tp[2], tp[3]); o.z = pack2(tp[4], tp[5]); o.w = pack2(tp[6], tp[7]);
        *(uint4*)(t.dst + (size_t)drow * t.K + k0 + kc) = o;
      }
    }
  }
  {
    const float4* xs = (const float4*)p.in[0];
    uint4* xb = (uint4*)(p.ws + OFF_XB);
    u16* lo = (u16*)p.out;
    const size_t n8 = (size_t)M * D / 8;
    const size_t stride = (size_t)gridDim.x * NTHR;
    for (size_t i = (size_t)blockIdx.x * NTHR + tid; i < n8; i += 4 * stride) {
      float4 va[4], vb[4];
#pragma unroll
      for (int j = 0; j < 4; ++j) { va[j] = xs[2 * (i + j * stride)]; vb[j] = xs[2 * (i + j * stride) + 1]; }
#pragma unroll
      for (int j = 0; j < 4; ++j) {
        const size_t e = i + j * stride;
        uint4 o; o.x = pack2(va[j].x, va[j].y); o.y = pack2(va[j].z, va[j].w); o.z = pack2(vb[j].x, vb[j].y); o.w = pack2(vb[j].z, vb[j].w);
        xb[e] = o;
        uint4 lw;
        lw.x = ((__float_as_uint(va[j].x) - (o.x << 16)) & 0xffffu) | ((__float_as_uint(va[j].y) - (o.x & 0xffff0000u)) << 16);
        lw.y = ((__float_as_uint(va[j].z) - (o.y << 16)) & 0xffffu) | ((__float_as_uint(va[j].w) - (o.y & 0xffff0000u)) << 16);
        lw.z = ((__float_as_uint(vb[j].x) - (o.z << 16)) & 0xffffu) | ((__float_as_uint(vb[j].y) - (o.z & 0xffff0000u)) << 16);
        lw.w = ((__float_as_uint(vb[j].z) - (o.w << 16)) & 0xffffu) | ((__float_as_uint(vb[j].w) - (o.w & 0xffff0000u)) << 16);
        const size_t row = e >> 7, c8 = e & 127;
        *(uint4*)(lo + row * 2048 + 1024 + c8 * 8) = lw;
      }
    }
  }
  {
    float2* rt = (float2*)(p.ws + OFF_ROPE);
    for (int i = blockIdx.x * NTHR + tid; i < 4096 * 8; i += gridDim.x * NTHR) {
      int pos = i >> 3, k = i & 7;
      float inv = (float)pow(500000.0, -(double)k / 8.0);
      float ang = (float)pos * inv;
      rt[i] = make_float2((float)cos((double)ang), (float)sin((double)ang));
    }
  }
  if (blockIdx.x < 4 && tid < 128) {
    int l = blockIdx.x >> 1, kv = blockIdx.x & 1;
    const float* pos = p.in[kv ? 14 : 10] + (size_t)l * 2048;
    const float* w1 = p.in[kv ? 15 : 11] + (size_t)l * 2048 * 128;
    const float* b1 = p.in[kv ? 16 : 12] + (size_t)l * 128;
    float acc = b1[tid];
    for (int i = 0; i < 2048; ++i) acc += pos[i] * w1[(size_t)i * 128 + tid];
    ((float*)(p.ws + OFF_B1P))[(l * 2 + kv) * 128 + tid] = acc;
  }
}

#define LAS __attribute__((address_space(3)))
constexpr int BM = 256, BK = 64, HALF = 128, HTB = HALF * BK * 2;

DI int lds_byte(int r, int c) {
  const int st = (r >> 4) * 2 + (c >> 5), rr = r & 15, cc = c & 31, ob = rr * 64 + cc * 2;
  return st * 1024 + (ob ^ (((ob >> 9) & 1) << 5));
}
DI void stage_rc(int b, int& R, int& C) {
  const int st = b / 1024, sb = b % 1024, swz = sb ^ (((sb >> 9) & 1) << 5);
  R = (st >> 1) * 16 + swz / 64; C = (st & 1) * 32 + (swz % 64) / 2;
}
DI int perm32(int rho) { const int n = rho >> 4, i = rho & 15; return 8 * (i >> 2) + 4 * n + (i & 3); }

enum { EPI_GATEUP = 0, EPI_RESID = 1, EPI_NSA_IN = 2, EPI_DIFF_Q = 3, EPI_DIFF_KV = 4 };

DI bool unit_next(int i, int nM, int nN, int& pm, int& pn) {
  const int nwg = nM * nN;
  const long L = (long)i * gridDim.x + blockIdx.x;
  if (L >= nwg) return false;
  int wgid = (int)L;
  { const int q = nwg / 8, r = nwg % 8, xcd = wgid % 8, off = wgid / 8; wgid = (xcd < r ? xcd * (q + 1) : r * (q + 1) + (xcd - r) * q) + off; }
  const int nig = 8 * nN, gid = wgid / nig, fm = gid * 8, gsz = (nM - fm) < 8 ? (nM - fm) : 8;
  pm = fm + ((wgid % nig) % gsz); pn = (wgid % nig) / gsz;
  return true;
}

DI void rope8(float* v, int fq, int pos, const float* rt, int lane) {
  float o[8];
#pragma unroll
  for (int i = 0; i < 8; ++i) o[i] = shx(v[i], 16, lane);
  if (fq < 2) {
    const float4* r4 = (const float4*)(rt + pos * 16);
#pragma unroll
    for (int i = 0; i < 4; ++i) {
      float4 cs = r4[i];
      float a0 = v[2 * i], a1 = v[2 * i + 1];
      if (fq == 0) { v[2 * i] = a0 * cs.x - o[2 * i] * cs.y; v[2 * i + 1] = a1 * cs.z - o[2 * i + 1] * cs.w; }
      else { v[2 * i] = o[2 * i] * cs.y + a0 * cs.x; v[2 * i + 1] = o[2 * i + 1] * cs.w + a1 * cs.z; }
    }
  }
}
DI uint4 pack8(const float* v) {
  uint4 o; o.x = pack2(v[0], v[1]); o.y = pack2(v[2], v[3]); o.z = pack2(v[4], v[5]); o.w = pack2(v[6], v[7]);
  return o;
}

DI void gemm_epi(const Params& p, int mode, float coef, const f32x4 (&acc)[2][2][4][2], int pm, int pn, int wr, int wc, int fr, int fq) {
  char* ws = launder_ptr(p.ws);
  const float* rt = (const float*)(ws + OFF_ROPE);
#pragma unroll
  for (int ai = 0; ai < 2; ++ai)
#pragma unroll
    for (int m = 0; m < 4; ++m) {
      const int row = pm * BM + ai * HALF + wr * 64 + m * 16 + fr;
      const int b = row >> 12, s = row & 4095;
      if (mode == EPI_GATEUP) {
        float v[8];
#pragma unroll
        for (int n = 0; n < 2; ++n)
#pragma unroll
          for (int e = 0; e < 4; ++e) {
            float gv = acc[ai][0][m][n][e], uv = acc[ai][1][m][n][e];
            v[n * 4 + e] = gv * uv * __builtin_amdgcn_rcpf(1.f + __builtin_amdgcn_exp2f(-1.4426950408889634f * gv));
          }
        *(uint4*)((u16*)(ws + OFF_H) + (size_t)row * F + pn * 128 + wc * 32 + 8 * fq) = pack8(v);
      } else if (mode == EPI_RESID) {
#pragma unroll
        for (int bj = 0; bj < 2; ++bj)
#pragma unroll
          for (int n = 0; n < 2; ++n) {
            float4* xp = (float4*)(p.out + (size_t)row * D + pn * BM + bj * HALF + wc * 32 + 16 * n + 4 * fq);
            float4 x = *xp; f32x4 a = acc[ai][bj][m][n];
            x.x = ALPHA * x.x + coef * a[0]; x.y = ALPHA * x.y + coef * a[1]; x.z = ALPHA * x.z + coef * a[2]; x.w = ALPHA * x.w + coef * a[3];
            *xp = x;
          }
      } else {
#pragma unroll
        for (int bj = 0; bj < 2; ++bj) {
          const int cb = pn * BM + bj * HALF + wc * 32, c = cb + 8 * fq;
          const bool head0 = (wc & 1) == 0;
          float v[8];
#pragma unroll
          for (int e = 0; e < 4; ++e) { v[e] = acc[ai][bj][m][0][e]; v[4 + e] = acc[ai][bj][m][1][e]; }
          if (mode == EPI_NSA_IN) {
            if (cb < 1024) {
#pragma unroll
              for (int e = 0; e < 8; ++e) v[e] *= 0.18033688011112042f;
              *(uint4*)((u16*)(ws + OFF_PROJ) + (size_t)row * D + c) = pack8(v);
              if (head0) rope8(v, fq, s, rt, fq * 16 + fr);
              *(uint4*)((u16*)(ws + OFF_QR) + (size_t)row * D + c) = pack8(v);
            } else if (cb < 1792) {
              const int seg = (cb - 1024) >> 7, g = ((cb - 1024) >> 6) & 1, d = c & 63;
              if (head0 && (seg == 2 || seg == 4)) rope8(v, fq, s, rt, fq * 16 + fr);
              *(uint4*)((u16*)(ws + OFF_SEG + (size_t)seg * SZ_SEG) + ((size_t)(b * 2 + g) * S + s) * 64 + d) = pack8(v);
            } else if (c < 1840) {
              float4* gp = (float4*)((float*)(ws + OFF_GATES) + (size_t)row * 48 + (c - 1792));
              gp[0] = make_float4(v[0], v[1], v[2], v[3]); gp[1] = make_float4(v[4], v[5], v[6], v[7]);
            }
          } else if (mode == EPI_DIFF_Q) {
#pragma unroll
            for (int e = 0; e < 8; ++e) v[e] *= 0.18033688011112042f;
            if (head0) rope8(v, fq, s, rt, fq * 16 + fr);
            *(uint4*)((u16*)(ws + OFF_PROJ) + (size_t)row * D + c) = pack8(v);
          } else {
            if (cb < 1024) {
              const int which = cb >> 9, hd = (cb >> 6) & 7, d = c & 63;
              if (head0) rope8(v, fq, s, rt, fq * 16 + fr);
              *(uint4*)((u16*)(ws + OFF_KD) + ((size_t)((b * 2 + which) * 8 + hd) * S + s) * 64 + d) = pack8(v);
            } else {
              const int e0 = c - 1024, hd = e0 >> 7, dv = e0 & 127;
              *(uint4*)((u16*)(ws + OFF_VD) + ((size_t)(b * 8 + hd) * S + s) * 128 + dv) = pack8(v);
            }
          }
        }
      }
    }
}


DI void fused_ln_epi(const Params& p, char* smem, float coef, f32x4 (&acc)[2][2][4][2], int pm, int pn, int wr, int wc, int fr, int fq,
                     int tid, int lnk, const float* g, const float* bt) {
  const int lane = fq * 16 + fr;
  char* ws = launder_ptr(p.ws); float* xout = (float*)launder_ptr((char*)p.out);
  u16* xb = (u16*)(ws + OFF_XB);
  u16* xlo = (u16*)xout;
  float2* P = (float2*)smem;
  float2* Sx = P + 1024;
  u64* slots = (u64*)(ws + OFF_SLOTS);
  unsigned* cnt = (unsigned*)(ws + OFF_CNT);
  int rl0 = wr * 64 + fr;
  asm volatile("" : "+v"(rl0));
  const int coff = pn * BM + wc * 32 + 8 * fq;
#pragma unroll
  for (int ai = 0; ai < 2; ++ai) {
    uint4 hreg[4][2], lreg[4][2];
#pragma unroll
    for (int m = 0; m < 4; ++m) {
      const size_t roff = (size_t)(pm * BM + rl0 + ai * HALF + m * 16);
#pragma unroll
      for (int bj = 0; bj < 2; ++bj) {
        hreg[m][bj] = *(const uint4*)(xb + roff * D + coff + bj * HALF);
        lreg[m][bj] = *(const uint4*)(xlo + roff * 2048 + 1024 + coff + bj * HALF);
      }
    }
#pragma unroll
    for (int m = 0; m < 4; ++m) {
      int rl = rl0 + ai * HALF + m * 16;
      asm volatile("" : "+v"(rl));
      float s = 0.f, q = 0.f;
#pragma unroll
      for (int bj = 0; bj < 2; ++bj) {
        const uint4 h8 = hreg[m][bj], l8 = lreg[m][bj];
        const unsigned hw[4] = {h8.x, h8.y, h8.z, h8.w}, lw[4] = {l8.x, l8.y, l8.z, l8.w};
#pragma unroll
        for (int n = 0; n < 2; ++n) {
          float4 x;
          x.x = __uint_as_float((hw[2 * n] << 16) + (unsigned)(int)(short)(lw[2 * n] & 0xffffu));
          x.y = __uint_as_float((hw[2 * n] & 0xffff0000u) + (unsigned)((int)lw[2 * n] >> 16));
          x.z = __uint_as_float((hw[2 * n + 1] << 16) + (unsigned)(int)(short)(lw[2 * n + 1] & 0xffffu));
          x.w = __uint_as_float((hw[2 * n + 1] & 0xffff0000u) + (unsigned)((int)lw[2 * n + 1] >> 16));
          f32x4 a = acc[ai][bj][m][n];
          a[0] = ALPHA * x.x + coef * a[0]; a[1] = ALPHA * x.y + coef * a[1]; a[2] = ALPHA * x.z + coef * a[2]; a[3] = ALPHA * x.w + coef * a[3];
          acc[ai][bj][m][n] = a;
          s += (a[0] + a[1]) + (a[2] + a[3]);
          q += (a[0] * a[0] + a[1] * a[1]) + (a[2] * a[2] + a[3] * a[3]);
        }
      }
      s += shx(s, 16, lane); q += shx(q, 16, lane);
      s += shx(s, 32, lane); q += shx(q, 32, lane);
      if (fq == 0) P[rl * 4 + wc] = make_float2(s, q);
    }
  }
  float4 gq[2][2], bq2[2][2];
#pragma unroll
  for (int bj = 0; bj < 2; ++bj) {
    const int c = pn * BM + bj * HALF + wc * 32 + 8 * fq;
    gq[bj][0] = *(const float4*)(g + c); gq[bj][1] = *(const float4*)(g + c + 4);
    bq2[bj][0] = *(const float4*)(bt + c); bq2[bj][1] = *(const float4*)(bt + c + 4);
  }
  __syncthreads();
  if (tid < 256) {
    const float2 a0 = P[tid * 4], a1 = P[tid * 4 + 1], a2 = P[tid * 4 + 2], a3 = P[tid * 4 + 3];
    const float s = (a0.x + a1.x) + (a2.x + a3.x), q = (a0.y + a1.y) + (a2.y + a3.y);
    const u64 bits = ((u64)__float_as_uint(q) << 32) | (u64)__float_as_uint(s);
    __hip_atomic_store(slots + ((size_t)(pm * 4 + pn) * 256 + tid), bits, __ATOMIC_RELAXED, __HIP_MEMORY_SCOPE_AGENT);
  }
  asm volatile("s_waitcnt vmcnt(0)" ::: "memory");
  __syncthreads();
  if (tid == 0) {
    unsigned* c = cnt + pm * 64;
    (void)__hip_atomic_fetch_add(c, 1u, __ATOMIC_RELAXED, __HIP_MEMORY_SCOPE_AGENT);
    const unsigned need = 4u * (unsigned)(lnk + 1);
    unsigned sp = 0;
    while (__hip_atomic_load(c, __ATOMIC_RELAXED, __HIP_MEMORY_SCOPE_AGENT) < need) {
      __builtin_amdgcn_s_sleep(1);
      if (++sp > (1u << 24)) break;
    }
  }
  __syncthreads();
  if (tid < 256) {
    float s = 0.f, q = 0.f;
    {
      const u64* sp0 = slots + ((size_t)(pm * 4) * 256 + tid);
      u64 b0, b1, b2, b3;
      asm volatile("global_load_dwordx2 %0, %4, off sc1\n\tglobal_load_dwordx2 %1, %5, off sc1\n\tglobal_load_dwordx2 %2, %6, off sc1\n\tglobal_load_dwordx2 %3, %7, off sc1\n\ts_waitcnt vmcnt(0)"
                   : "=&v"(b0), "=&v"(b1), "=&v"(b2), "=&v"(b3) : "v"(sp0), "v"(sp0 + 256), "v"(sp0 + 512), "v"(sp0 + 768) : "memory");
      s = ((__uint_as_float((unsigned)b0) + __uint_as_float((unsigned)b1)) + __uint_as_float((unsigned)b2)) + __uint_as_float((unsigned)b3);
      q = ((__uint_as_float((unsigned)(b0 >> 32)) + __uint_as_float((unsigned)(b1 >> 32))) + __uint_as_float((unsigned)(b2 >> 32))) + __uint_as_float((unsigned)(b3 >> 32));
    }
    const float mean = s * (1.f / D);
    const float var = fmaxf(q * (1.f / D) - mean * mean, 0.f);
    Sx[tid] = make_float2(mean, rsqrtf(var + 1e-5f));
  }
  __syncthreads();
#pragma unroll
  for (int bj = 0; bj < 2; ++bj) {
    const int c = pn * BM + bj * HALF + wc * 32 + 8 * fq;
    const float4 g0 = gq[bj][0], g1 = gq[bj][1];
    const float4 b0 = bq2[bj][0], b1 = bq2[bj][1];
#pragma unroll
    for (int ai = 0; ai < 2; ++ai)
#pragma unroll
      for (int m = 0; m < 4; ++m) {
        int rl = rl0 + ai * HALF + m * 16;
        asm volatile("" : "+v"(rl));
        const float2 ms = Sx[rl];
        const f32x4 a = acc[ai][bj][m][0], bq = acc[ai][bj][m][1];
        float v[8];
        v[0] = (a[0] - ms.x) * ms.y * g0.x + b0.x; v[1] = (a[1] - ms.x) * ms.y * g0.y + b0.y;
        v[2] = (a[2] - ms.x) * ms.y * g0.z + b0.z; v[3] = (a[3] - ms.x) * ms.y * g0.w + b0.w;
        v[4] = (bq[0] - ms.x) * ms.y * g1.x + b1.x; v[5] = (bq[1] - ms.x) * ms.y * g1.y + b1.y;
        v[6] = (bq[2] - ms.x) * ms.y * g1.z + b1.z; v[7] = (bq[3] - ms.x) * ms.y * g1.w + b1.w;
        const size_t roff = (size_t)(pm * BM + rl);
        if (lnk == 11) {
          float* xo = xout + roff * D + c;
          *(float4*)xo = make_float4(v[0], v[1], v[2], v[3]);
          *(float4*)(xo + 4) = make_float4(v[4], v[5], v[6], v[7]);
        } else {
          const uint4 h8 = pack8(v);
          *(uint4*)(xb + roff * D + c) = h8;
          uint4 l8;
          l8.x = ((__float_as_uint(v[0]) - (h8.x << 16)) & 0xffffu) | ((__float_as_uint(v[1]) - (h8.x & 0xffff0000u)) << 16);
          l8.y = ((__float_as_uint(v[2]) - (h8.y << 16)) & 0xffffu) | ((__float_as_uint(v[3]) - (h8.y & 0xffff0000u)) << 16);
          l8.z = ((__float_as_uint(v[4]) - (h8.z << 16)) & 0xffffu) | ((__float_as_uint(v[5]) - (h8.z & 0xffff0000u)) << 16);
          l8.w = ((__float_as_uint(v[6]) - (h8.w << 16)) & 0xffffu) | ((__float_as_uint(v[7]) - (h8.w & 0xffff0000u)) << 16);
          *(uint4*)(xlo + roff * 2048 + 1024 + c) = l8;
        }
      }
  }
  __syncthreads();
}

DI void gemm_phase(const Params& p, char* smem, const u16* Ag, const u16* Btg, int N, int K, int mode, float coef, int lnk, const float* lng, const float* lnb) {
  LAS unsigned char* lds = (LAS unsigned char*)smem;
  const int tid = get_tid(), wid = __builtin_amdgcn_readfirstlane(tid >> 6), lane = tid & 63, wr = wid >> 2, wc = wid & 3, fr = lane & 15, fq = lane >> 4;
  const int nt = K / BK, nM = M / BM, nN = N / BM;
  const bool perm = true;
  const bool single = (mode == EPI_RESID);
  unsigned voffA[2], voffB[2];
#pragma unroll
  for (int i = 0; i < 2; ++i) {
    int R, C; stage_rc(tid * 16 + i * 8192, R, C);
    const int Rb = perm ? ((R & ~31) + perm32(R & 31)) : R;
    voffA[i] = (unsigned)(R * K + C) * 2u; voffB[i] = (unsigned)(Rb * K + C) * 2u;
  }
  const size_t kstep = (size_t)(BK * 2);
  const size_t hstep = (size_t)HALF * K * 2;
  const size_t tstep = 2 * hstep;
  const unsigned ldsw = (unsigned)wid * 1024u;
  const int aoff = lds_byte(wr * 64 + fr, fq * 8), boff = lds_byte(wc * 32 + fr, fq * 8);
#define G_SA(b, h) (((b) * 2 + (h)) * HTB)
#define G_SB(b, h) ((4 + (b) * 2 + (h)) * HTB)
#define G_STAGE(bufoff, gbase, voff) do { _Pragma("unroll") for (int _i = 0; _i < 2; ++_i) \
    __builtin_amdgcn_global_load_lds((const unsigned*)((const char*)(gbase) + (voff)[_i]), (LAS unsigned*)(lds + (bufoff) + ldsw + _i * 8192), 16, 0, 0); } while (0)
#define G_LDA(dst, b, h) do { _Pragma("unroll") for (int m = 0; m < 4; ++m) _Pragma("unroll") for (int k = 0; k < 2; ++k) dst[m][k] = *(const LAS bf16x8*)(lds + G_SA(b, h) + aoff + m * 2048 + k * 1024); } while (0)
#define G_LDB(dst, b, h) do { _Pragma("unroll") for (int n = 0; n < 2; ++n) _Pragma("unroll") for (int k = 0; k < 2; ++k) dst[n][k] = *(const LAS bf16x8*)(lds + G_SB(b, h) + boff + n * 2048 + k * 1024); } while (0)
#define G_MMA(ai, bj, At, Bt) do { __builtin_amdgcn_s_setprio(1); _Pragma("unroll") for (int m = 0; m < 4; ++m) _Pragma("unroll") for (int n = 0; n < 2; ++n) _Pragma("unroll") for (int k = 0; k < 2; ++k) \
    acc[ai][bj][m][n] = __builtin_amdgcn_mfma_f32_16x16x32_bf16(Bt[n][k], At[m][k], acc[ai][bj][m][n], 0, 0, 0); __builtin_amdgcn_s_setprio(0); } while (0)
#define G_WAIT_V(n) asm volatile("s_waitcnt vmcnt(" #n ")" ::: "memory")
#define G_WAIT_L(n) asm volatile("s_waitcnt lgkmcnt(" #n ")" ::: "memory")
#define G_BAR __builtin_amdgcn_s_barrier()
#define G_SCHED __builtin_amdgcn_sched_barrier(0)
  int cpm, cpn, npm = 0, npn = 0, ui = 0;
  f32x4 acc[2][2][4][2];
  bf16x8 At[4][2], B0[2][2], B1[2][2];
  for (int ubase = 0;; ++ubase) {
  if (!unit_next(ubase, nM, nN, cpm, cpn)) break;
  ui = ubase;
#pragma unroll
  for (int a = 0; a < 2; ++a)
#pragma unroll
    for (int b = 0; b < 2; ++b)
#pragma unroll
      for (int m = 0; m < 4; ++m)
#pragma unroll
        for (int n = 0; n < 2; ++n) acc[a][b][m][n] = (f32x4){0.f, 0.f, 0.f, 0.f};
  const char* cA = (const char*)Ag + (size_t)cpm * tstep; const char* cB = (const char*)Btg + (size_t)cpn * tstep;
  G_STAGE(G_SB(0, 0), cB, voffB); G_STAGE(G_SA(0, 0), cA, voffA); G_STAGE(G_SB(0, 1), cB + hstep, voffB); G_STAGE(G_SA(0, 1), cA + hstep, voffA);
  if (wr == 1) G_BAR;
  G_WAIT_V(4); G_BAR;
  G_STAGE(G_SB(1, 0), cB + kstep, voffB); G_STAGE(G_SA(1, 0), cA + kstep, voffA); G_STAGE(G_SB(1, 1), cB + hstep + kstep, voffB);
  G_WAIT_V(6); G_BAR;
  for (;;) {
    const bool has_next = unit_next(ui + 1, nM, nN, npm, npn);
    const char* nA = has_next ? (const char*)Ag + (size_t)npm * tstep : cA; const char* nB = has_next ? (const char*)Btg + (size_t)npn * tstep : cB;
    for (int t = 0; t < nt; t += 2) {
      const bool last = (t == nt - 2);
      const char* a1 = cA + (size_t)(t + 1) * kstep;
      const char* a2 = last ? nA : cA + (size_t)(t + 2) * kstep; const char* b2 = last ? nB : cB + (size_t)(t + 2) * kstep;
      const char* a3 = a2 + kstep; const char* b3 = b2 + kstep;
      G_LDB(B0, 0, 0); G_SCHED; G_LDA(At, 0, 0); G_STAGE(G_SA(1, 1), a1 + hstep, voffA);
      G_WAIT_L(8); G_BAR; G_WAIT_L(0); G_MMA(0, 0, At, B0); G_BAR; G_SCHED;
      G_LDB(B1, 0, 1); G_STAGE(G_SB(0, 0), b2, voffB);
      G_BAR; G_WAIT_L(0); G_MMA(0, 1, At, B1); G_BAR;
      G_LDA(At, 0, 1); G_STAGE(G_SA(0, 0), a2, voffA);
      G_BAR; G_WAIT_L(0); G_MMA(1, 0, At, B0); G_BAR; G_SCHED;
      G_STAGE(G_SB(0, 1), b2 + hstep, voffB);
      G_WAIT_V(6); G_BAR; G_MMA(1, 1, At, B1); G_BAR;
      G_LDB(B0, 1, 0); G_SCHED; G_LDA(At, 1, 0); G_STAGE(G_SA(0, 1), a2 + hstep, voffA);
      G_WAIT_L(8); G_BAR; G_WAIT_L(0); G_MMA(0, 0, At, B0); G_BAR; G_SCHED;
      G_LDB(B1, 1, 1); G_STAGE(G_SB(1, 0), b3, voffB);
      G_BAR; G_WAIT_L(0); G_MMA(0, 1, At, B1); G_BAR;
      G_LDA(At, 1, 1); G_STAGE(G_SA(1, 0), a3, voffA);
      G_BAR; G_WAIT_L(0); G_MMA(1, 0, At, B0); G_BAR; G_SCHED;
      G_STAGE(G_SB(1, 1), b3 + hstep, voffB);
      G_WAIT_V(6); G_BAR; G_MMA(1, 1, At, B1); G_BAR;
    }
    if (!single) {
      gemm_epi(p, mode, coef, acc, cpm, cpn, wr, wc, fr, fq);
      if (!has_next) break;
    } else {
      if (!has_next) G_WAIT_V(0);
      if (wr == 0) G_BAR;
      if (!has_next) G_BAR;
      fused_ln_epi(p, smem + 131072, coef, acc, cpm, cpn, wr, wc, fr, fq, tid, lnk, lng, lnb);
      if (!has_next) break;
      if (wr == 1) G_BAR;
    }
#pragma unroll
    for (int a = 0; a < 2; ++a)
#pragma unroll
      for (int b = 0; b < 2; ++b)
#pragma unroll
        for (int m = 0; m < 4; ++m)
#pragma unroll
          for (int n = 0; n < 2; ++n) acc[a][b][m][n] = (f32x4){0.f, 0.f, 0.f, 0.f};
    cpm = npm; cpn = npn; cA = nA; cB = nB; ++ui;
  }
  if (!single) {
    G_WAIT_V(0);
    if (wr == 0) G_BAR;
    G_BAR;
  }
  break;
  }
#undef G_SA
#undef G_SB
#undef G_STAGE
#undef G_LDA
#undef G_LDB
#undef G_MMA
}

DI float gelu_tanh(float x) {
  float u = 0.7978845608028654f * (x + 0.044715f * x * x * x);
  return 0.5f * x * (1.f + tanhf(u));
}

DI void compress_phase(const Params& p, char* smem, int l) {
  const int tid = get_tid(), w = tid >> 6, lane = tid & 63, fr = lane & 15, fq = lane >> 4;
  float* hid = (float*)smem;
  char* ws = launder_ptr(p.ws);
  char* mb = layer_w(ws, l) + 2 * (SZ_WGU + SZ_WD);
  for (int item = blockIdx.x; item < 512; item += gridDim.x) {
    const int kv = item & 1, ct = (item >> 1) & 15, bg = item >> 5;
    const u16* src = (const u16*)(ws + OFF_SEG + (size_t)kv * SZ_SEG) + (size_t)bg * S * 64;
    const u16* w1t = (const u16*)(mb + 4194304 + 2097152 + (size_t)kv * 524288);
    const float* w2 = p.in[kv ? 17 : 13] + (size_t)l * 128 * 64;
    const float* b1p = (const float*)(ws + OFF_B1P) + (l * 2 + kv) * 128;
    const int c0 = ct * 16;
    int cr = c0 + fr; if (cr > 254) cr = 254;
    const u16* ap = src + (size_t)cr * 16 * 64 + fq * 8;
    const u16* bp = w1t + (size_t)(w * 16 + fr) * 2048 + fq * 8;
    f32x4 acc = {0.f, 0.f, 0.f, 0.f};
#pragma unroll 16
    for (int kk = 0; kk < 64; ++kk) {
      bf16x8 a = *(const bf16x8*)(ap + kk * 32);
      bf16x8 bb = *(const bf16x8*)(bp + kk * 32);
      acc = __builtin_amdgcn_mfma_f32_16x16x32_bf16(a, bb, acc, 0, 0, 0);
    }
    __syncthreads();
#pragma unroll
    for (int j = 0; j < 4; ++j) {
      int col = w * 16 + fr;
      hid[(fq * 4 + j) * 128 + col] = gelu_tanh(acc[j] + b1p[col]);
    }
    __syncthreads();
#pragma unroll
    for (int e = 0; e < 2; ++e) {
      int o = tid + e * 512, r = o >> 6, d = o & 63;
      float s = 0.f;
      for (int k = 0; k < 128; ++k) s += hid[r * 128 + k] * w2[k * 64 + d];
      int c = c0 + r;
      if (c < 255) {
        if (kv == 0) ((u16*)(ws + OFF_KCMP))[((size_t)bg * 256 + c) * 64 + d] = f2bf(s);
        else ((u16*)(ws + OFF_VCMPT))[((size_t)bg * 256 + c) * 64 + d] = f2bf(s);
      }
    }
  }
}

template <int KS>
DI f32x16 qk_tile(const u16* Ksub, const bf16x8* qf, int ql, int h, float init = 0.f) {
  f32x16 s;
#pragma unroll
  for (int i = 0; i < 16; ++i) s[i] = init;
#pragma unroll
  for (int ks = 0; ks < 4; ++ks) {
    bf16x8 a = *(const bf16x8*)(Ksub + ql * KS + ks * 16 + h * 8);
    s = mfma32(a, qf[ks], s);
  }
  return s;
}
template <int KS>
DI f32x16 qk_tile_lds(const u16* Ksub, const u16* Qsub, int ql, int h, float init) {
  f32x16 s;
#pragma unroll
  for (int i = 0; i < 16; ++i) s[i] = init;
#pragma unroll
  for (int ks = 0; ks < 4; ++ks) {
    bf16x8 a = *(const bf16x8*)(Ksub + ql * KS + ks * 16 + h * 8);
    bf16x8 b = *(const bf16x8*)(Qsub + ql * KS + ks * 16 + h * 8);
    s = mfma32(a, b, s);
  }
  return s;
}
DI s16x4 tr_read(const u16* ptr) { return __builtin_amdgcn_ds_read_tr16_b64_v4i16((LAS s16x4*)ptr); }
template <int NMB, int VS>
DI void pv_tile(const u16* vsub, const bf16x8* pf, f32x16* O, int lane) {
  const int l16 = lane & 15, q = l16 >> 2, pp = l16 & 3, blk = (lane >> 4) & 1, h = lane >> 5;
  const u16* base = vsub + (4 * h + q) * VS + 16 * blk + 4 * pp;
#pragma unroll
  for (int mb = 0; mb < NMB; ++mb)
#pragma unroll
    for (int s2 = 0; s2 < 2; ++s2) {
      s16x4 lo = tr_read(base + (16 * s2) * VS + mb * 32);
      s16x4 hi = tr_read(base + (16 * s2 + 8) * VS + mb * 32);
      bf16x8 a = __builtin_shufflevector(lo, hi, 0, 1, 2, 3, 4, 5, 6, 7);
      O[mb] = mfma32(a, pf[s2], O[mb]);
    }
}
template <int VS>
DI void pv_load(const u16* vsub, bf16x8* vf, int lane) {
  const int l16 = lane & 15, q = l16 >> 2, pp = l16 & 3, blk = (lane >> 4) & 1, h = lane >> 5;
  const u16* base = vsub + (4 * h + q) * VS + 16 * blk + 4 * pp;
#pragma unroll
  for (int mb = 0; mb < 2; ++mb)
#pragma unroll
    for (int s2 = 0; s2 < 2; ++s2) {
      s16x4 lo = tr_read(base + (16 * s2) * VS + mb * 32);
      s16x4 hi = tr_read(base + (16 * s2 + 8) * VS + mb * 32);
      vf[mb * 2 + s2] = __builtin_shufflevector(lo, hi, 0, 1, 2, 3, 4, 5, 6, 7);
    }
}
DI void pv_mma(const bf16x8* vf, const bf16x8* pf, f32x16* O) {
#pragma unroll
  for (int mb = 0; mb < 2; ++mb)
#pragma unroll
    for (int s2 = 0; s2 < 2; ++s2) O[mb] = mfma32(vf[mb * 2 + s2], pf[s2], O[mb]);
}
template <int KS>
DI void k_load8(const u16* Kt, bf16x8* kf, int ql, int h) {
#pragma unroll
  for (int sub = 0; sub < 2; ++sub)
#pragma unroll
    for (int ks = 0; ks < 4; ++ks) kf[sub * 4 + ks] = *(const bf16x8*)(Kt + (sub * 32 + ql) * KS + ks * 16 + h * 8);
}
DI f32x16 qk_mma(const bf16x8* kf, const bf16x8* qf, float init) {
  f32x16 s;
#pragma unroll
  for (int i = 0; i < 16; ++i) s[i] = init;
#pragma unroll
  for (int ks = 0; ks < 4; ++ks) s = mfma32(kf[ks], qf[ks], s);
  return s;
}
template <int VS>
DI void v_load8(const u16* Vt, bf16x8* vf, int lane) {
  const int l16 = lane & 15, q = l16 >> 2, pp = l16 & 3, blk = (lane >> 4) & 1, h = lane >> 5;
  const u16* base = Vt + (4 * h + q) * VS + 16 * blk + 4 * pp;
#pragma unroll
  for (int sub = 0; sub < 2; ++sub)
#pragma unroll
    for (int mb = 0; mb < 2; ++mb)
#pragma unroll
      for (int s2 = 0; s2 < 2; ++s2) {
        s16x4 lo = tr_read(base + (sub * 32 + 16 * s2) * VS + mb * 32);
        s16x4 hi = tr_read(base + (sub * 32 + 16 * s2 + 8) * VS + mb * 32);
        vf[sub * 4 + mb * 2 + s2] = __builtin_shufflevector(lo, hi, 0, 1, 2, 3, 4, 5, 6, 7);
      }
}
DI void pv_mma8(const bf16x8* vf, const bf16x8* pf, f32x16* O) {
#pragma unroll
  for (int sub = 0; sub < 2; ++sub)
#pragma unroll
    for (int mb = 0; mb < 2; ++mb)
#pragma unroll
      for (int s2 = 0; s2 < 2; ++s2) O[mb] = mfma32(vf[sub * 4 + mb * 2 + s2], pf[sub * 2 + s2], O[mb]);
}
constexpr float NINF = -__builtin_inff();
template <bool MASK>
DI bool softmax_step(f32x16& s, int kbase, int lo, int hi, float& m, float& l, float& alpha, bf16x8* pf, int lane) {
  if (MASK) {
#pragma unroll
    for (int i = 0; i < 16; ++i) {
      int kp = kbase + (i & 3) + 8 * (i >> 2);
      s[i] = ((kp > lo) && (kp <= hi)) ? s[i] : NINF;
    }
  }
  float mx = fmaxf(fmaxf(s[0], s[1]), s[2]);
#pragma unroll
  for (int i = 3; i < 15; i += 2) mx = fmaxf(fmaxf(mx, s[i]), s[i + 1]);
  mx = fmaxf(mx, s[15]);
  const bool need = __any(mx > 8.f);
  alpha = 1.f;
  if (need) {
    mx = fmaxf(mx, shx(mx, 32, lane));
    const float d = fmaxf(mx, 0.f);
    alpha = __builtin_amdgcn_exp2f(-d);
    l *= alpha;
    m += d;
#pragma unroll
    for (int i = 0; i < 16; ++i) s[i] -= d;
  }
  float rs = 0.f;
#pragma unroll
  for (int i = 0; i < 16; ++i) {
    float pv = __builtin_amdgcn_exp2f(s[i]);
    s[i] = pv; rs += pv;
  }
  l += rs;
#pragma unroll
  for (int s2 = 0; s2 < 2; ++s2) {
    unsigned u[4];
#pragma unroll
    for (int j = 0; j < 4; ++j) u[j] = pack2(s[8 * s2 + 2 * j], s[8 * s2 + 2 * j + 1]);
    pf[s2] = __builtin_bit_cast(bf16x8, *(uint4*)u);
  }
  return need;
}

template <bool MASK>
DI bool softmax_step64(f32x16& s0, f32x16& s1, int kbase, int lo, int hi, float& m, float& l, float& alpha, bf16x8* pf, int lane) {
  if (MASK) {
#pragma unroll
    for (int i = 0; i < 16; ++i) {
      int kp = kbase + (i & 3) + 8 * (i >> 2);
      s0[i] = ((kp > lo) && (kp <= hi)) ? s0[i] : NINF;
      s1[i] = ((kp + 32 > lo) && (kp + 32 <= hi)) ? s1[i] : NINF;
    }
  }
  float mx = fmaxf(s0[0], s1[0]);
#pragma unroll
  for (int i = 1; i < 16; ++i) mx = fmaxf(fmaxf(mx, s0[i]), s1[i]);
  const bool need = __any(mx > 8.f);
  alpha = 1.f;
  if (need) {
    mx = fmaxf(mx, shx(mx, 32, lane));
    const float d = fmaxf(mx, 0.f);
    alpha = __builtin_amdgcn_exp2f(-d);
    l *= alpha;
    m += d;
#pragma unroll
    for (int i = 0; i < 16; ++i) { s0[i] -= d; s1[i] -= d; }
  }
  float rs0 = 0.f, rs1 = 0.f;
#pragma unroll
  for (int i = 0; i < 16; ++i) {
    float p0 = __builtin_amdgcn_exp2f(s0[i]), p1 = __builtin_amdgcn_exp2f(s1[i]);
    s0[i] = p0; s1[i] = p1; rs0 += p0; rs1 += p1;
  }
  l += rs0 + rs1;
#pragma unroll
  for (int s2 = 0; s2 < 2; ++s2) {
    unsigned u[4], v[4];
#pragma unroll
    for (int j = 0; j < 4; ++j) { u[j] = pack2(s0[8 * s2 + 2 * j], s0[8 * s2 + 2 * j + 1]); v[j] = pack2(s1[8 * s2 + 2 * j], s1[8 * s2 + 2 * j + 1]); }
    pf[s2] = __builtin_bit_cast(bf16x8, *(uint4*)u);
    pf[2 + s2] = __builtin_bit_cast(bf16x8, *(uint4*)v);
  }
  return need;
}

constexpr int KST = 72, VST = 96, VDS = 160;

DI void nsa_load_q(const u16* qbase, long row, int hq, int h, bf16x8* qf) {
#pragma unroll
  for (int ks = 0; ks < 4; ++ks) qf[ks] = *(const bf16x8*)(qbase + row * D + hq * 64 + ks * 16 + h * 8);
}

DI void nsa_attn_phase(const Params& p, char* smem) {
  const int tid0 = get_tid();
  u16* Kb = (u16*)smem;
  u16* Vb = Kb + 2 * 64 * KST;
  u16* Kc = Vb + 2 * 64 * VST;
  u16* Vc = Kc + 256 * KST;
  unsigned* imp = (unsigned*)(Vc + 256 * VST);
  u64* sel = (u64*)(imp + 32 * 65);
  unsigned* uni = (unsigned*)(sel + 32);
  char* ws = launder_ptr(p.ws);
  const u16* KS_g = (const u16*)(ws + OFF_SEG + 2 * SZ_SEG);
  const u16* VS_g = (const u16*)(ws + OFF_SEG + 3 * SZ_SEG);
  const u16* KW_g = (const u16*)(ws + OFF_SEG + 4 * SZ_SEG);
  const u16* VW_g = (const u16*)(ws + OFF_SEG + 5 * SZ_SEG);
  const float* gates = (const float*)(ws + OFF_GATES);
  u16* Oout = (u16*)(ws + OFF_PROJ);

  for (int item = blockIdx.x; item < 2048; item += gridDim.x) {
    const int rnd = item >> 8, j256 = item & 255;
    int tid = tid0; asm volatile("" : "+v"(tid));
    const int w = tid >> 6, lane = tid & 63, ql = lane & 31, h = lane >> 5;
    const int bg = j256 & 15, k16 = j256 >> 4;
    const int tile = rnd * 16 + ((rnd & 1) ? 15 - k16 : k16);
    const int b = bg >> 1, g = bg & 1;
    const int t0 = tile * 32, t = t0 + ql, hq = g * 8 + w;
    const long row = (long)b * S + t;
    const int cur = t0 >> 6;

    __syncthreads();
    const int tidi = tid;
    const int ntc = (t0 >> 9) + 1, nc = ntc * 32;
    for (int i = tidi; i < 32 * 65; i += NTHR) imp[i] = 0;
    if (tidi < 2) uni[tidi] = 0;
    bf16x8 qf[4];
    nsa_load_q((const u16*)(ws + OFF_PROJ), row, hq, h, qf);
    const int lr = tid >> 3, lch = tid & 7;
    uint4 kreg, vreg;
    const float gr0 = gates[row * 48 + hq], gr1 = gates[row * 48 + 16 + hq], gr2 = gates[row * 48 + 32 + hq];
    const float g0 = __builtin_amdgcn_rcpf(1.f + __expf(-gr0)), g1 = __builtin_amdgcn_rcpf(1.f + __expf(-gr1)), g2 = __builtin_amdgcn_rcpf(1.f + __expf(-gr2));
    {
      const u16* kcg = (const u16*)(ws + OFF_KCMP) + (size_t)bg * 256 * 64;
      const u16* vcg = (const u16*)(ws + OFF_VCMPT) + (size_t)bg * 256 * 64;
      uint4 kc4[4], vc4[4];
#pragma unroll
      for (int j = 0; j < 4; ++j) {
        const int i = tidi + j * NTHR;
        kc4[j] = *(const uint4*)(kcg + (i >> 3) * 64 + (i & 7) * 8); vc4[j] = *(const uint4*)(vcg + (i >> 3) * 64 + (i & 7) * 8);
      }
#pragma unroll
      for (int j = 0; j < 4; ++j) {
        const int i = tidi + j * NTHR;
        if (i < nc * 8) { *(uint4*)(Kc + (i >> 3) * KST + (i & 7) * 8) = kc4[j]; *(uint4*)(Vc + (i >> 3) * VST + (i & 7) * 8) = vc4[j]; }
      }
    }
    __syncthreads();

    f32x16 O[2];
    unsigned outp[16];
    bf16x8 pf[4];
    const int cmaxq = (t >= 31) ? ((t - 31) >> 4) : -1;
    float m = NEGF, l = 0.f;
    for (int ct = 0; ct < ntc; ++ct) {
      f32x16 s = qk_tile<KST>(Kc + ct * 32 * KST, qf, ql, h);
      float mx = NEGF;
#pragma unroll
      for (int i = 0; i < 16; ++i) {
        int c = ct * 32 + 4 * h + (i & 3) + 8 * (i >> 2);
        s[i] = (c <= cmaxq) ? s[i] : NEGF;
        mx = fmaxf(mx, s[i]);
      }
      mx = fmaxf(mx, shx(mx, 32, lane));
      const float mn = fmaxf(m, mx);
      float rs = 0.f;
#pragma unroll
      for (int i = 0; i < 16; ++i) rs += (s[i] > -1e29f) ? __builtin_amdgcn_exp2f(s[i] - mn) : 0.f;
      rs += shx(rs, 32, lane);
      l = l * __builtin_amdgcn_exp2f(m - mn) + rs;
      m = mn;
    }
    const float invl = (l > 0.f) ? 1.f / l : 0.f;
#pragma unroll
    for (int mb = 0; mb < 2; ++mb)
#pragma unroll
      for (int i = 0; i < 16; ++i) O[mb][i] = 0.f;
    for (int ct = 0; ct < ntc; ++ct) {
      f32x16 s = qk_tile<KST>(Kc + ct * 32 * KST, qf, ql, h);
#pragma unroll
      for (int i = 0; i < 16; ++i) {
        int c = ct * 32 + 4 * h + (i & 3) + 8 * (i >> 2);
        s[i] = (c <= cmaxq) ? __builtin_amdgcn_exp2f(s[i] - m) * invl : 0.f;
      }
#pragma unroll
      for (int a = 0; a < 4; ++a) {
        int n = ct * 8 + 2 * a + h;
        float mainv = s[4 * a] + s[4 * a + 1] + s[4 * a + 2] + 0.5f * s[4 * a + 3];
        float carry = 0.5f * s[4 * a + 3];
        unsigned um = (unsigned)(mainv * 16777216.f + 0.5f), uc = (unsigned)(carry * 16777216.f + 0.5f);
        if (um) atomicAdd(&imp[ql * 65 + n], um);
        if (uc && n < 63) atomicAdd(&imp[ql * 65 + n + 1], uc);
      }
#pragma unroll
      for (int s2 = 0; s2 < 2; ++s2) {
        unsigned u[4];
#pragma unroll
        for (int j = 0; j < 4; ++j) u[j] = pack2(s[8 * s2 + 2 * j], s[8 * s2 + 2 * j + 1]);
        pf[s2] = __builtin_bit_cast(bf16x8, *(uint4*)u);
      }
      pv_tile<2, VST>(Vc + ct * 32 * VST, pf, O, lane);
    }
#pragma unroll
    for (int mb = 0; mb < 2; ++mb)
#pragma unroll
      for (int i = 0; i < 16; i += 2) outp[mb * 8 + (i >> 1)] = pack2(g0 * O[mb][i], g0 * O[mb][i + 1]);
    __syncthreads();
    for (int qq = 0; qq < 4; ++qq) {
      const int q = w * 4 + qq;
      unsigned v = imp[q * 65 + lane];
      const bool valid = lane <= cur;
      const bool forced = (lane == 0) || (lane == cur) || (lane == cur - 1);
      if (forced) v += (1u << 30);
      int rank = 0;
      for (int mth = 0; mth <= cur; ++mth) {
        unsigned vm = __builtin_amdgcn_readlane(v, mth);
        rank += (vm > v || (vm == v && mth < lane)) ? 1 : 0;
      }
      u64 msk = __ballot(valid && rank < 16);
      if (lane == 0) { sel[q] = msk; atomicOr(&uni[0], (unsigned)msk); atomicOr(&uni[1], (unsigned)(msk >> 32)); }
    }
    __syncthreads();
    const u64 selq = sel[ql];
    const u64 unim = ((u64)uni[1] << 32) | uni[0];
    nsa_load_q((const u16*)(ws + OFF_QR), row, hq, h, qf);

    for (int br = 1; br <= 2; ++br) {
      const u16* Kg = (br == 1 ? KS_g : KW_g) + (size_t)bg * S * 64;
      const u16* Vg = (br == 1 ? VS_g : VW_g) + (size_t)bg * S * 64;
      u64 tm;
      if (br == 1) tm = unim;
      else {
        int first = (t0 - 512) >> 6; if (first < 0) first = 0;
        tm = (~0ull >> (63 - cur)) & (~0ull << first);
      }
      m = 0.f; l = 0.f;
#pragma unroll
      for (int mb = 0; mb < 2; ++mb)
#pragma unroll
        for (int i = 0; i < 16; ++i) O[mb][i] = 0.f;
#define NSA_LD(KP, VP, nt) do { kreg = *(const uint4*)((KP) + (size_t)((nt) * 64 + lr) * 64 + lch * 8); \
                               vreg = *(const uint4*)((VP) + (size_t)((nt) * 64 + lr) * 64 + lch * 8); } while (0)
#define NSA_ST(bb) do { *(uint4*)(Kb + (bb) * 64 * KST + lr * KST + lch * 8) = kreg; *(uint4*)(Vb + (bb) * 64 * VST + lr * VST + lch * 8) = vreg; } while (0)
      int buf = 0;
      int n = __builtin_ctzll(tm);
      tm &= tm - 1;
      if (br == 1) NSA_LD(Kg, Vg, n);
      NSA_ST(0);
      int n1 = -1;
      if (tm) { n1 = __builtin_ctzll(tm); tm &= tm - 1; NSA_LD(Kg, Vg, n1); }
      bool wpre = false;
      __syncthreads();
      for (;;) {
        int n2 = -1;
        if (n1 >= 0) {
          NSA_ST(buf ^ 1);
          if (tm) { n2 = __builtin_ctzll(tm); tm &= tm - 1; NSA_LD(Kg, Vg, n2); }
        }
        if (br == 1 && n2 < 0 && !wpre) {
          int wf = (t0 - 512) >> 6; if (wf < 0) wf = 0;
          NSA_LD(KW_g + (size_t)bg * S * 64, VW_g + (size_t)bg * S * 64, wf);
          wpre = true;
        }
        const u16* Kt = Kb + buf * 64 * KST;
        const u16* Vt = Vb + buf * 64 * VST;
        int lo, hi = t;
        const bool lsel = (selq >> n) & 1;
        lo = (br == 1) ? -1 : t - 512;
        {
          const int kp0 = n * 64;
          const float init = (br == 2 || lsel) ? -m : NINF;
          bf16x8 fr8[8];
          k_load8<KST>(Kt, fr8, ql, h);
          f32x16 s0 = qk_mma(fr8, qf, init);
          f32x16 s1 = qk_mma(fr8 + 4, qf, init);
          pv_load<VST>(Vt, fr8, lane);
          float alpha; bool need;
          const bool interior = (kp0 + 63 <= t0) && (br == 1 || kp0 > t0 + 31 - 512);
          if (!interior) need = softmax_step64<true>(s0, s1, kp0 + 4 * h, lo, hi, m, l, alpha, pf, lane);
          else need = softmax_step64<false>(s0, s1, 0, 0, 0, m, l, alpha, pf, lane);
          if (need) {
#pragma unroll
            for (int mb = 0; mb < 2; ++mb)
#pragma unroll
              for (int i = 0; i < 16; ++i) O[mb][i] *= alpha;
          }
          pv_mma(fr8, pf, O);
          pv_load<VST>(Vt + 32 * VST, fr8 + 4, lane);
          pv_mma(fr8 + 4, pf + 2, O);
        }
        __syncthreads();
        if (n1 < 0) break;
        n = n1; n1 = n2; buf ^= 1;
      }
#undef NSA_LD
#undef NSA_ST
      l += shx(l, 32, lane);
      const float sc = (br == 1 ? g1 : g2) * ((l > 0.f) ? 1.f / l : 0.f);
#pragma unroll
      for (int mb = 0; mb < 2; ++mb)
#pragma unroll
        for (int i = 0; i < 16; i += 2) {
          const unsigned pk = outp[mb * 8 + (i >> 1)];
          const float a0 = sc * O[mb][i] + __uint_as_float(pk << 16), a1 = sc * O[mb][i + 1] + __uint_as_float(pk & 0xffff0000u);
          if (br == 1) outp[mb * 8 + (i >> 1)] = pack2(a0, a1);
          else { O[mb][i] = a0; O[mb][i + 1] = a1; }
        }
    }
#pragma unroll
    for (int mb = 0; mb < 2; ++mb)
#pragma unroll
      for (int a = 0; a < 4; ++a) {
        uint2 o; o.x = pack2(O[mb][4 * a], O[mb][4 * a + 1]); o.y = pack2(O[mb][4 * a + 2], O[mb][4 * a + 3]);
        *(uint2*)(Oout + row * D + hq * 64 + mb * 32 + 8 * a + 4 * h) = o;
      }
  }
}

DI void diff_attn_phase(const Params& p, char* smem, int j) {
  const int tid = get_tid(), w = tid >> 6, lane = tid & 63, ql = lane & 31, h = lane >> 5;
  char* ws = launder_ptr(p.ws);
  u16* K1b = (u16*)smem;
  u16* K2b = K1b + 2 * 64 * KST;
  u16* Vb = K2b + 2 * 64 * KST;
  u16* Qs = Vb + 2 * 64 * VDS + w * (2 * 32 * KST);
  const int layer = 2 + j;
  const float lambda_init = (layer == 2) ? 0.47071301834f : 0.55605820415f;
  float lam;
  {
    float a = p.in[21][j * 64 + lane] * p.in[22][j * 64 + lane];
    float c = p.in[23][j * 64 + lane] * p.in[24][j * 64 + lane];
#pragma unroll
    for (int o = 32; o > 0; o >>= 1) { a += shx(a, o, lane); c += shx(c, o, lane); }
    lam = expf(a) - expf(c) + lambda_init;
  }
  const u16* QD = (const u16*)(ws + OFF_PROJ);
  u16* Oout = (u16*)(ws + OFF_QR);
  const float* sg = p.in[25] + j * 128;

  for (int item = blockIdx.x; item < 1024; item += gridDim.x) {
    const int rnd = item >> 8, j256 = item & 255;
    const int bh = j256 & 63, kq = j256 >> 6;
    const int qb = (rnd == 0) ? kq : (rnd == 1) ? 15 - kq : (rnd == 2) ? 4 + kq : 11 - kq;
    const int b = bh >> 3, hd = bh & 7;
    const int t0 = qb * 256 + w * 32, t = t0 + ql;
    const long row = (long)b * S + t;
    const u16* K1g = (const u16*)(ws + OFF_KD) + ((size_t)((b * 2 + 0) * 8 + hd)) * S * 64;
    const u16* K2g = (const u16*)(ws + OFF_KD) + ((size_t)((b * 2 + 1) * 8 + hd)) * S * 64;
    const u16* Vg = (const u16*)(ws + OFF_VD) + ((size_t)(b * 8 + hd)) * S * 128;
#pragma unroll
    for (int ks = 0; ks < 4; ++ks) {
      bf16x8 qa = *(const bf16x8*)(QD + row * D + hd * 64 + ks * 16 + h * 8);
      bf16x8 qb2 = *(const bf16x8*)(QD + row * D + 512 + hd * 64 + ks * 16 + h * 8);
      *(bf16x8*)(Qs + ql * KST + ks * 16 + h * 8) = qa;
      *(bf16x8*)(Qs + 32 * KST + ql * KST + ks * 16 + h * 8) = qb2;
    }
    f32x16 O1[4], O2[4];
#pragma unroll
    for (int mb = 0; mb < 4; ++mb)
#pragma unroll
      for (int i = 0; i < 16; ++i) { O1[mb][i] = 0.f; O2[mb][i] = 0.f; }
    float m1 = 0.f, l1 = 0.f, m2 = 0.f, l2 = 0.f;
    const int ntile = (qb + 1) * 4;
    const int lr = tid >> 3, lch = tid & 7;
    uint4 k1r, k2r;
    __syncthreads();
    {
      k1r = *(const uint4*)(K1g + (size_t)lr * 64 + lch * 8);
      k2r = *(const uint4*)(K2g + (size_t)lr * 64 + lch * 8);
      *(uint4*)(K1b + lr * KST + lch * 8) = k1r;
      *(uint4*)(K2b + lr * KST + lch * 8) = k2r;
      k1r = *(const uint4*)(Vg + (size_t)lr * 128 + lch * 8);
      k2r = *(const uint4*)(Vg + (size_t)lr * 128 + 64 + lch * 8);
      *(uint4*)(Vb + lr * VDS + lch * 8) = k1r;
      *(uint4*)(Vb + lr * VDS + 64 + lch * 8) = k2r;
      if (ntile > 1) {
        k1r = *(const uint4*)(Vg + (size_t)(64 + lr) * 128 + lch * 8);
        k2r = *(const uint4*)(Vg + (size_t)(64 + lr) * 128 + 64 + lch * 8);
      }
    }
    __syncthreads();
    int buf = 0;
    for (int n = 0; n < ntile; ++n) {
      const bool more = (n + 1 < ntile);
      if (more) {
        const int nb = buf ^ 1, k0 = (n + 1) * 64;
        *(uint4*)(Vb + nb * 64 * VDS + lr * VDS + lch * 8) = k1r;
        *(uint4*)(Vb + nb * 64 * VDS + lr * VDS + 64 + lch * 8) = k2r;
        k1r = *(const uint4*)(K1g + (size_t)(k0 + lr) * 64 + lch * 8);
        k2r = *(const uint4*)(K2g + (size_t)(k0 + lr) * 64 + lch * 8);
      }
      const u16* K1t = K1b + buf * 64 * KST;
      const u16* K2t = K2b + buf * 64 * KST;
      const u16* Vt = Vb + buf * 64 * VDS;
#pragma unroll
      for (int sub = 0; sub < 2; ++sub) {
        if (sub == 1 && more) {
          const int nb = buf ^ 1, k0 = (n + 2) * 64;
          *(uint4*)(K1b + nb * 64 * KST + lr * KST + lch * 8) = k1r;
          *(uint4*)(K2b + nb * 64 * KST + lr * KST + lch * 8) = k2r;
          if (n + 2 < ntile) {
            k1r = *(const uint4*)(Vg + (size_t)(k0 + lr) * 128 + lch * 8);
            k2r = *(const uint4*)(Vg + (size_t)(k0 + lr) * 128 + 64 + lch * 8);
          }
        }
        const int kp0 = n * 64 + sub * 32;
        if (kp0 > t0 + 31) continue;
        bf16x8 pf1[2], pf2[2];
        {
          f32x16 sA = qk_tile_lds<KST>(K1t + sub * 32 * KST, Qs, ql, h, -m1);
          f32x16 sB = qk_tile_lds<KST>(K2t + sub * 32 * KST, Qs + 32 * KST, ql, h, -m2);
          float alpha1, alpha2; bool need1, need2;
          if (kp0 + 31 <= t0) {
            need1 = softmax_step<false>(sA, 0, 0, 0, m1, l1, alpha1, pf1, lane);
            need2 = softmax_step<false>(sB, 0, 0, 0, m2, l2, alpha2, pf2, lane);
          } else {
            need1 = softmax_step<true>(sA, kp0 + 4 * h, -1, t, m1, l1, alpha1, pf1, lane);
            need2 = softmax_step<true>(sB, kp0 + 4 * h, -1, t, m2, l2, alpha2, pf2, lane);
          }
          if (need1 || need2) {
#pragma unroll
            for (int mb = 0; mb < 4; ++mb)
#pragma unroll
              for (int i = 0; i < 16; ++i) { O1[mb][i] *= alpha1; O2[mb][i] *= alpha2; }
          }
        }
        {
          const int l16 = lane & 15, tq = l16 >> 2, tp = l16 & 3, blk = (lane >> 4) & 1;
          const u16* vbase = Vt + (sub * 32 + 4 * h + tq) * VDS + 16 * blk + 4 * tp;
#pragma unroll
          for (int mb = 0; mb < 4; ++mb)
#pragma unroll
            for (int s2 = 0; s2 < 2; ++s2) {
              s16x4 lo = tr_read(vbase + (16 * s2) * VDS + mb * 32);
              s16x4 hi = tr_read(vbase + (16 * s2 + 8) * VDS + mb * 32);
              bf16x8 a = __builtin_shufflevector(lo, hi, 0, 1, 2, 3, 4, 5, 6, 7);
              O1[mb] = mfma32(a, pf1[s2], O1[mb]);
              O2[mb] = mfma32(a, pf2[s2], O2[mb]);
            }
        }
      }
      __syncthreads();
      buf ^= 1;
    }
    l1 += shx(l1, 32, lane); l2 += shx(l2, 32, lane);
    const float i1 = 1.f / l1, i2 = lam / l2;
    float ss = 0.f;
#pragma unroll
    for (int mb = 0; mb < 4; ++mb)
#pragma unroll
      for (int i = 0; i < 16; ++i) { float o = O1[mb][i] * i1 - O2[mb][i] * i2; O1[mb][i] = o; ss += o * o; }
    ss += shx(ss, 32, lane);
    const float rn = rsqrtf(ss * (1.f / 128.f) + 1e-5f) * (1.f - lambda_init);
#pragma unroll
    for (int mb = 0; mb < 4; ++mb)
#pragma unroll
      for (int a = 0; a < 4; ++a) {
        const int dv = mb * 32 + 8 * a + 4 * h;
        float4 gg = *(const float4*)(sg + dv);
        uint2 o;
        o.x = pack2(O1[mb][4 * a] * rn * gg.x, O1[mb][4 * a + 1] * rn * gg.y);
        o.y = pack2(O1[mb][4 * a + 2] * rn * gg.z, O1[mb][4 * a + 3] * rn * gg.w);
        *(uint2*)(Oout + row * D + hd * 128 + dv) = o;
      }
  }
}


#define XB_TMO      128
#define XB_XCNT(j)  (256  + 64 * (j))
#define XB_XSUB(j)  (1280 + 64 * (j))
#define XB_XGEN(j)  (2304 + 64 * (j))
#define XB_TOP      3328
#define XB_TOPGEN   3392
#define XCD_BAR_WORDS 3456
#define XB_SPIN_CAP (1u << 22)
DI unsigned xb_ld(unsigned* p) { return __hip_atomic_load(p, __ATOMIC_RELAXED, __HIP_MEMORY_SCOPE_AGENT); }
DI unsigned xb_add(unsigned* p, unsigned v) { return __hip_atomic_fetch_add(p, v, __ATOMIC_RELAXED, __HIP_MEMORY_SCOPE_AGENT); }
DI unsigned xb_xcc_id() { return (unsigned)__builtin_amdgcn_s_getreg((3 << 11) | 20) & 0xFu; }
#define XB_SPIN(cond, bar) do { unsigned _sp = 0; while (cond) { __builtin_amdgcn_s_sleep(1); \
    if ((++_sp & 255u) == 0u) { if (xb_ld(&(bar)[XB_TMO])) break; if (_sp > XB_SPIN_CAP) { atomicAdd(&(bar)[XB_TMO], 1u); break; } } } } while (0)
struct XcdBarrier { unsigned* bar; unsigned x; volatile LAS unsigned* st; };
DI XcdBarrier xcd_barrier_post(unsigned* bar, volatile LAS unsigned* st) {
  XcdBarrier b; b.bar = bar; b.x = xb_xcc_id(); b.st = st;
  if (get_tid() == 0) (void)xb_add(&bar[XB_XCNT(b.x)], 1u);
  return b;
}
DI void xcd_barrier_complete(unsigned* bar, unsigned x, unsigned& nloc, unsigned& nx) {
  const unsigned G = gridDim.x * gridDim.y * gridDim.z;
  unsigned sum, cnt, mine, sp = 0u;
  for (;;) {
    sum = 0u; cnt = 0u; mine = 0u;
#pragma unroll
    for (unsigned j = 0; j < 16; ++j) { const unsigned c = xb_ld(&bar[XB_XCNT(j)]); sum += c; cnt += (c > 0u) ? 1u : 0u; mine = (j == x) ? c : mine; }
    if (sum == G) break;
    __builtin_amdgcn_s_sleep(1);
    if ((++sp & 255u) == 0u) { if (xb_ld(&bar[XB_TMO])) break; if (sp > XB_SPIN_CAP) { atomicAdd(&bar[XB_TMO], 1u); break; } }
  }
  nloc = mine > 0u ? mine : 1u; nx = cnt > 0u ? cnt : 1u;
}
DI void xcd_barrier(const XcdBarrier& b) {
  asm volatile("s_waitcnt vmcnt(0)" ::: "memory");
  __syncthreads();
  if (get_tid() == 0) {
    unsigned* bar = b.bar;
    __builtin_amdgcn_s_waitcnt(0);
    unsigned nloc = b.st[0], nx = b.st[1];
    if (nloc == 0u) { xcd_barrier_complete(bar, b.x, nloc, nx); b.st[0] = nloc; b.st[1] = nx; }
    const unsigned old = xb_add(&bar[XB_XSUB(b.x)], 1u);
    const unsigned gen = old / nloc;
    if (old + 1u == (gen + 1u) * nloc) {
      __builtin_amdgcn_fence(__ATOMIC_RELEASE, "agent");
      asm volatile("s_waitcnt vmcnt(0)" ::: "memory");
      const unsigned og = xb_add(&bar[XB_TOP], 1u);
      const unsigned tg = og / nx;
      if (og + 1u == (tg + 1u) * nx) xb_add(&bar[XB_TOPGEN], 1u);
      else XB_SPIN(xb_ld(&bar[XB_TOPGEN]) == tg, bar);
      __builtin_amdgcn_fence(__ATOMIC_ACQUIRE, "agent");
      xb_add(&bar[XB_XGEN(b.x)], 1u);
      asm volatile("s_waitcnt vmcnt(0)" ::: "memory");
    } else {
      XB_SPIN(xb_ld(&bar[XB_XGEN(b.x)]) == gen, bar);
      __builtin_amdgcn_fence(__ATOMIC_ACQUIRE, "agent");
      asm volatile("s_waitcnt vmcnt(0)" ::: "memory");
    }
  }
  __syncthreads();
}

__global__ void __launch_bounds__(NTHR) mega(Params p, int ph_lo, int ph_hi, int coop) {
  extern __shared__ __attribute__((aligned(16))) char smem[];
  cg::grid_group grid = cg::this_grid();
  volatile LAS unsigned* xst = (volatile LAS unsigned*)(smem + SMEM_BYTES - 16);
  if (get_tid() == 0) { xst[0] = 0u; xst[1] = 0u; }
  __syncthreads();
  const XcdBarrier xb = xcd_barrier_post((unsigned*)(p.ws + OFF_BAR), xst);
  int ph = 0;
  if (ph_hi < 0) grid.sync();
  if (ph >= ph_lo && ph < ph_hi) { prep_phase(p, smem); if (coop && ph + 1 < ph_hi) xcd_barrier(xb); }
  ++ph;
  for (int l = 0; l < 4; ++l) {
    for (int st = 0; st < 12; ++st) {
      if (st == 4 && l >= 2) continue;
      if (st == 11 && l != 1) continue;
      if (st == 2 || st == 7 || st == 10) continue;
      if (ph >= ph_lo && ph < ph_hi) {
        char* wsl = launder_ptr(p.ws);
        char* wb = layer_w(wsl, l);
        char* mb = wb + 2 * (SZ_WGU + SZ_WD);
        const u16* XB = (const u16*)(wsl + OFF_XB);
        const u16* HB = (const u16*)(wsl + OFF_H);
        int kind = 0;
        const u16* A = XB; const u16* Bt = nullptr; int N = D, K = D, mode = EPI_RESID; float coef = 1.f; int lni = 0;
        switch (st) {
          case 0: Bt = (const u16*)wb; N = 2 * F; mode = EPI_GATEUP; break;
          case 1: A = HB; Bt = (const u16*)(wb + SZ_WGU); K = F; coef = 0.5f; lni = l * 3; break;
          case 2: kind = 1; lni = l * 3; break;
          case 3: Bt = (const u16*)mb; if (l < 2) { N = 2048; mode = EPI_NSA_IN; } else { mode = EPI_DIFF_Q; } break;
          case 4: kind = 2; break;
          case 5: kind = (l < 2) ? 3 : 4; break;
          case 6: A = (const u16*)(wsl + (l < 2 ? OFF_PROJ : OFF_QR)); Bt = (const u16*)(mb + (l < 2 ? 4194304 : 2097152)); lni = l * 3 + 1; break;
          case 7: kind = 1; lni = l * 3 + 1; break;
          case 8: Bt = (const u16*)(wb + SZ_WGU + SZ_WD); N = 2 * F; mode = EPI_GATEUP; break;
          case 9: A = HB; Bt = (const u16*)(wb + SZ_WGU + SZ_WD + SZ_WGU); K = F; coef = 0.5f; lni = l * 3 + 2; break;
          case 10: kind = 1; lni = l * 3 + 2; break;
          default: Bt = (const u16*)(wsl + OFF_WKV); N = 2048; mode = EPI_DIFF_KV; break;
        }
        if (kind == 0) gemm_phase(p, smem, A, Bt, N, K, mode, coef, lni, p.in[7] + (size_t)lni * D, p.in[8] + (size_t)lni * D);
        else if (kind == 2) compress_phase(p, smem, l);
        else if (kind == 3) nsa_attn_phase(p, smem);
        else diff_attn_phase(p, smem, l - 2);
        if (coop && ph + 1 < ph_hi) xcd_barrier(xb);
      }
      ++ph;
    }
  }
}

extern "C" void kernel_launch(void* const* d_in, const int* in_sizes, int n_in, void* d_out, int out_size, void* d_ws,
                              size_t ws_size, hipStream_t stream) {
  if (n_in < 27 || ws_size < WS_NEED) { fprintf(stderr, "bad args: n_in %d ws %zu need %zu\n", n_in, ws_size, (size_t)WS_NEED); return; }
  Params p{};
  for (int i = 0; i < 27; ++i) p.in[i] = (const float*)d_in[i];
  p.out = (float*)d_out;
  p.ws = (char*)d_ws;
  static int grid_blocks = 0;
  (void)hipFuncSetAttribute((const void*)mega, hipFuncAttributeMaxDynamicSharedMemorySize, SMEM_BYTES);
  if (!grid_blocks) {
    int dev = 0, cus = 0, per_cu = 0;
    (void)hipGetDevice(&dev);
    (void)hipDeviceGetAttribute(&cus, hipDeviceAttributeMultiprocessorCount, dev);
    (void)hipOccupancyMaxActiveBlocksPerMultiprocessor(&per_cu, mega, NTHR, SMEM_BYTES);
    if (per_cu < 1) per_cu = 1;
    grid_blocks = cus;
    if (grid_blocks % 8) grid_blocks -= grid_blocks % 8;
  }
  (void)hipMemsetAsync((char*)d_ws + OFF_BAR, 0, 16384 + 32768, stream);
  int lo = 0, hi = 1000, coop = 1;
  void* args[] = {&p, &lo, &hi, &coop};
  hipError_t e = hipLaunchCooperativeKernel((const void*)mega, dim3(grid_blocks), dim3(NTHR), args, SMEM_BYTES, stream);
  if (e != hipSuccess) fprintf(stderr, "cooperative launch failed: %s (grid %d)\n", hipGetErrorString(e), grid_blocks);
}
```

```cpp
#include <hip/hip_runtime.h>
#include <hip/hip_cooperative_groups.h>
#include <cstdio>
namespace cg = cooperative_groups;

#define DI __device__ __forceinline__
typedef unsigned short u16;
typedef unsigned long long u64;
using bf16x8 = __attribute__((ext_vector_type(8))) short;
using s16x4 = __attribute__((ext_vector_type(4))) short;
using f32x4 = __attribute__((ext_vector_type(4))) float;
using f32x16 = __attribute__((ext_vector_type(16))) float;
using f32x2 = __attribute__((ext_vector_type(2))) float;
using bf16v2 = __attribute__((ext_vector_type(2))) __bf16;

constexpr int NB = 8, S = 4096, M = NB * S, D = 1024, F = 2816;
constexpr int NTHR = 512;
constexpr int SMEM_BYTES = 155648;
constexpr float ALPHA = 1.681792830507429f;
constexpr float NEGF = -1e30f;

constexpr size_t OFF_XB = 0;
constexpr size_t OFF_H = 67108864;
constexpr size_t OFF_KV = OFF_H + 184549376;
constexpr size_t OFF_W = OFF_KV + 134217728;
constexpr size_t SZ_WGU = 11534336, SZ_WD = 5767168;
constexpr size_t LW_A = 41943040, LW_B = 38797312;
constexpr size_t OFF_WKV = OFF_W + 2 * LW_B;
constexpr size_t OFF_SEG = OFF_WKV + 4194304;
constexpr size_t SZ_SEG = 8388608;
constexpr size_t OFF_GATES = OFF_SEG + 6 * SZ_SEG;
constexpr size_t OFF_KCMP = OFF_GATES + 6291456;
constexpr size_t OFF_VCMPT = OFF_KCMP + 524288;
constexpr size_t OFF_ROPE = OFF_VCMPT + 524288;
constexpr size_t OFF_B1P = OFF_ROPE + 262144;
constexpr size_t OFF_BAR = OFF_B1P + 4096;
constexpr size_t OFF_CNT = OFF_BAR + 16384;
constexpr size_t OFF_SLOTS = OFF_CNT + 32768;
constexpr size_t WS_NEED = OFF_SLOTS + 1048576;
constexpr size_t OFF_PROJ = OFF_H;
constexpr size_t OFF_QR = OFF_H + 67108864;
constexpr size_t OFF_PARK = OFF_H + 134217728;
constexpr size_t OFF_KD = OFF_KV;
constexpr size_t OFF_VD = OFF_KV + 67108864;

struct Params {
  const float* in[27];
  float* out;
  char* ws;
};

struct Params;
typedef __attribute__((address_space(1))) char gchar_t;
DI char* launder_ptr(char* w) { gchar_t* g = (gchar_t*)w; asm volatile("" : "+s"(g)); return (char*)g; }
DI int get_tid() { int t = threadIdx.x; asm volatile("" : "+v"(t)); return t; }
DI float shx(float v, int mask, int lane) { return __int_as_float(__builtin_amdgcn_ds_bpermute((lane ^ mask) << 2, __float_as_int(v))); }
DI u16 f2bf(float x) { return __builtin_bit_cast(u16, (__bf16)x); }
DI unsigned pack2(float a, float b) {
  f32x2 v = {a, b};
  return __builtin_bit_cast(unsigned, __builtin_convertvector(v, bf16v2));
}
DI float bf2f(u16 v) { return __uint_as_float(((unsigned)v) << 16); }
DI f32x16 mfma32(bf16x8 a, bf16x8 b, f32x16 c) { return __builtin_amdgcn_mfma_f32_32x32x16_bf16(a, b, c, 0, 0, 0); }

DI char* layer_w(char* ws, int l) { return l < 2 ? ws + OFF_KV + (size_t)l * LW_A : ws + OFF_W + (size_t)(l - 2) * LW_B; }

struct Task { const float* src; u16* dst; int K, Nsrc, Ndst, mode; };
DI Task get_task(const Params& p, int task) {
  Task t; t.src = nullptr; t.dst = nullptr; t.K = 0; t.Nsrc = 0; t.Ndst = 0; t.mode = 0;
  if (task == 40) { t.src = p.in[19]; t.dst = (u16*)(p.ws + OFF_WKV); t.K = 1024; t.Nsrc = 2048; t.Ndst = 2048; return t; }
  int l = task / 10, k = task % 10;
  char* wb = layer_w(p.ws, l);
  if (k < 6) {
    int f2 = k / 3, kk = k % 3;
    const float* src = p.in[1 + f2 * 3 + kk];
    if (kk < 2) { t.src = src + (size_t)l * D * F; t.dst = (u16*)(wb + f2 * (SZ_WGU + SZ_WD)); t.K = D; t.Nsrc = F; t.Ndst = F; t.mode = 1 + kk; }
    else { t.src = src + (size_t)l * F * D; t.dst = (u16*)(wb + f2 * (SZ_WGU + SZ_WD) + SZ_WGU); t.K = F; t.Nsrc = D; t.Ndst = D; }
    return t;
  }
  char* mb = wb + 2 * (SZ_WGU + SZ_WD);
  if (l < 2) {
    if (k == 6) { t.src = p.in[9] + (size_t)l * D * 1840; t.dst = (u16*)mb; t.K = D; t.Nsrc = 1840; t.Ndst = 2048; }
    else if (k == 7) { t.src = p.in[18] + (size_t)l * D * D; t.dst = (u16*)(mb + 4194304); t.K = D; t.Nsrc = D; t.Ndst = D; }
    else if (k == 8) { t.src = p.in[11] + (size_t)l * 2048 * 128; t.dst = (u16*)(mb + 4194304 + 2097152); t.K = 2048; t.Nsrc = 128; t.Ndst = 128; }
    else { t.src = p.in[15] + (size_t)l * 2048 * 128; t.dst = (u16*)(mb + 4194304 + 2097152 + 524288); t.K = 2048; t.Nsrc = 128; t.Ndst = 128; }
  } else {
    int j = l - 2;
    if (k == 6) { t.src = p.in[20] + (size_t)j * D * D; t.dst = (u16*)mb; t.K = D; t.Nsrc = D; t.Ndst = D; }
    else if (k == 7) { t.src = p.in[26] + (size_t)j * D * D; t.dst = (u16*)(mb + 2097152); t.K = D; t.Nsrc = D; t.Ndst = D; }
  }
  return t;
}

DI void prep_phase(const Params& p, char* smem) {
  const int tid = get_tid();
  float* T = (float*)smem;
  {
    for (int gt = blockIdx.x; gt < 5056; gt += gridDim.x) {
      int task, tile;
      if (gt >= 4928) { task = 40; tile = gt - 4928; }
      else {
        int l, r;
        if (gt < 2560) { l = gt / 1280; r = gt - l * 1280; } else { l = 2 + (gt - 2560) / 1184; r = (gt - 2560) % 1184; }
        if (r < 1056) { task = l * 10 + r / 176; tile = r % 176; }
        else {
          r -= 1056;
          if (l < 2) { if (r < 128) { task = l * 10 + 6; tile = r; } else if (r < 192) { task = l * 10 + 7; tile = r - 128; } else if (r < 208) { task = l * 10 + 8; tile = r - 192; } else { task = l * 10 + 9; tile = r - 208; } }
          else { if (r < 64) { task = l * 10 + 6; tile = r; } else { task = l * 10 + 7; tile = r - 64; } }
        }
      }
      Task t = get_task(p, task);
      const int nkt = t.K / 256;
      const int k0 = (tile % nkt) * 256, n0 = (tile / nkt) * 64;
      __syncthreads();
      float4 v[8];
#pragma unroll
      for (int e = 0; e < 8; ++e) {
        int idx = tid + e * 512, kk = idx >> 4, n4 = (idx & 15) * 4;
        v[e] = (n0 + n4 < t.Nsrc) ? *(const float4*)(t.src + (size_t)(k0 + kk) * t.Nsrc + n0 + n4) : make_float4(0.f, 0.f, 0.f, 0.f);
      }
#pragma unroll
      for (int e = 0; e < 8; ++e) {
        int idx = tid + e * 512, kk = idx >> 4, n4 = (idx & 15) * 4;
        T[(n4 + 0) * 257 + kk] = v[e].x; T[(n4 + 1) * 257 + kk] = v[e].y; T[(n4 + 2) * 257 + kk] = v[e].z; T[(n4 + 3) * 257 + kk] = v[e].w;
      }
      __syncthreads();
      const int nn = tid >> 3;
      int n = n0 + nn;
      int drow = t.mode == 0 ? n : ((n >> 7) * 256 + (t.mode - 1) * 128 + (n & 127));
#pragma unroll
      for (int j = 0; j < 4; ++j) {
        const int kc = (tid & 7) * 8 + j * 64;
        const float* tp = T + nn * 257 + kc;
        uint4 o;
        o.x = pack2(tp[0], tp[1]); o.y = pack2(tp[2], tp[3]); o.z = pack2(tp[4], tp[5]); o.w = pack2(tp[6], tp[7]);
        *(uint4*)(t.dst + (size_t)drow * t.K + k0 + kc) = o;
      }
    }
  }
  {
    const float4* xs = (const float4*)p.in[0];
    uint4* xb = (uint4*)(p.ws + OFF_XB);
    u16* lo = (u16*)p.out;
    const size_t n8 = (size_t)M * D / 8;
    const size_t stride = (size_t)gridDim.x * NTHR;
    for (size_t i = (size_t)blockIdx.x * NTHR + tid; i < n8; i += 4 * stride) {
      float4 va[4], vb[4];
#pragma unroll
      for (int j = 0; j < 4; ++j) { va[j] = xs[2 * (i + j * stride)]; vb[j] = xs[2 * (i + j * stride) + 1]; }
#pragma unroll
      for (int j = 0; j < 4; ++j) {
        const size_t e = i + j * stride;
        uint4 o; o.x = pack2(va[j].x, va[j].y); o.y = pack2(va[j].z, va[j].w); o.z = pack2(vb[j].x, vb[j].y); o.w = pack2(vb[j].z, vb[j].w);
        xb[e] = o;
        uint4 lw;
        lw.x = ((__float_as_uint(va[j].x) - (o.x << 16)) & 0xffffu) | ((__float_as_uint(va[j].y) - (o.x & 0xffff0000u)) << 16);
        lw.y = ((__float_as_uint(va[j].z) - (o.y << 16)) & 0xffffu) | ((__float_as_uint(va[j].w) - (o.y & 0xffff0000u)) << 16);
        lw.z = ((__float_as_uint(vb[j].x) - (o.z << 16)) & 0xffffu) | ((__float_as_uint(vb[j].y) - (o.z & 0xffff0000u)) << 16);
        lw.w = ((__float_as_uint(vb[j].z) - (o.w << 16)) & 0xffffu) | ((__float_as_uint(vb[j].w) - (o.w & 0xffff0000u)) << 16);
        const size_t row = e >> 7, c8 = e & 127;
        *(uint4*)(lo + row * 2048 + 1024 + c8 * 8) = lw;
      }
    }
  }
  {
    float2* rt = (float2*)(p.ws + OFF_ROPE);
    for (int i = blockIdx.x * NTHR + tid; i < 4096 * 8; i += gridDim.x * NTHR) {
      int pos = i >> 3, k = i & 7;
      float inv = (float)pow(500000.0, -(double)k / 8.0);
      float ang = (float)pos * inv;
      rt[i] = make_float2((float)cos((double)ang), (float)sin((double)ang));
    }
  }
  if (blockIdx.x < 4 && tid < 128) {
    int l = blockIdx.x >> 1, kv = blockIdx.x & 1;
    const float* pos = p.in[kv ? 14 : 10] + (size_t)l * 2048;
    const float* w1 = p.in[kv ? 15 : 11] + (size_t)l * 2048 * 128;
    const float* b1 = p.in[kv ? 16 : 12] + (size_t)l * 128;
    float acc = b1[tid];
    for (int i = 0; i < 2048; ++i) acc += pos[i] * w1[(size_t)i * 128 + tid];
    ((float*)(p.ws + OFF_B1P))[(l * 2 + kv) * 128 + tid] = acc;
  }
}

#define LAS __attribute__((address_space(3)))
constexpr int BM = 256, BK = 64, HALF = 128, HTB = HALF * BK * 2;

DI int lds_byte(int r, int c) {
  const int st = (r >> 4) * 2 + (c >> 5), rr = r & 15, cc = c & 31, ob = rr * 64 + cc * 2;
  return st * 1024 + (ob ^ (((ob >> 9) & 1) << 5));
}
DI void stage_rc(int b, int& R, int& C) {
  const int st = b / 1024, sb = b % 1024, swz = sb ^ (((sb >> 9) & 1) << 5);
  R = (st >> 1) * 16 + swz / 64; C = (st & 1) * 32 + (swz % 64) / 2;
}
DI int perm32(int rho) { const int n = rho >> 4, i = rho & 15; return 8 * (i >> 2) + 4 * n + (i & 3); }

enum { EPI_GATEUP = 0, EPI_RESID = 1, EPI_NSA_IN = 2, EPI_DIFF_Q = 3, EPI_DIFF_KV = 4 };

DI bool unit_next(int i, int nM, int nN, int& pm, int& pn) {
  const int nwg = nM * nN;
  const long L = (long)i * gridDim.x + blockIdx.x;
  if (L >= nwg) return false;
  int wgid = (int)L;
  { const int q = nwg / 8, r = nwg % 8, xcd = wgid % 8, off = wgid / 8; wgid = (xcd < r ? xcd * (q + 1) : r * (q + 1) + (xcd - r) * q) + off; }
  const int nig = 8 * nN, gid = wgid / nig, fm = gid * 8, gsz = (nM - fm) < 8 ? (nM - fm) : 8;
  pm = fm + ((wgid % nig) % gsz); pn = (wgid % nig) / gsz;
  return true;
}

DI void rope8(float* v, int fq, int pos, const float* rt, int lane) {
  float o[8];
#pragma unroll
  for (int i = 0; i < 8; ++i) o[i] = shx(v[i], 16, lane);
  if (fq < 2) {
    const float4* r4 = (const float4*)(rt + pos * 16);
#pragma unroll
    for (int i = 0; i < 4; ++i) {
      float4 cs = r4[i];
      float a0 = v[2 * i], a1 = v[2 * i + 1];
      if (fq == 0) { v[2 * i] = a0 * cs.x - o[2 * i] * cs.y; v[2 * i + 1] = a1 * cs.z - o[2 * i + 1] * cs.w; }
      else { v[2 * i] = o[2 * i] * cs.y + a0 * cs.x; v[2 * i + 1] = o[2 * i + 1] * cs.w + a1 * cs.z; }
    }
  }
}
DI uint4 pack8(const float* v) {
  uint4 o; o.x = pack2(v[0], v[1]); o.y = pack2(v[2], v[3]); o.z = pack2(v[4], v[5]); o.w = pack2(v[6], v[7]);
  return o;
}

DI void gemm_epi(const Params& p, int mode, float coef, const f32x4 (&acc)[2][2][4][2], int pm, int pn, int wr, int wc, int fr, int fq) {
  char* ws = launder_ptr(p.ws);
  const float* rt = (const float*)(ws + OFF_ROPE);
#pragma unroll
  for (int ai = 0; ai < 2; ++ai)
#pragma unroll
    for (int m = 0; m < 4; ++m) {
      const int row = pm * BM + ai * HALF + wr * 64 + m * 16 + fr;
      const int b = row >> 12, s = row & 4095;
      if (mode == EPI_GATEUP) {
        float v[8];
#pragma unroll
        for (int n = 0; n < 2; ++n)
#pragma unroll
          for (int e = 0; e < 4; ++e) {
            float gv = acc[ai][0][m][n][e], uv = acc[ai][1][m][n][e];
            v[n * 4 + e] = gv * uv * __builtin_amdgcn_rcpf(1.f + __builtin_amdgcn_exp2f(-1.4426950408889634f * gv));
          }
        *(uint4*)((u16*)(ws + OFF_H) + (size_t)row * F + pn * 128 + wc * 32 + 8 * fq) = pack8(v);
      } else if (mode == EPI_RESID) {
#pragma unroll
        for (int bj = 0; bj < 2; ++bj)
#pragma unroll
          for (int n = 0; n < 2; ++n) {
            float4* xp = (float4*)(p.out + (size_t)row * D + pn * BM + bj * HALF + wc * 32 + 16 * n + 4 * fq);
            float4 x = *xp; f32x4 a = acc[ai][bj][m][n];
            x.x = ALPHA * x.x + coef * a[0]; x.y = ALPHA * x.y + coef * a[1]; x.z = ALPHA * x.z + coef * a[2]; x.w = ALPHA * x.w + coef * a[3];
            *xp = x;
          }
      } else {
#pragma unroll
        for (int bj = 0; bj < 2; ++bj) {
          const int cb = pn * BM + bj * HALF + wc * 32, c = cb + 8 * fq;
          const bool head0 = (wc & 1) == 0;
          float v[8];
#pragma unroll
          for (int e = 0; e < 4; ++e) { v[e] = acc[ai][bj][m][0][e]; v[4 + e] = acc[ai][bj][m][1][e]; }
          if (mode == EPI_NSA_IN) {
            if (cb < 1024) {
#pragma unroll
              for (int e = 0; e < 8; ++e) v[e] *= 0.18033688011112042f;
              *(uint4*)((u16*)(ws + OFF_PROJ) + (size_t)row * D + c) = pack8(v);
            } else if (cb < 1792) {
              const int seg = (cb - 1024) >> 7, g = ((cb - 1024) >> 6) & 1, d = c & 63;
              if (head0 && (seg == 2 || seg == 4)) rope8(v, fq, s, rt, fq * 16 + fr);
              *(uint4*)((u16*)(ws + OFF_SEG + (size_t)seg * SZ_SEG) + ((size_t)(b * 2 + g) * S + s) * 64 + d) = pack8(v);
            } else if (c < 1840) {
              float4* gp = (float4*)((float*)(ws + OFF_GATES) + (size_t)row * 48 + (c - 1792));
              gp[0] = make_float4(v[0], v[1], v[2], v[3]); gp[1] = make_float4(v[4], v[5], v[6], v[7]);
            }
          } else if (mode == EPI_DIFF_Q) {
#pragma unroll
            for (int e = 0; e < 8; ++e) v[e] *= 0.18033688011112042f;
            if (head0) rope8(v, fq, s, rt, fq * 16 + fr);
            *(uint4*)((u16*)(ws + OFF_PROJ) + (size_t)row * D + c) = pack8(v);
          } else {
            if (cb < 1024) {
              const int which = cb >> 9, hd = (cb >> 6) & 7, d = c & 63;
              if (head0) rope8(v, fq, s, rt, fq * 16 + fr);
              *(uint4*)((u16*)(ws + OFF_KD) + ((size_t)((b * 2 + which) * 8 + hd) * S + s) * 64 + d) = pack8(v);
            } else {
              const int e0 = c - 1024, hd = e0 >> 7, dv = e0 & 127;
              *(uint4*)((u16*)(ws + OFF_VD) + ((size_t)(b * 8 + hd) * S + s) * 128 + dv) = pack8(v);
            }
          }
        }
      }
    }
}


DI void fused_ln_epi(const Params& p, char* smem, float coef, f32x4 (&acc)[2][2][4][2], int pm, int pn, int wr, int wc, int fr, int fq,
                     int tid, int lnk, const float* g, const float* bt) {
  const int lane = fq * 16 + fr;
  char* ws = launder_ptr(p.ws); float* xout = (float*)launder_ptr((char*)p.out);
  u16* xb = (u16*)(ws + OFF_XB);
  u16* xlo = (u16*)xout;
  float2* P = (float2*)smem;
  float2* Sx = P + 1024;
  u64* slots = (u64*)(ws + OFF_SLOTS);
  unsigned* cnt = (unsigned*)(ws + OFF_CNT);
  int rl0 = wr * 64 + fr;
  asm volatile("" : "+v"(rl0));
  const int coff = pn * BM + wc * 32 + 8 * fq;
#pragma unroll
  for (int ai = 0; ai < 2; ++ai) {
    uint4 hreg[4][2], lreg[4][2];
#pragma unroll
    for (int m = 0; m < 4; ++m) {
      const size_t roff = (size_t)(pm * BM + rl0 + ai * HALF + m * 16);
#pragma unroll
      for (int bj = 0; bj < 2; ++bj) {
        hreg[m][bj] = *(const uint4*)(xb + roff * D + coff + bj * HALF);
        lreg[m][bj] = *(const uint4*)(xlo + roff * 2048 + 1024 + coff + bj * HALF);
      }
    }
#pragma unroll
    for (int m = 0; m < 4; ++m) {
      int rl = rl0 + ai * HALF + m * 16;
      asm volatile("" : "+v"(rl));
      float s = 0.f, q = 0.f;
#pragma unroll
      for (int bj = 0; bj < 2; ++bj) {
        const uint4 h8 = hreg[m][bj], l8 = lreg[m][bj];
        const unsigned hw[4] = {h8.x, h8.y, h8.z, h8.w}, lw[4] = {l8.x, l8.y, l8.z, l8.w};
#pragma unroll
        for (int n = 0; n < 2; ++n) {
          float4 x;
          x.x = __uint_as_float((hw[2 * n] << 16) + (unsigned)(int)(short)(lw[2 * n] & 0xffffu));
          x.y = __uint_as_float((hw[2 * n] & 0xffff0000u) + (unsigned)((int)lw[2 * n] >> 16));
          x.z = __uint_as_float((hw[2 * n + 1] << 16) + (unsigned)(int)(short)(lw[2 * n + 1] & 0xffffu));
          x.w = __uint_as_float((hw[2 * n + 1] & 0xffff0000u) + (unsigned)((int)lw[2 * n + 1] >> 16));
          f32x4 a = acc[ai][bj][m][n];
          a[0] = ALPHA * x.x + coef * a[0]; a[1] = ALPHA * x.y + coef * a[1]; a[2] = ALPHA * x.z + coef * a[2]; a[3] = ALPHA * x.w + coef * a[3];
          acc[ai][bj][m][n] = a;
          s += (a[0] + a[1]) + (a[2] + a[3]);
          q += (a[0] * a[0] + a[1] * a[1]) + (a[2] * a[2] + a[3] * a[3]);
        }
      }
      s += shx(s, 16, lane); q += shx(q, 16, lane);
      s += shx(s, 32, lane); q += shx(q, 32, lane);
      if (fq == 0) P[rl * 4 + wc] = make_float2(s, q);
    }
  }
  float4 gq[2][2], bq2[2][2];
#pragma unroll
  for (int bj = 0; bj < 2; ++bj) {
    const int c = pn * BM + bj * HALF + wc * 32 + 8 * fq;
    gq[bj][0] = *(const float4*)(g + c); gq[bj][1] = *(const float4*)(g + c + 4);
    bq2[bj][0] = *(const float4*)(bt + c); bq2[bj][1] = *(const float4*)(bt + c + 4);
  }
  __syncthreads();
  if (tid < 256) {
    const float2 a0 = P[tid * 4], a1 = P[tid * 4 + 1], a2 = P[tid * 4 + 2], a3 = P[tid * 4 + 3];
    const float s = (a0.x + a1.x) + (a2.x + a3.x), q = (a0.y + a1.y) + (a2.y + a3.y);
    const u64 bits = ((u64)__float_as_uint(q) << 32) | (u64)__float_as_uint(s);
    __hip_atomic_store(slots + ((size_t)(pm * 4 + pn) * 256 + tid), bits, __ATOMIC_RELAXED, __HIP_MEMORY_SCOPE_AGENT);
  }
  asm volatile("s_waitcnt vmcnt(0)" ::: "memory");
  __syncthreads();
  if (tid == 0) {
    unsigned* c = cnt + pm * 64;
    (void)__hip_atomic_fetch_add(c, 1u, __ATOMIC_RELAXED, __HIP_MEMORY_SCOPE_AGENT);
    const unsigned need = 4u * (unsigned)(lnk + 1);
    unsigned sp = 0;
    while (__hip_atomic_load(c, __ATOMIC_RELAXED, __HIP_MEMORY_SCOPE_AGENT) < need) {
      __builtin_amdgcn_s_sleep(1);
      if (++sp > (1u << 24)) break;
    }
  }
  __syncthreads();
  if (tid < 256) {
    float s = 0.f, q = 0.f;
    {
      const u64* sp0 = slots + ((size_t)(pm * 4) * 256 + tid);
      u64 b0, b1, b2, b3;
      asm volatile("global_load_dwordx2 %0, %4, off sc1\n\tglobal_load_dwordx2 %1, %5, off sc1\n\tglobal_load_dwordx2 %2, %6, off sc1\n\tglobal_load_dwordx2 %3, %7, off sc1\n\ts_waitcnt vmcnt(0)"
                   : "=&v"(b0), "=&v"(b1), "=&v"(b2), "=&v"(b3) : "v"(sp0), "v"(sp0 + 256), "v"(sp0 + 512), "v"(sp0 + 768) : "memory");
      s = ((__uint_as_float((unsigned)b0) + __uint_as_float((unsigned)b1)) + __uint_as_float((unsigned)b2)) + __uint_as_float((unsigned)b3);
      q = ((__uint_as_float((unsigned)(b0 >> 32)) + __uint_as_float((unsigned)(b1 >> 32))) + __uint_as_float((unsigned)(b2 >> 32))) + __uint_as_float((unsigned)(b3 >> 32));
    }
    const float mean = s * (1.f / D);
    const float var = fmaxf(q * (1.f / D) - mean * mean, 0.f);
    Sx[tid] = make_float2(mean, rsqrtf(var + 1e-5f));
  }
  __syncthreads();
#pragma unroll
  for (int bj = 0; bj < 2; ++bj) {
    const int c = pn * BM + bj * HALF + wc * 32 + 8 * fq;
    const float4 g0 = gq[bj][0], g1 = gq[bj][1];
    const float4 b0 = bq2[bj][0], b1 = bq2[bj][1];
#pragma unroll
    for (int ai = 0; ai < 2; ++ai)
#pragma unroll
      for (int m = 0; m < 4; ++m) {
        int rl = rl0 + ai * HALF + m * 16;
        asm volatile("" : "+v"(rl));
        const float2 ms = Sx[rl];
        const f32x4 a = acc[ai][bj][m][0], bq = acc[ai][bj][m][1];
        float v[8];
        v[0] = (a[0] - ms.x) * ms.y * g0.x + b0.x; v[1] = (a[1] - ms.x) * ms.y * g0.y + b0.y;
        v[2] = (a[2] - ms.x) * ms.y * g0.z + b0.z; v[3] = (a[3] - ms.x) * ms.y * g0.w + b0.w;
        v[4] = (bq[0] - ms.x) * ms.y * g1.x + b1.x; v[5] = (bq[1] - ms.x) * ms.y * g1.y + b1.y;
        v[6] = (bq[2] - ms.x) * ms.y * g1.z + b1.z; v[7] = (bq[3] - ms.x) * ms.y * g1.w + b1.w;
        const size_t roff = (size_t)(pm * BM + rl);
        if (lnk == 11) {
          float* xo = xout + roff * D + c;
          *(float4*)xo = make_float4(v[0], v[1], v[2], v[3]);
          *(float4*)(xo + 4) = make_float4(v[4], v[5], v[6], v[7]);
        } else {
          const uint4 h8 = pack8(v);
          *(uint4*)(xb + roff * D + c) = h8;
          uint4 l8;
          l8.x = ((__float_as_uint(v[0]) - (h8.x << 16)) & 0xffffu) | ((__float_as_uint(v[1]) - (h8.x & 0xffff0000u)) << 16);
          l8.y = ((__float_as_uint(v[2]) - (h8.y << 16)) & 0xffffu) | ((__float_as_uint(v[3]) - (h8.y & 0xffff0000u)) << 16);
          l8.z = ((__float_as_uint(v[4]) - (h8.z << 16)) & 0xffffu) | ((__float_as_uint(v[5]) - (h8.z & 0xffff0000u)) << 16);
          l8.w = ((__float_as_uint(v[6]) - (h8.w << 16)) & 0xffffu) | ((__float_as_uint(v[7]) - (h8.w & 0xffff0000u)) << 16);
          *(uint4*)(xlo + roff * 2048 + 1024 + c) = l8;
        }
      }
  }
  __syncthreads();
}

DI void gemm_phase(const Params& p, char* smem, const u16* Ag, const u16* Btg, int N, int K, int mode, float coef, int lnk, const float* lng, const float* lnb) {
  LAS unsigned char* lds = (LAS unsigned char*)smem;
  const int tid = get_tid(), wid = __builtin_amdgcn_readfirstlane(tid >> 6), lane = tid & 63, wr = wid >> 2, wc = wid & 3, fr = lane & 15, fq = lane >> 4;
  const int nt = K / BK, nM = M / BM, nN = N / BM;
  const bool perm = true;
  const bool single = (mode == EPI_RESID);
  unsigned voffA[2], voffB[2];
#pragma unroll
  for (int i = 0; i < 2; ++i) {
    int R, C; stage_rc(tid * 16 + i * 8192, R, C);
    const int Rb = perm ? ((R & ~31) + perm32(R & 31)) : R;
    voffA[i] = (unsigned)(R * K + C) * 2u; voffB[i] = (unsigned)(Rb * K + C) * 2u;
  }
  const size_t kstep = (size_t)(BK * 2);
  const size_t hstep = (size_t)HALF * K * 2;
  const size_t tstep = 2 * hstep;
  const unsigned ldsw = (unsigned)wid * 1024u;
  const int aoff = lds_byte(wr * 64 + fr, fq * 8), boff = lds_byte(wc * 32 + fr, fq * 8);
#define G_SA(b, h) (((b) * 2 + (h)) * HTB)
#define G_SB(b, h) ((4 + (b) * 2 + (h)) * HTB)
#define G_STAGE(bufoff, gbase, voff) do { _Pragma("unroll") for (int _i = 0; _i < 2; ++_i) \
    __builtin_amdgcn_global_load_lds((const unsigned*)((const char*)(gbase) + (voff)[_i]), (LAS unsigned*)(lds + (bufoff) + ldsw + _i * 8192), 16, 0, 0); } while (0)
#define G_LDA(dst, b, h) do { _Pragma("unroll") for (int m = 0; m < 4; ++m) _Pragma("unroll") for (int k = 0; k < 2; ++k) dst[m][k] = *(const LAS bf16x8*)(lds + G_SA(b, h) + aoff + m * 2048 + k * 1024); } while (0)
#define G_LDB(dst, b, h) do { _Pragma("unroll") for (int n = 0; n < 2; ++n) _Pragma("unroll") for (int k = 0; k < 2; ++k) dst[n][k] = *(const LAS bf16x8*)(lds + G_SB(b, h) + boff + n * 2048 + k * 1024); } while (0)
#define G_MMA(ai, bj, At, Bt) do { __builtin_amdgcn_s_setprio(1); _Pragma("unroll") for (int m = 0; m < 4; ++m) _Pragma("unroll") for (int n = 0; n < 2; ++n) _Pragma("unroll") for (int k = 0; k < 2; ++k) \
    acc[ai][bj][m][n] = __builtin_amdgcn_mfma_f32_16x16x32_bf16(Bt[n][k], At[m][k], acc[ai][bj][m][n], 0, 0, 0); __builtin_amdgcn_s_setprio(0); } while (0)
#define G_WAIT_V(n) asm volatile("s_waitcnt vmcnt(" #n ")" ::: "memory")
#define G_WAIT_L(n) asm volatile("s_waitcnt lgkmcnt(" #n ")" ::: "memory")
#define G_BAR __builtin_amdgcn_s_barrier()
#define G_SCHED __builtin_amdgcn_sched_barrier(0)
  int cpm, cpn, npm = 0, npn = 0, ui = 0;
  f32x4 acc[2][2][4][2];
  bf16x8 At[4][2], B0[2][2], B1[2][2];
  for (int ubase = 0;; ++ubase) {
  if (!unit_next(ubase, nM, nN, cpm, cpn)) break;
  ui = ubase;
#pragma unroll
  for (int a = 0; a < 2; ++a)
#pragma unroll
    for (int b = 0; b < 2; ++b)
#pragma unroll
      for (int m = 0; m < 4; ++m)
#pragma unroll
        for (int n = 0; n < 2; ++n) acc[a][b][m][n] = (f32x4){0.f, 0.f, 0.f, 0.f};
  const char* cA = (const char*)Ag + (size_t)cpm * tstep; const char* cB = (const char*)Btg + (size_t)cpn * tstep;
  G_STAGE(G_SB(0, 0), cB, voffB); G_STAGE(G_SA(0, 0), cA, voffA); G_STAGE(G_SB(0, 1), cB + hstep, voffB); G_STAGE(G_SA(0, 1), cA + hstep, voffA);
  if (wr == 1) G_BAR;
  G_WAIT_V(4); G_BAR;
  G_STAGE(G_SB(1, 0), cB + kstep, voffB); G_STAGE(G_SA(1, 0), cA + kstep, voffA); G_STAGE(G_SB(1, 1), cB + hstep + kstep, voffB);
  G_WAIT_V(6); G_BAR;
  for (;;) {
    const bool has_next = unit_next(ui + 1, nM, nN, npm, npn);
    const char* nA = has_next ? (const char*)Ag + (size_t)npm * tstep : cA; const char* nB = has_next ? (const char*)Btg + (size_t)npn * tstep : cB;
    for (int t = 0; t < nt; t += 2) {
      const bool last = (t == nt - 2);
      const char* a1 = cA + (size_t)(t + 1) * kstep;
      const char* a2 = last ? nA : cA + (size_t)(t + 2) * kstep; const char* b2 = last ? nB : cB + (size_t)(t + 2) * kstep;
      const char* a3 = a2 + kstep; const char* b3 = b2 + kstep;
      G_LDB(B0, 0, 0); G_SCHED; G_LDA(At, 0, 0); G_STAGE(G_SA(1, 1), a1 + hstep, voffA);
      G_WAIT_L(8); G_BAR; G_WAIT_L(0); G_MMA(0, 0, At, B0); G_BAR; G_SCHED;
      G_LDB(B1, 0, 1); G_STAGE(G_SB(0, 0), b2, voffB);
      G_BAR; G_WAIT_L(0); G_MMA(0, 1, At, B1); G_BAR;
      G_LDA(At, 0, 1); G_STAGE(G_SA(0, 0), a2, voffA);
      G_BAR; G_WAIT_L(0); G_MMA(1, 0, At, B0); G_BAR; G_SCHED;
      G_STAGE(G_SB(0, 1), b2 + hstep, voffB);
      G_WAIT_V(6); G_BAR; G_MMA(1, 1, At, B1); G_BAR;
      G_LDB(B0, 1, 0); G_SCHED; G_LDA(At, 1, 0); G_STAGE(G_SA(0, 1), a2 + hstep, voffA);
      G_WAIT_L(8); G_BAR; G_WAIT_L(0); G_MMA(0, 0, At, B0); G_BAR; G_SCHED;
      G_LDB(B1, 1, 1); G_STAGE(G_SB(1, 0), b3, voffB);
      G_BAR; G_WAIT_L(0); G_MMA(0, 1, At, B1); G_BAR;
      G_LDA(At, 1, 1); G_STAGE(G_SA(1, 0), a3, voffA);
      G_BAR; G_WAIT_L(0); G_MMA(1, 0, At, B0); G_BAR; G_SCHED;
      G_STAGE(G_SB(1, 1), b3 + hstep, voffB);
      G_WAIT_V(6); G_BAR; G_MMA(1, 1, At, B1); G_BAR;
    }
    if (!single) {
      gemm_epi(p, mode, coef, acc, cpm, cpn, wr, wc, fr, fq);
      if (!has_next) break;
    } else {
      if (!has_next) G_WAIT_V(0);
      if (wr == 0) G_BAR;
      if (!has_next) G_BAR;
      fused_ln_epi(p, smem + 131072, coef, acc, cpm, cpn, wr, wc, fr, fq, tid, lnk, lng, lnb);
      if (!has_next) break;
      if (wr == 1) G_BAR;
    }
#pragma unroll
    for (int a = 0; a < 2; ++a)
#pragma unroll
      for (int b = 0; b < 2; ++b)
#pragma unroll
        for (int m = 0; m < 4; ++m)
#pragma unroll
          for (int n = 0; n < 2; ++n) acc[a][b][m][n] = (f32x4){0.f, 0.f, 0.f, 0.f};
    cpm = npm; cpn = npn; cA = nA; cB = nB; ++ui;
  }
  if (!single) {
    G_WAIT_V(0);
    if (wr == 0) G_BAR;
    G_BAR;
  }
  break;
  }
#undef G_SA
#undef G_SB
#undef G_STAGE
#undef G_LDA
#undef G_LDB
#undef G_MMA
}

DI float gelu_tanh(float x) {
  float u = 0.7978845608028654f * (x + 0.044715f * x * x * x);
  return 0.5f * x * (1.f + tanhf(u));
}

DI void compress_phase(const Params& p, char* smem, int l) {
  const int tid = get_tid(), w = tid >> 6, lane = tid & 63, fr = lane & 15, fq = lane >> 4;
  float* hid = (float*)smem;
  char* ws = launder_ptr(p.ws);
  char* mb = layer_w(ws, l) + 2 * (SZ_WGU + SZ_WD);
  for (int item = blockIdx.x; item < 512; item += gridDim.x) {
    const int kv = item & 1, ct = (item >> 1) & 15, bg = item >> 5;
    const u16* src = (const u16*)(ws + OFF_SEG + (size_t)kv * SZ_SEG) + (size_t)bg * S * 64;
    const u16* w1t = (const u16*)(mb + 4194304 + 2097152 + (size_t)kv * 524288);
    const float* w2 = p.in[kv ? 17 : 13] + (size_t)l * 128 * 64;
    const float* b1p = (const float*)(ws + OFF_B1P) + (l * 2 + kv) * 128;
    const int c0 = ct * 16;
    int cr = c0 + fr; if (cr > 254) cr = 254;
    const u16* ap = src + (size_t)cr * 16 * 64 + fq * 8;
    const u16* bp = w1t + (size_t)(w * 16 + fr) * 2048 + fq * 8;
    f32x4 acc = {0.f, 0.f, 0.f, 0.f};
#pragma unroll 16
    for (int kk = 0; kk < 64; ++kk) {
      bf16x8 a = *(const bf16x8*)(ap + kk * 32);
      bf16x8 bb = *(const bf16x8*)(bp + kk * 32);
      acc = __builtin_amdgcn_mfma_f32_16x16x32_bf16(a, bb, acc, 0, 0, 0);
    }
    __syncthreads();
#pragma unroll
    for (int j = 0; j < 4; ++j) {
      int col = w * 16 + fr;
      hid[(fq * 4 + j) * 128 + col] = gelu_tanh(acc[j] + b1p[col]);
    }
    __syncthreads();
#pragma unroll
    for (int e = 0; e < 2; ++e) {
      int o = tid + e * 512, r = o >> 6, d = o & 63;
      float s = 0.f;
      for (int k = 0; k < 128; ++k) s += hid[r * 128 + k] * w2[k * 64 + d];
      int c = c0 + r;
      if (c < 255) {
        if (kv == 0) ((u16*)(ws + OFF_KCMP))[((size_t)bg * 256 + c) * 64 + d] = f2bf(s);
        else ((u16*)(ws + OFF_VCMPT))[((size_t)bg * 256 + c) * 64 + d] = f2bf(s);
      }
    }
  }
}

template <int KS>
DI f32x16 qk_tile(const u16* Ksub, const bf16x8* qf, int ql, int h, float init = 0.f) {
  f32x16 s;
#pragma unroll
  for (int i = 0; i < 16; ++i) s[i] = init;
#pragma unroll
  for (int ks = 0; ks < 4; ++ks) {
    bf16x8 a = *(const bf16x8*)(Ksub + ql * KS + ks * 16 + h * 8);
    s = mfma32(a, qf[ks], s);
  }
  return s;
}
template <int KS>
DI f32x16 qk_tile_lds(const u16* Ksub, const u16* Qsub, int ql, int h, float init) {
  f32x16 s;
#pragma unroll
  for (int i = 0; i < 16; ++i) s[i] = init;
#pragma unroll
  for (int ks = 0; ks < 4; ++ks) {
    bf16x8 a = *(const bf16x8*)(Ksub + ql * KS + ks * 16 + h * 8);
    bf16x8 b = *(const bf16x8*)(Qsub + ql * KS + ks * 16 + h * 8);
    s = mfma32(a, b, s);
  }
  return s;
}
DI s16x4 tr_read(const u16* ptr) { return __builtin_amdgcn_ds_read_tr16_b64_v4i16((LAS s16x4*)ptr); }
template <int NMB, int VS>
DI void pv_tile(const u16* vsub, const bf16x8* pf, f32x16* O, int lane) {
  const int l16 = lane & 15, q = l16 >> 2, pp = l16 & 3, blk = (lane >> 4) & 1, h = lane >> 5;
  const u16* base = vsub + (4 * h + q) * VS + 16 * blk + 4 * pp;
#pragma unroll
  for (int mb = 0; mb < NMB; ++mb)
#pragma unroll
    for (int s2 = 0; s2 < 2; ++s2) {
      s16x4 lo = tr_read(base + (16 * s2) * VS + mb * 32);
      s16x4 hi = tr_read(base + (16 * s2 + 8) * VS + mb * 32);
      bf16x8 a = __builtin_shufflevector(lo, hi, 0, 1, 2, 3, 4, 5, 6, 7);
      O[mb] = mfma32(a, pf[s2], O[mb]);
    }
}
template <int VS>
DI void pv_load(const u16* vsub, bf16x8* vf, int lane) {
  const int l16 = lane & 15, q = l16 >> 2, pp = l16 & 3, blk = (lane >> 4) & 1, h = lane >> 5;
  const u16* base = vsub + (4 * h + q) * VS + 16 * blk + 4 * pp;
#pragma unroll
  for (int mb = 0; mb < 2; ++mb)
#pragma unroll
    for (int s2 = 0; s2 < 2; ++s2) {
      s16x4 lo = tr_read(base + (16 * s2) * VS + mb * 32);
      s16x4 hi = tr_read(base + (16 * s2 + 8) * VS + mb * 32);
      vf[mb * 2 + s2] = __builtin_shufflevector(lo, hi, 0, 1, 2, 3, 4, 5, 6, 7);
    }
}
DI void pv_mma(const bf16x8* vf, const bf16x8* pf, f32x16* O) {
#pragma unroll
  for (int mb = 0; mb < 2; ++mb)
#pragma unroll
    for (int s2 = 0; s2 < 2; ++s2) O[mb] = mfma32(vf[mb * 2 + s2], pf[s2], O[mb]);
}
template <int KS>
DI void k_load8(const u16* Kt, bf16x8* kf, int ql, int h) {
#pragma unroll
  for (int sub = 0; sub < 2; ++sub)
#pragma unroll
    for (int ks = 0; ks < 4; ++ks) kf[sub * 4 + ks] = *(const bf16x8*)(Kt + (sub * 32 + ql) * KS + ks * 16 + h * 8);
}
DI f32x16 qk_mma(const bf16x8* kf, const bf16x8* qf, float init) {
  f32x16 s;
#pragma unroll
  for (int i = 0; i < 16; ++i) s[i] = init;
#pragma unroll
  for (int ks = 0; ks < 4; ++ks) s = mfma32(kf[ks], qf[ks], s);
  return s;
}
template <int VS>
DI void v_load8(const u16* Vt, bf16x8* vf, int lane) {
  const int l16 = lane & 15, q = l16 >> 2, pp = l16 & 3, blk = (lane >> 4) & 1, h = lane >> 5;
  const u16* base = Vt + (4 * h + q) * VS + 16 * blk + 4 * pp;
#pragma unroll
  for (int sub = 0; sub < 2; ++sub)
#pragma unroll
    for (int mb = 0; mb < 2; ++mb)
#pragma unroll
      for (int s2 = 0; s2 < 2; ++s2) {
        s16x4 lo = tr_read(base + (sub * 32 + 16 * s2) * VS + mb * 32);
        s16x4 hi = tr_read(base + (sub * 32 + 16 * s2 + 8) * VS + mb * 32);
        vf[sub * 4 + mb * 2 + s2] = __builtin_shufflevector(lo, hi, 0, 1, 2, 3, 4, 5, 6, 7);
      }
}
DI void pv_mma8(const bf16x8* vf, const bf16x8* pf, f32x16* O) {
#pragma unroll
  for (int sub = 0; sub < 2; ++sub)
#pragma unroll
    for (int mb = 0; mb < 2; ++mb)
#pragma unroll
      for (int s2 = 0; s2 < 2; ++s2) O[mb] = mfma32(vf[sub * 4 + mb * 2 + s2], pf[sub * 2 + s2], O[mb]);
}
constexpr float NINF = -__builtin_inff();
template <bool MASK>
DI bool softmax_step(f32x16& s, int kbase, int lo, int hi, float& m, float& l, float& alpha, bf16x8* pf, int lane) {
  if (MASK) {
#pragma unroll
    for (int i = 0; i < 16; ++i) {
      int kp = kbase + (i & 3) + 8 * (i >> 2);
      s[i] = ((kp > lo) && (kp <= hi)) ? s[i] : NINF;
    }
  }
  float mx = fmaxf(fmaxf(s[0], s[1]), s[2]);
#pragma unroll
  for (int i = 3; i < 15; i += 2) mx = fmaxf(fmaxf(mx, s[i]), s[i + 1]);
  mx = fmaxf(mx, s[15]);
  const bool need = __any(mx > 8.f);
  alpha = 1.f;
  if (need) {
    mx = fmaxf(mx, shx(mx, 32, lane));
    const float d = fmaxf(mx, 0.f);
    alpha = __builtin_amdgcn_exp2f(-d);
    l *= alpha;
    m += d;
#pragma unroll
    for (int i = 0; i < 16; ++i) s[i] -= d;
  }
  float rs = 0.f;
#pragma unroll
  for (int i = 0; i < 16; ++i) {
    float pv = __builtin_amdgcn_exp2f(s[i]);
    s[i] = pv; rs += pv;
  }
  l += rs;
#pragma unroll
  for (int s2 = 0; s2 < 2; ++s2) {
    unsigned u[4];
#pragma unroll
    for (int j = 0; j < 4; ++j) u[j] = pack2(s[8 * s2 + 2 * j], s[8 * s2 + 2 * j + 1]);
    pf[s2] = __builtin_bit_cast(bf16x8, *(uint4*)u);
  }
  return need;
}

template <bool MASK>
DI bool softmax_step64(f32x16& s0, f32x16& s1, int kbase, int lo, int hi, float& m, float& l, float& alpha, bf16x8* pf, int lane) {
  if (MASK) {
#pragma unroll
    for (int i = 0; i < 16; ++i) {
      int kp = kbase + (i & 3) + 8 * (i >> 2);
      s0[i] = ((kp > lo) && (kp <= hi)) ? s0[i] : NINF;
      s1[i] = ((kp + 32 > lo) && (kp + 32 <= hi)) ? s1[i] : NINF;
    }
  }
  float mx = fmaxf(s0[0], s1[0]);
#pragma unroll
  for (int i = 1; i < 16; ++i) mx = fmaxf(fmaxf(mx, s0[i]), s1[i]);
  const bool need = __any(mx > 8.f);
  alpha = 1.f;
  if (need) {
    mx = fmaxf(mx, shx(mx, 32, lane));
    const float d = fmaxf(mx, 0.f);
    alpha = __builtin_amdgcn_exp2f(-d);
    l *= alpha;
    m += d;
#pragma unroll
    for (int i = 0; i < 16; ++i) { s0[i] -= d; s1[i] -= d; }
  }
  float rs0 = 0.f, rs1 = 0.f;
#pragma unroll
  for (int i = 0; i < 16; ++i) {
    float p0 = __builtin_amdgcn_exp2f(s0[i]), p1 = __builtin_amdgcn_exp2f(s1[i]);
    s0[i] = p0; s1[i] = p1; rs0 += p0; rs1 += p1;
  }
  l += rs0 + rs1;
#pragma unroll
  for (int s2 = 0; s2 < 2; ++s2) {
    unsigned u[4], v[4];
#pragma unroll
    for (int j = 0; j < 4; ++j) { u[j] = pack2(s0[8 * s2 + 2 * j], s0[8 * s2 + 2 * j + 1]); v[j] = pack2(s1[8 * s2 + 2 * j], s1[8 * s2 + 2 * j + 1]); }
    pf[s2] = __builtin_bit_cast(bf16x8, *(uint4*)u);
    pf[2 + s2] = __builtin_bit_cast(bf16x8, *(uint4*)v);
  }
  return need;
}

constexpr int KST = 72, VST = 96, VDS = 160;

DI void nsa_load_q(const u16* qbase, long row, int hq, int h, bf16x8* qf) {
#pragma unroll
  for (int ks = 0; ks < 4; ++ks) qf[ks] = *(const bf16x8*)(qbase + row * D + hq * 64 + ks * 16 + h * 8);
}

DI void nsa_attn_phase(const Params& p, char* smem) {
  const int tid0 = get_tid();
  u16* Kb = (u16*)smem;
  u16* Vb = Kb + 2 * 64 * KST;
  u16* Kc = Vb + 2 * 64 * VST;
  u16* Vc = Kc + 256 * KST;
  unsigned* imp = (unsigned*)(Vc + 256 * VST);
  u64* sel = (u64*)(imp + 32 * 65);
  unsigned* uni = (unsigned*)(sel + 32);
  char* ws = launder_ptr(p.ws);
  const u16* KS_g = (const u16*)(ws + OFF_SEG + 2 * SZ_SEG);
  const u16* VS_g = (const u16*)(ws + OFF_SEG + 3 * SZ_SEG);
  const u16* KW_g = (const u16*)(ws + OFF_SEG + 4 * SZ_SEG);
  const u16* VW_g = (const u16*)(ws + OFF_SEG + 5 * SZ_SEG);
  const float* gates = (const float*)(ws + OFF_GATES);
  u16* Oout = (u16*)(ws + OFF_PROJ);

  for (int item = blockIdx.x; item < 2048; item += gridDim.x) {
    const int rnd = item >> 8, j256 = item & 255;
    int tid = tid0; asm volatile("" : "+v"(tid));
    const int w = tid >> 6, lane = tid & 63, ql = lane & 31, h = lane >> 5;
    const int bg = j256 & 15, k16 = j256 >> 4;
    const int tile = rnd * 16 + ((rnd & 1) ? 15 - k16 : k16);
    const int b = bg >> 1, g = bg & 1;
    const int t0 = tile * 32, t = t0 + ql, hq = g * 8 + w;
    const long row = (long)b * S + t;
    const int cur = t0 >> 6;

    __syncthreads();
    const int tidi = tid;
    const int ntc = (t0 >> 9) + 1, nc = ntc * 32;
    for (int i = tidi; i < 32 * 65; i += NTHR) imp[i] = 0;
    if (tidi < 2) uni[tidi] = 0;
    bf16x8 qf[4];
    nsa_load_q((const u16*)(ws + OFF_PROJ), row, hq, h, qf);
    const int lr = tid >> 3, lch = tid & 7;
    uint4 kreg, vreg;
    const float gr0 = gates[row * 48 + hq], gr1 = gates[row * 48 + 16 + hq], gr2 = gates[row * 48 + 32 + hq];
    const float g0 = __builtin_amdgcn_rcpf(1.f + __expf(-gr0)), g1 = __builtin_amdgcn_rcpf(1.f + __expf(-gr1)), g2 = __builtin_amdgcn_rcpf(1.f + __expf(-gr2));
    {
      const u16* kcg = (const u16*)(ws + OFF_KCMP) + (size_t)bg * 256 * 64;
      const u16* vcg = (const u16*)(ws + OFF_VCMPT) + (size_t)bg * 256 * 64;
      uint4 kc4[4], vc4[4];
#pragma unroll
      for (int j = 0; j < 4; ++j) {
        const int i = tidi + j * NTHR;
        kc4[j] = *(const uint4*)(kcg + (i >> 3) * 64 + (i & 7) * 8); vc4[j] = *(const uint4*)(vcg + (i >> 3) * 64 + (i & 7) * 8);
      }
#pragma unroll
      for (int j = 0; j < 4; ++j) {
        const int i = tidi + j * NTHR;
        if (i < nc * 8) { *(uint4*)(Kc + (i >> 3) * KST + (i & 7) * 8) = kc4[j]; *(uint4*)(Vc + (i >> 3) * VST + (i & 7) * 8) = vc4[j]; }
      }
    }
    __syncthreads();

    f32x16 O[2];
    unsigned outp[16];
    bf16x8 pf[4];
    const int cmaxq = (t >= 31) ? ((t - 31) >> 4) : -1;
    float m = NEGF, l = 0.f;
    for (int ct = 0; ct < ntc; ++ct) {
      f32x16 s = qk_tile<KST>(Kc + ct * 32 * KST, qf, ql, h);
      float mx = NEGF;
#pragma unroll
      for (int i = 0; i < 16; ++i) {
        int c = ct * 32 + 4 * h + (i & 3) + 8 * (i >> 2);
        s[i] = (c <= cmaxq) ? s[i] : NEGF;
        mx = fmaxf(mx, s[i]);
      }
      mx = fmaxf(mx, shx(mx, 32, lane));
      const float mn = fmaxf(m, mx);
      float rs = 0.f;
#pragma unroll
      for (int i = 0; i < 16; ++i) rs += (s[i] > -1e29f) ? __builtin_amdgcn_exp2f(s[i] - mn) : 0.f;
      rs += shx(rs, 32, lane);
      l = l * __builtin_amdgcn_exp2f(m - mn) + rs;
      m = mn;
    }
    const float invl = (l > 0.f) ? 1.f / l : 0.f;
#pragma unroll
    for (int mb = 0; mb < 2; ++mb)
#pragma unroll
      for (int i = 0; i < 16; ++i) O[mb][i] = 0.f;
    for (int ct = 0; ct < ntc; ++ct) {
      f32x16 s = qk_tile<KST>(Kc + ct * 32 * KST, qf, ql, h);
#pragma unroll
      for (int i = 0; i < 16; ++i) {
        int c = ct * 32 + 4 * h + (i & 3) + 8 * (i >> 2);
        s[i] = (c <= cmaxq) ? __builtin_amdgcn_exp2f(s[i] - m) * invl : 0.f;
      }
#pragma unroll
      for (int a = 0; a < 4; ++a) {
        int n = ct * 8 + 2 * a + h;
        float mainv = s[4 * a] + s[4 * a + 1] + s[4 * a + 2] + 0.5f * s[4 * a + 3];
        float carry = 0.5f * s[4 * a + 3];
        unsigned um = (unsigned)(mainv * 16777216.f + 0.5f), uc = (unsigned)(carry * 16777216.f + 0.5f);
        if (um) atomicAdd(&imp[ql * 65 + n], um);
        if (uc && n < 63) atomicAdd(&imp[ql * 65 + n + 1], uc);
      }
#pragma unroll
      for (int s2 = 0; s2 < 2; ++s2) {
        unsigned u[4];
#pragma unroll
        for (int j = 0; j < 4; ++j) u[j] = pack2(s[8 * s2 + 2 * j], s[8 * s2 + 2 * j + 1]);
        pf[s2] = __builtin_bit_cast(bf16x8, *(uint4*)u);
      }
      pv_tile<2, VST>(Vc + ct * 32 * VST, pf, O, lane);
    }
#pragma unroll
    for (int mb = 0; mb < 2; ++mb)
#pragma unroll
      for (int i = 0; i < 16; i += 2) outp[mb * 8 + (i >> 1)] = pack2(g0 * O[mb][i], g0 * O[mb][i + 1]);
    __syncthreads();
    for (int qq = 0; qq < 4; ++qq) {
      const int q = w * 4 + qq;
      unsigned v = imp[q * 65 + lane];
      const bool valid = lane <= cur;
      const bool forced = (lane == 0) || (lane == cur) || (lane == cur - 1);
      if (forced) v += (1u << 30);
      int rank = 0;
      for (int mth = 0; mth <= cur; ++mth) {
        unsigned vm = __builtin_amdgcn_readlane(v, mth);
        rank += (vm > v || (vm == v && mth < lane)) ? 1 : 0;
      }
      u64 msk = __ballot(valid && rank < 16);
      if (lane == 0) { sel[q] = msk; atomicOr(&uni[0], (unsigned)msk); atomicOr(&uni[1], (unsigned)(msk >> 32)); }
    }
    __syncthreads();
    const u64 selq = sel[ql];
    const u64 unim = ((u64)uni[1] << 32) | uni[0];
    {
      const float4* r4 = (const float4*)((const float*)(ws + OFF_ROPE) + t * 16);
      const uint4 w4 = __builtin_bit_cast(uint4, qf[0]);
      unsigned wv[4] = {w4.x, w4.y, w4.z, w4.w};
#pragma unroll
      for (int j = 0; j < 4; ++j) {
        const unsigned pw = (unsigned)__builtin_amdgcn_ds_bpermute((lane ^ 32) << 2, (int)wv[j]);
        const float4 cs = r4[j];
        const float a0 = __uint_as_float(wv[j] << 16), a1 = __uint_as_float(wv[j] & 0xffff0000u);
        const float o0 = __uint_as_float(pw << 16), o1 = __uint_as_float(pw & 0xffff0000u);
        float n0, n1;
        if (h == 0) { n0 = a0 * cs.x - o0 * cs.y; n1 = a1 * cs.z - o1 * cs.w; }
        else { n0 = o0 * cs.y + a0 * cs.x; n1 = o1 * cs.w + a1 * cs.z; }
        wv[j] = pack2(n0, n1);
      }
      qf[0] = __builtin_bit_cast(bf16x8, make_uint4(wv[0], wv[1], wv[2], wv[3]));
    }

    for (int br = 1; br <= 2; ++br) {
      const u16* Kg = (br == 1 ? KS_g : KW_g) + (size_t)bg * S * 64;
      const u16* Vg = (br == 1 ? VS_g : VW_g) + (size_t)bg * S * 64;
      u64 tm;
      if (br == 1) tm = unim;
      else {
        int first = (t0 - 512) >> 6; if (first < 0) first = 0;
        tm = (~0ull >> (63 - cur)) & (~0ull << first);
      }
      m = 0.f; l = 0.f;
#pragma unroll
      for (int mb = 0; mb < 2; ++mb)
#pragma unroll
        for (int i = 0; i < 16; ++i) O[mb][i] = 0.f;
#define NSA_LD(KP, VP, nt) do { kreg = *(const uint4*)((KP) + (size_t)((nt) * 64 + lr) * 64 + lch * 8); \
                               vreg = *(const uint4*)((VP) + (size_t)((nt) * 64 + lr) * 64 + lch * 8); } while (0)
#define NSA_ST(bb) do { *(uint4*)(Kb + (bb) * 64 * KST + lr * KST + lch * 8) = kreg; *(uint4*)(Vb + (bb) * 64 * VST + lr * VST + lch * 8) = vreg; } while (0)
      int buf = 0;
      int n = __builtin_ctzll(tm);
      tm &= tm - 1;
      if (br == 1) NSA_LD(Kg, Vg, n);
      NSA_ST(0);
      int n1 = -1;
      if (tm) { n1 = __builtin_ctzll(tm); tm &= tm - 1; NSA_LD(Kg, Vg, n1); }
      bool wpre = false;
      __syncthreads();
      for (;;) {
        int n2 = -1;
        if (n1 >= 0) {
          NSA_ST(buf ^ 1);
          if (tm) { n2 = __builtin_ctzll(tm); tm &= tm - 1; NSA_LD(Kg, Vg, n2); }
        }
        if (br == 1 && n2 < 0 && !wpre) {
          int wf = (t0 - 512) >> 6; if (wf < 0) wf = 0;
          NSA_LD(KW_g + (size_t)bg * S * 64, VW_g + (size_t)bg * S * 64, wf);
          wpre = true;
        }
        const u16* Kt = Kb + buf * 64 * KST;
        const u16* Vt = Vb + buf * 64 * VST;
        int lo, hi = t;
        const bool lsel = (selq >> n) & 1;
        lo = (br == 1) ? -1 : t - 512;
        {
          const int kp0 = n * 64;
          const float init = (br == 2 || lsel) ? -m : NINF;
          bf16x8 fr8[8];
          k_load8<KST>(Kt, fr8, ql, h);
          f32x16 s0 = qk_mma(fr8, qf, init);
          f32x16 s1 = qk_mma(fr8 + 4, qf, init);
          pv_load<VST>(Vt, fr8, lane);
          float alpha; bool need;
          const bool interior = (kp0 + 63 <= t0) && (br == 1 || kp0 > t0 + 31 - 512);
          if (!interior) need = softmax_step64<true>(s0, s1, kp0 + 4 * h, lo, hi, m, l, alpha, pf, lane);
          else need = softmax_step64<false>(s0, s1, 0, 0, 0, m, l, alpha, pf, lane);
          if (need) {
#pragma unroll
            for (int mb = 0; mb < 2; ++mb)
#pragma unroll
              for (int i = 0; i < 16; ++i) O[mb][i] *= alpha;
          }
          pv_mma(fr8, pf, O);
          pv_load<VST>(Vt + 32 * VST, fr8 + 4, lane);
          pv_mma(fr8 + 4, pf + 2, O);
        }
        __syncthreads();
        if (n1 < 0) break;
        n = n1; n1 = n2; buf ^= 1;
      }
#undef NSA_LD
#undef NSA_ST
      l += shx(l, 32, lane);
      const float sc = (br == 1 ? g1 : g2) * ((l > 0.f) ? 1.f / l : 0.f);
#pragma unroll
      for (int mb = 0; mb < 2; ++mb)
#pragma unroll
        for (int i = 0; i < 16; i += 2) {
          const unsigned pk = outp[mb * 8 + (i >> 1)];
          const float a0 = sc * O[mb][i] + __uint_as_float(pk << 16), a1 = sc * O[mb][i + 1] + __uint_as_float(pk & 0xffff0000u);
          if (br == 1) outp[mb * 8 + (i >> 1)] = pack2(a0, a1);
          else { O[mb][i] = a0; O[mb][i + 1] = a1; }
        }
    }
#pragma unroll
    for (int mb = 0; mb < 2; ++mb)
#pragma unroll
      for (int a = 0; a < 4; ++a) {
        uint2 o; o.x = pack2(O[mb][4 * a], O[mb][4 * a + 1]); o.y = pack2(O[mb][4 * a + 2], O[mb][4 * a + 3]);
        *(uint2*)(Oout + row * D + hq * 64 + mb * 32 + 8 * a + 4 * h) = o;
      }
  }
}

DI void diff_attn_phase(const Params& p, char* smem, int j) {
  const int tid = get_tid(), w = tid >> 6, lane = tid & 63, ql = lane & 31, h = lane >> 5;
  char* ws = launder_ptr(p.ws);
  u16* K1b = (u16*)smem;
  u16* K2b = K1b + 2 * 64 * KST;
  u16* Vb = K2b + 2 * 64 * KST;
  u16* Qs = Vb + 2 * 64 * VDS + w * (2 * 32 * KST);
  const int layer = 2 + j;
  const float lambda_init = (layer == 2) ? 0.47071301834f : 0.55605820415f;
  float lam;
  {
    float a = p.in[21][j * 64 + lane] * p.in[22][j * 64 + lane];
    float c = p.in[23][j * 64 + lane] * p.in[24][j * 64 + lane];
#pragma unroll
    for (int o = 32; o > 0; o >>= 1) { a += shx(a, o, lane); c += shx(c, o, lane); }
    lam = expf(a) - expf(c) + lambda_init;
  }
  const u16* QD = (const u16*)(ws + OFF_PROJ);
  u16* Oout = (u16*)(ws + OFF_QR);
  const float* sg = p.in[25] + j * 128;

  for (int item = blockIdx.x; item < 1024; item += gridDim.x) {
    const int rnd = item >> 8, j256 = item & 255;
    const int bh = j256 & 63, kq = j256 >> 6;
    const int qb = (rnd == 0) ? kq : (rnd == 1) ? 15 - kq : (rnd == 2) ? 4 + kq : 11 - kq;
    const int b = bh >> 3, hd = bh & 7;
    const int t0 = qb * 256 + w * 32, t = t0 + ql;
    const long row = (long)b * S + t;
    const u16* K1g = (const u16*)(ws + OFF_KD) + ((size_t)((b * 2 + 0) * 8 + hd)) * S * 64;
    const u16* K2g = (const u16*)(ws + OFF_KD) + ((size_t)((b * 2 + 1) * 8 + hd)) * S * 64;
    const u16* Vg = (const u16*)(ws + OFF_VD) + ((size_t)(b * 8 + hd)) * S * 128;
#pragma unroll
    for (int ks = 0; ks < 4; ++ks) {
      bf16x8 qa = *(const bf16x8*)(QD + row * D + hd * 64 + ks * 16 + h * 8);
      bf16x8 qb2 = *(const bf16x8*)(QD + row * D + 512 + hd * 64 + ks * 16 + h * 8);
      *(bf16x8*)(Qs + ql * KST + ks * 16 + h * 8) = qa;
      *(bf16x8*)(Qs + 32 * KST + ql * KST + ks * 16 + h * 8) = qb2;
    }
    f32x16 O1[4], O2[4];
#pragma unroll
    for (int mb = 0; mb < 4; ++mb)
#pragma unroll
      for (int i = 0; i < 16; ++i) { O1[mb][i] = 0.f; O2[mb][i] = 0.f; }
    float m1 = 0.f, l1 = 0.f, m2 = 0.f, l2 = 0.f;
    const int ntile = (qb + 1) * 4;
    const int lr = tid >> 3, lch = tid & 7;
    uint4 k1r, k2r;
    __syncthreads();
    {
      k1r = *(const uint4*)(K1g + (size_t)lr * 64 + lch * 8);
      k2r = *(const uint4*)(K2g + (size_t)lr * 64 + lch * 8);
      *(uint4*)(K1b + lr * KST + lch * 8) = k1r;
      *(uint4*)(K2b + lr * KST + lch * 8) = k2r;
      k1r = *(const uint4*)(Vg + (size_t)lr * 128 + lch * 8);
      k2r = *(const uint4*)(Vg + (size_t)lr * 128 + 64 + lch * 8);
      *(uint4*)(Vb + lr * VDS + lch * 8) = k1r;
      *(uint4*)(Vb + lr * VDS + 64 + lch * 8) = k2r;
      if (ntile > 1) {
        k1r = *(const uint4*)(Vg + (size_t)(64 + lr) * 128 + lch * 8);
        k2r = *(const uint4*)(Vg + (size_t)(64 + lr) * 128 + 64 + lch * 8);
      }
    }
    __syncthreads();
    int buf = 0;
    for (int n = 0; n < ntile; ++n) {
      const bool more = (n + 1 < ntile);
      if (more) {
        const int nb = buf ^ 1, k0 = (n + 1) * 64;
        *(uint4*)(Vb + nb * 64 * VDS + lr * VDS + lch * 8) = k1r;
        *(uint4*)(Vb + nb * 64 * VDS + lr * VDS + 64 + lch * 8) = k2r;
        k1r = *(const uint4*)(K1g + (size_t)(k0 + lr) * 64 + lch * 8);
        k2r = *(const uint4*)(K2g + (size_t)(k0 + lr) * 64 + lch * 8);
      }
      const u16* K1t = K1b + buf * 64 * KST;
      const u16* K2t = K2b + buf * 64 * KST;
      const u16* Vt = Vb + buf * 64 * VDS;
#pragma unroll
      for (int sub = 0; sub < 2; ++sub) {
        if (sub == 1 && more) {
          const int nb = buf ^ 1, k0 = (n + 2) * 64;
          *(uint4*)(K1b + nb * 64 * KST + lr * KST + lch * 8) = k1r;
          *(uint4*)(K2b + nb * 64 * KST + lr * KST + lch * 8) = k2r;
          if (n + 2 < ntile) {
            k1r = *(const uint4*)(Vg + (size_t)(k0 + lr) * 128 + lch * 8);
            k2r = *(const uint4*)(Vg + (size_t)(k0 + lr) * 128 + 64 + lch * 8);
          }
        }
        const int kp0 = n * 64 + sub * 32;
        if (kp0 > t0 + 31) continue;
        bf16x8 pf1[2], pf2[2];
        {
          f32x16 sA = qk_tile_lds<KST>(K1t + sub * 32 * KST, Qs, ql, h, -m1);
          f32x16 sB = qk_tile_lds<KST>(K2t + sub * 32 * KST, Qs + 32 * KST, ql, h, -m2);
          float alpha1, alpha2; bool need1, need2;
          if (kp0 + 31 <= t0) {
            need1 = softmax_step<false>(sA, 0, 0, 0, m1, l1, alpha1, pf1, lane);
            need2 = softmax_step<false>(sB, 0, 0, 0, m2, l2, alpha2, pf2, lane);
          } else {
            need1 = softmax_step<true>(sA, kp0 + 4 * h, -1, t, m1, l1, alpha1, pf1, lane);
            need2 = softmax_step<true>(sB, kp0 + 4 * h, -1, t, m2, l2, alpha2, pf2, lane);
          }
          if (need1 || need2) {
#pragma unroll
            for (int mb = 0; mb < 4; ++mb)
#pragma unroll
              for (int i = 0; i < 16; ++i) { O1[mb][i] *= alpha1; O2[mb][i] *= alpha2; }
          }
        }
        {
          const int l16 = lane & 15, tq = l16 >> 2, tp = l16 & 3, blk = (lane >> 4) & 1;
          const u16* vbase = Vt + (sub * 32 + 4 * h + tq) * VDS + 16 * blk + 4 * tp;
#pragma unroll
          for (int mb = 0; mb < 4; ++mb)
#pragma unroll
            for (int s2 = 0; s2 < 2; ++s2) {
              s16x4 lo = tr_read(vbase + (16 * s2) * VDS + mb * 32);
              s16x4 hi = tr_read(vbase + (16 * s2 + 8) * VDS + mb * 32);
              bf16x8 a = __builtin_shufflevector(lo, hi, 0, 1, 2, 3, 4, 5, 6, 7);
              O1[mb] = mfma32(a, pf1[s2], O1[mb]);
              O2[mb] = mfma32(a, pf2[s2], O2[mb]);
            }
        }
      }
      __syncthreads();
      buf ^= 1;
    }
    l1 += shx(l1, 32, lane); l2 += shx(l2, 32, lane);
    const float i1 = 1.f / l1, i2 = lam / l2;
    float ss = 0.f;
#pragma unroll
    for (int mb = 0; mb < 4; ++mb)
#pragma unroll
      for (int i = 0; i < 16; ++i) { float o = O1[mb][i] * i1 - O2[mb][i] * i2; O1[mb][i] = o; ss += o * o; }
    ss += shx(ss, 32, lane);
    const float rn = rsqrtf(ss * (1.f / 128.f) + 1e-5f) * (1.f - lambda_init);
#pragma unroll
    for (int mb = 0; mb < 4; ++mb)
#pragma unroll
      for (int a = 0; a < 4; ++a) {
        const int dv = mb * 32 + 8 * a + 4 * h;
        float4 gg = *(const float4*)(sg + dv);
        uint2 o;
        o.x = pack2(O1[mb][4 * a] * rn * gg.x, O1[mb][4 * a + 1] * rn * gg.y);
        o.y = pack2(O1[mb][4 * a + 2] * rn * gg.z, O1[mb][4 * a + 3] * rn * gg.w);
        *(uint2*)(Oout + row * D + hd * 128 + dv) = o;
      }
  }
}


#define XB_TMO      128
#define XB_XCNT(j)  (256  + 64 * (j))
#define XB_XSUB(j)  (1280 + 64 * (j))
#define XB_XGEN(j)  (2304 + 64 * (j))
#define XB_TOP      3328
#define XB_TOPGEN   3392
#define XCD_BAR_WORDS 3456
#define XB_SPIN_CAP (1u << 22)
DI unsigned xb_ld(unsigned* p) { return __hip_atomic_load(p, __ATOMIC_RELAXED, __HIP_MEMORY_SCOPE_AGENT); }
DI unsigned xb_add(unsigned* p, unsigned v) { return __hip_atomic_fetch_add(p, v, __ATOMIC_RELAXED, __HIP_MEMORY_SCOPE_AGENT); }
DI unsigned xb_xcc_id() { return (unsigned)__builtin_amdgcn_s_getreg((3 << 11) | 20) & 0xFu; }
#define XB_SPIN(cond, bar) do { unsigned _sp = 0; while (cond) { __builtin_amdgcn_s_sleep(1); \
    if ((++_sp & 255u) == 0u) { if (xb_ld(&(bar)[XB_TMO])) break; if (_sp > XB_SPIN_CAP) { atomicAdd(&(bar)[XB_TMO], 1u); break; } } } } while (0)
struct XcdBarrier { unsigned* bar; unsigned x; volatile LAS unsigned* st; };
DI XcdBarrier xcd_barrier_post(unsigned* bar, volatile LAS unsigned* st) {
  XcdBarrier b; b.bar = bar; b.x = xb_xcc_id(); b.st = st;
  if (get_tid() == 0) (void)xb_add(&bar[XB_XCNT(b.x)], 1u);
  return b;
}
DI void xcd_barrier_complete(unsigned* bar, unsigned x, unsigned& nloc, unsigned& nx) {
  const unsigned G = gridDim.x * gridDim.y * gridDim.z;
  unsigned sum, cnt, mine, sp = 0u;
  for (;;) {
    sum = 0u; cnt = 0u; mine = 0u;
#pragma unroll
    for (unsigned j = 0; j < 16; ++j) { const unsigned c = xb_ld(&bar[XB_XCNT(j)]); sum += c; cnt += (c > 0u) ? 1u : 0u; mine = (j == x) ? c : mine; }
    if (sum == G) break;
    __builtin_amdgcn_s_sleep(1);
    if ((++sp & 255u) == 0u) { if (xb_ld(&bar[XB_TMO])) break; if (sp > XB_SPIN_CAP) { atomicAdd(&bar[XB_TMO], 1u); break; } }
  }
  nloc = mine > 0u ? mine : 1u; nx = cnt > 0u ? cnt : 1u;
}
DI void xcd_barrier(const XcdBarrier& b) {
  asm volatile("s_waitcnt vmcnt(0)" ::: "memory");
  __syncthreads();
  if (get_tid() == 0) {
    unsigned* bar = b.bar;
    __builtin_amdgcn_s_waitcnt(0);
    unsigned nloc = b.st[0], nx = b.st[1];
    if (nloc == 0u) { xcd_barrier_complete(bar, b.x, nloc, nx); b.st[0] = nloc; b.st[1] = nx; }
    const unsigned old = xb_add(&bar[XB_XSUB(b.x)], 1u);
    const unsigned gen = old / nloc;
    if (old + 1u == (gen + 1u) * nloc) {
      __builtin_amdgcn_fence(__ATOMIC_RELEASE, "agent");
      asm volatile("s_waitcnt vmcnt(0)" ::: "memory");
      const unsigned og = xb_add(&bar[XB_TOP], 1u);
      const unsigned tg = og / nx;
      if (og + 1u == (tg + 1u) * nx) xb_add(&bar[XB_TOPGEN], 1u);
      else XB_SPIN(xb_ld(&bar[XB_TOPGEN]) == tg, bar);
      __builtin_amdgcn_fence(__ATOMIC_ACQUIRE, "agent");
      xb_add(&bar[XB_XGEN(b.x)], 1u);
      asm volatile("s_waitcnt vmcnt(0)" ::: "memory");
    } else {
      XB_SPIN(xb_ld(&bar[XB_XGEN(b.x)]) == gen, bar);
      __builtin_amdgcn_fence(__ATOMIC_ACQUIRE, "agent");
      asm volatile("s_waitcnt vmcnt(0)" ::: "memory");
    }
  }
  __syncthreads();
}

__global__ void __launch_bounds__(NTHR) mega(Params p, int ph_lo, int ph_hi, int coop) {
  extern __shared__ __attribute__((aligned(16))) char smem[];
  cg::grid_group grid = cg::this_grid();
  volatile LAS unsigned* xst = (volatile LAS unsigned*)(smem + SMEM_BYTES - 16);
  if (get_tid() == 0) { xst[0] = 0u; xst[1] = 0u; }
  __syncthreads();
  const XcdBarrier xb = xcd_barrier_post((unsigned*)(p.ws + OFF_BAR), xst);
  int ph = 0;
  if (ph_hi < 0) grid.sync();
  if (ph >= ph_lo && ph < ph_hi) { prep_phase(p, smem); if (coop && ph + 1 < ph_hi) xcd_barrier(xb); }
  ++ph;
  for (int l = 0; l < 4; ++l) {
    for (int st = 0; st < 12; ++st) {
      if (st == 4 && l >= 2) continue;
      if (st == 11 && l != 1) continue;
      if (st == 2 || st == 7 || st == 10) continue;
      if (ph >= ph_lo && ph < ph_hi) {
        char* wsl = launder_ptr(p.ws);
        char* wb = layer_w(wsl, l);
        char* mb = wb + 2 * (SZ_WGU + SZ_WD);
        const u16* XB = (const u16*)(wsl + OFF_XB);
        const u16* HB = (const u16*)(wsl + OFF_H);
        int kind = 0;
        const u16* A = XB; const u16* Bt = nullptr; int N = D, K = D, mode = EPI_RESID; float coef = 1.f; int lni = 0;
        switch (st) {
          case 0: Bt = (const u16*)wb; N = 2 * F; mode = EPI_GATEUP; break;
          case 1: A = HB; Bt = (const u16*)(wb + SZ_WGU); K = F; coef = 0.5f; lni = l * 3; break;
          case 2: kind = 1; lni = l * 3; break;
          case 3: Bt = (const u16*)mb; if (l < 2) { N = 2048; mode = EPI_NSA_IN; } else { mode = EPI_DIFF_Q; } break;
          case 4: kind = 2; break;
          case 5: kind = (l < 2) ? 3 : 4; break;
          case 6: A = (const u16*)(wsl + (l < 2 ? OFF_PROJ : OFF_QR)); Bt = (const u16*)(mb + (l < 2 ? 4194304 : 2097152)); lni = l * 3 + 1; break;
          case 7: kind = 1; lni = l * 3 + 1; break;
          case 8: Bt = (const u16*)(wb + SZ_WGU + SZ_WD); N = 2 * F; mode = EPI_GATEUP; break;
          case 9: A = HB; Bt = (const u16*)(wb + SZ_WGU + SZ_WD + SZ_WGU); K = F; coef = 0.5f; lni = l * 3 + 2; break;
          case 10: kind = 1; lni = l * 3 + 2; break;
          default: Bt = (const u16*)(wsl + OFF_WKV); N = 2048; mode = EPI_DIFF_KV; break;
        }
        if (kind == 0) gemm_phase(p, smem, A, Bt, N, K, mode, coef, lni, p.in[7] + (size_t)lni * D, p.in[8] + (size_t)lni * D);
        else if (kind == 2) compress_phase(p, smem, l);
        else if (kind == 3) nsa_attn_phase(p, smem);
        else diff_attn_phase(p, smem, l - 2);
        if (coop && ph + 1 < ph_hi) xcd_barrier(xb);
      }
      ++ph;
    }
  }
}

extern "C" void kernel_launch(void* const* d_in, const int* in_sizes, int n_in, void* d_out, int out_size, void* d_ws,
                              size_t ws_size, hipStream_t stream) {
  if (n_in < 27 || ws_size < WS_NEED) { fprintf(stderr, "bad args: n_in %d ws %zu need %zu\n", n_in, ws_size, (size_t)WS_NEED); return; }
  Params p{};
  for (int i = 0; i < 27; ++i) p.in[i] = (const float*)d_in[i];
  p.out = (float*)d_out;
  p.ws = (char*)d_ws;
  static int grid_blocks = 0;
  (void)hipFuncSetAttribute((const void*)mega, hipFuncAttributeMaxDynamicSharedMemorySize, SMEM_BYTES);
  if (!grid_blocks) {
    int dev = 0, cus = 0, per_cu = 0;
    (void)hipGetDevice(&dev);
    (void)hipDeviceGetAttribute(&cus, hipDeviceAttributeMultiprocessorCount, dev);
    (void)hipOccupancyMaxActiveBlocksPerMultiprocessor(&per_cu, mega, NTHR, SMEM_BYTES);
    if (per_cu < 1) per_cu = 1;
    grid_blocks = cus;
    if (grid_blocks % 8) grid_blocks -= grid_blocks % 8;
  }
  (void)hipMemsetAsync((char*)d_ws + OFF_BAR, 0, 16384 + 32768, stream);
  int lo = 0, hi = 1000, coop = 1;
  void* args[] = {&p, &lo, &hi, &coop};
  hipError_t e = hipLaunchCooperativeKernel((const void*)mega, dim3(grid_blocks), dim3(NTHR), args, SMEM_BYTES, stream);
  if (e != hipSuccess) fprintf(stderr, "cooperative launch failed: %s (grid %d)\n", hipGetErrorString(e), grid_blocks);
}
```

```cpp
#include <hip/hip_runtime.h>
#include <hip/hip_cooperative_groups.h>
#include <cstdio>
namespace cg = cooperative_groups;

#define DI __device__ __forceinline__
typedef unsigned short u16;
typedef unsigned long long u64;
using bf16x8 = __attribute__((ext_vector_type(8))) short;
using s16x4 = __attribute__((ext_vector_type(4))) short;
using f32x4 = __attribute__((ext_vector_type(4))) float;
using f32x16 = __attribute__((ext_vector_type(16))) float;
using f32x2 = __attribute__((ext_vector_type(2))) float;
using bf16v2 = __attribute__((ext_vector_type(2))) __bf16;

constexpr int NB = 8, S = 4096, M = NB * S, D = 1024, F = 2816;
constexpr int NTHR = 512;
constexpr int SMEM_BYTES = 155648;
constexpr float ALPHA = 1.681792830507429f;
constexpr float NEGF = -1e30f;

constexpr size_t OFF_XB = 0;
constexpr size_t OFF_H = 67108864;
constexpr size_t OFF_KV = OFF_H + 184549376;
constexpr size_t OFF_W = OFF_KV + 134217728;
constexpr size_t SZ_WGU = 11534336, SZ_WD = 5767168;
constexpr size_t LW_A = 41943040, LW_B = 38797312;
constexpr size_t OFF_WKV = OFF_W + 2 * LW_B;
constexpr size_t OFF_SEG = OFF_WKV + 4194304;
constexpr size_t SZ_SEG = 8388608;
constexpr size_t OFF_GATES = OFF_SEG + 6 * SZ_SEG;
constexpr size_t OFF_KCMP = OFF_GATES + 6291456;
constexpr size_t OFF_VCMPT = OFF_KCMP + 524288;
constexpr size_t OFF_ROPE = OFF_VCMPT + 524288;
constexpr size_t OFF_B1P = OFF_ROPE + 262144;
constexpr size_t OFF_BAR = OFF_B1P + 4096;
constexpr size_t OFF_CNT = OFF_BAR + 16384;
constexpr size_t OFF_SLOTS = OFF_CNT + 32768;
constexpr size_t WS_NEED = OFF_SLOTS + 1048576;
constexpr size_t OFF_PROJ = OFF_H;
constexpr size_t OFF_QR = OFF_H + 67108864;
constexpr size_t OFF_PARK = OFF_H + 134217728;
constexpr size_t OFF_KD = OFF_KV;
constexpr size_t OFF_VD = OFF_KV + 67108864;

struct Params {
  const float* in[27];
  float* out;
  char* ws;
};

struct Params;
typedef __attribute__((address_space(1))) char gchar_t;
DI char* launder_ptr(char* w) { gchar_t* g = (gchar_t*)w; asm volatile("" : "+s"(g)); return (char*)g; }
DI int get_tid() { int t = threadIdx.x; asm volatile("" : "+v"(t)); return t; }
DI float shx(float v, int mask, int lane) { return __int_as_float(__builtin_amdgcn_ds_bpermute((lane ^ mask) << 2, __float_as_int(v))); }
DI u16 f2bf(float x) { return __builtin_bit_cast(u16, (__bf16)x); }
DI unsigned pack2(float a, float b) {
  f32x2 v = {a, b};
  return __builtin_bit_cast(unsigned, __builtin_convertvector(v, bf16v2));
}
DI float bf2f(u16 v) { return __uint_as_float(((unsigned)v) << 16); }
DI f32x16 mfma32(bf16x8 a, bf16x8 b, f32x16 c) { return __builtin_amdgcn_mfma_f32_32x32x16_bf16(a, b, c, 0, 0, 0); }

DI char* layer_w(char* ws, int l) { return l < 2 ? ws + OFF_KV + (size_t)l * LW_A : ws + OFF_W + (size_t)(l - 2) * LW_B; }

struct Task { const float* src; u16* dst; int K, Nsrc, Ndst, mode; };
DI Task get_task(const Params& p, int task) {
  Task t; t.src = nullptr; t.dst = nullptr; t.K = 0; t.Nsrc = 0; t.Ndst = 0; t.mode = 0;
  if (task == 40) { t.src = p.in[19]; t.dst = (u16*)(p.ws + OFF_WKV); t.K = 1024; t.Nsrc = 2048; t.Ndst = 2048; return t; }
  int l = task / 10, k = task % 10;
  char* wb = layer_w(p.ws, l);
  if (k < 6) {
    int f2 = k / 3, kk = k % 3;
    const float* src = p.in[1 + f2 * 3 + kk];
    if (kk < 2) { t.src = src + (size_t)l * D * F; t.dst = (u16*)(wb + f2 * (SZ_WGU + SZ_WD)); t.K = D; t.Nsrc = F; t.Ndst = F; t.mode = 1 + kk; }
    else { t.src = src + (size_t)l * F * D; t.dst = (u16*)(wb + f2 * (SZ_WGU + SZ_WD) + SZ_WGU); t.K = F; t.Nsrc = D; t.Ndst = D; }
    return t;
  }
  char* mb = wb + 2 * (SZ_WGU + SZ_WD);
  if (l < 2) {
    if (k == 6) { t.src = p.in[9] + (size_t)l * D * 1840; t.dst = (u16*)mb; t.K = D; t.Nsrc = 1840; t.Ndst = 2048; }
    else if (k == 7) { t.src = p.in[18] + (size_t)l * D * D; t.dst = (u16*)(mb + 4194304); t.K = D; t.Nsrc = D; t.Ndst = D; }
    else if (k == 8) { t.src = p.in[11] + (size_t)l * 2048 * 128; t.dst = (u16*)(mb + 4194304 + 2097152); t.K = 2048; t.Nsrc = 128; t.Ndst = 128; }
    else { t.src = p.in[15] + (size_t)l * 2048 * 128; t.dst = (u16*)(mb + 4194304 + 2097152 + 524288); t.K = 2048; t.Nsrc = 128; t.Ndst = 128; }
  } else {
    int j = l - 2;
    if (k == 6) { t.src = p.in[20] + (size_t)j * D * D; t.dst = (u16*)mb; t.K = D; t.Nsrc = D; t.Ndst = D; }
    else if (k == 7) { t.src = p.in[26] + (size_t)j * D * D; t.dst = (u16*)(mb + 2097152); t.K = D; t.Nsrc = D; t.Ndst = D; }
  }
  return t;
}

DI void prep_phase(const Params& p, char* smem) {
  const int tid = get_tid();
  float* T = (float*)smem;
  {
    for (int gt = blockIdx.x; gt < 5056; gt += gridDim.x) {
      int task, tile;
      if (gt >= 4928) { task = 40; tile = gt - 4928; }
      else {
        int l, r;
        if (gt < 2560) { l = gt / 1280; r = gt - l * 1280; } else { l = 2 + (gt - 2560) / 1184; r = (gt - 2560) % 1184; }
        if (r < 1056) { task = l * 10 + r / 176; tile = r % 176; }
        else {
          r -= 1056;
          if (l < 2) { if (r < 128) { task = l * 10 + 6; tile = r; } else if (r < 192) { task = l * 10 + 7; tile = r - 128; } else if (r < 208) { task = l * 10 + 8; tile = r - 192; } else { task = l * 10 + 9; tile = r - 208; } }
          else { if (r < 64) { task = l * 10 + 6; tile = r; } else { task = l * 10 + 7; tile = r - 64; } }
        }
      }
      Task t = get_task(p, task);
      const int nkt = t.K / 256;
      const int k0 = (tile % nkt) * 256, n0 = (tile / nkt) * 64;
      __syncthreads();
      float4 v[8];
#pragma unroll
      for (int e = 0; e < 8; ++e) {
        int idx = tid + e * 512, kk = idx >> 4, n4 = (idx & 15) * 4;
        v[e] = (n0 + n4 < t.Nsrc) ? *(const float4*)(t.src + (size_t)(k0 + kk) * t.Nsrc + n0 + n4) : make_float4(0.f, 0.f, 0.f, 0.f);
      }
#pragma unroll
      for (int e = 0; e < 8; ++e) {
        int idx = tid + e * 512, kk = idx >> 4, n4 = (idx & 15) * 4;
        T[(n4 + 0) * 257 + kk] = v[e].x; T[(n4 + 1) * 257 + kk] = v[e].y; T[(n4 + 2) * 257 + kk] = v[e].z; T[(n4 + 3) * 257 + kk] = v[e].w;
      }
      __syncthreads();
      const int nn = tid >> 3;
      int n = n0 + nn;
      int drow = t.mode == 0 ? n : ((n >> 7) * 256 + (t.mode - 1) * 128 + (n & 127));
#pragma unroll
      for (int j = 0; j < 4; ++j) {
        const int kc = (tid & 7) * 8 + j * 64;
        const float* tp = T + nn * 257 + kc;
        uint4 o;
        o.x = pack2(tp[0], tp[1]); o.y = pack2(tp[2], tp[3]); o.z = pack2(tp[4], tp[5]); o.w = pack2(tp[6], tp[7]);
        *(uint4*)(t.dst + (size_t)drow * t.K + k0 + kc) = o;
      }
    }
  }
  {
    const float4* xs = (const float4*)p.in[0];
    uint4* xb = (uint4*)(p.ws + OFF_XB);
    u16* lo = (u16*)p.out;
    const size_t n8 = (size_t)M * D / 8;
    const size_t stride = (size_t)gridDim.x * NTHR;
    for (size_t i = (size_t)blockIdx.x * NTHR + tid; i < n8; i += 4 * stride) {
      float4 va[4], vb[4];
#pragma unroll
      for (int j = 0; j < 4; ++j) { va[j] = xs[2 * (i + j * stride)]; vb[j] = xs[2 * (i + j * stride) + 1]; }
#pragma unroll
      for (int j = 0; j < 4; ++j) {
        const size_t e = i + j * stride;
        uint4 o; o.x = pack2(va[j].x, va[j].y); o.y = pack2(va[j].z, va[j].w); o.z = pack2(vb[j].x, vb[j].y); o.w = pack2(vb[j].z, vb[j].w);
        xb[e] = o;
        uint4 lw;
        lw.x = ((__float_as_uint(va[j].x) - (o.x << 16)) & 0xffffu) | ((__float_as_uint(va[j].y) - (o.x & 0xffff0000u)) << 16);
        lw.y = ((__float_as_uint(va[j].z) - (o.y << 16)) & 0xffffu) | ((__float_as_uint(va[j].w) - (o.y & 0xffff0000u)) << 16);
        lw.z = ((__float_as_uint(vb[j].x) - (o.z << 16)) & 0xffffu) | ((__float_as_uint(vb[j].y) - (o.z & 0xffff0000u)) << 16);
        lw.w = ((__float_as_uint(vb[j].z) - (o.w << 16)) & 0xffffu) | ((__float_as_uint(vb[j].w) - (o.w & 0xffff0000u)) << 16);
        const size_t row = e >> 7, c8 = e & 127;
        *(uint4*)(lo + row * 2048 + 1024 + c8 * 8) = lw;
      }
    }
  }
  {
    float2* rt = (float2*)(p.ws + OFF_ROPE);
    for (int i = blockIdx.x * NTHR + tid; i < 4096 * 8; i += gridDim.x * NTHR) {
      int pos = i >> 3, k = i & 7;
      float inv = (float)pow(500000.0, -(double)k / 8.0);
      float ang = (float)pos * inv;
      rt[i] = make_float2((float)cos((double)ang), (float)sin((double)ang));
    }
  }
  if (blockIdx.x < 4 && tid < 128) {
    int l = blockIdx.x >> 1, kv = blockIdx.x & 1;
    const float* pos = p.in[kv ? 14 : 10] + (size_t)l * 2048;
    const float* w1 = p.in[kv ? 15 : 11] + (size_t)l * 2048 * 128;
    const float* b1 = p.in[kv ? 16 : 12] + (size_t)l * 128;
    float acc = b1[tid];
    for (int i = 0; i < 2048; ++i) acc += pos[i] * w1[(size_t)i * 128 + tid];
    ((float*)(p.ws + OFF_B1P))[(l * 2 + kv) * 128 + tid] = acc;
  }
}

#define LAS __attribute__((address_space(3)))
constexpr int BM = 256, BK = 64, HALF = 128, HTB = HALF * BK * 2;

DI int lds_byte(int r, int c) {
  const int st = (r >> 4) * 2 + (c >> 5), rr = r & 15, cc = c & 31, ob = rr * 64 + cc * 2;
  return st * 1024 + (ob ^ (((ob >> 9) & 1) << 5));
}
DI void stage_rc(int b, int& R, int& C) {
  const int st = b / 1024, sb = b % 1024, swz = sb ^ (((sb >> 9) & 1) << 5);
  R = (st >> 1) * 16 + swz / 64; C = (st & 1) * 32 + (swz % 64) / 2;
}
DI int perm32(int rho) { const int n = rho >> 4, i = rho & 15; return 8 * (i >> 2) + 4 * n + (i & 3); }

enum { EPI_GATEUP = 0, EPI_RESID = 1, EPI_NSA_IN = 2, EPI_DIFF_Q = 3, EPI_DIFF_KV = 4 };

DI bool unit_next(int i, int nM, int nN, int& pm, int& pn) {
  const int nwg = nM * nN;
  const long L = (long)i * gridDim.x + blockIdx.x;
  if (L >= nwg) return false;
  int wgid = (int)L;
  { const int q = nwg / 8, r = nwg % 8, xcd = wgid % 8, off = wgid / 8; wgid = (xcd < r ? xcd * (q + 1) : r * (q + 1) + (xcd - r) * q) + off; }
  const int nig = 8 * nN, gid = wgid / nig, fm = gid * 8, gsz = (nM - fm) < 8 ? (nM - fm) : 8;
  pm = fm + ((wgid % nig) % gsz); pn = (wgid % nig) / gsz;
  return true;
}

DI void rope8(float* v, int fq, int pos, const float* rt, int lane) {
  float o[8];
#pragma unroll
  for (int i = 0; i < 8; ++i) o[i] = shx(v[i], 16, lane);
  if (fq < 2) {
    const float4* r4 = (const float4*)(rt + pos * 16);
#pragma unroll
    for (int i = 0; i < 4; ++i) {
      float4 cs = r4[i];
      float a0 = v[2 * i], a1 = v[2 * i + 1];
      if (fq == 0) { v[2 * i] = a0 * cs.x - o[2 * i] * cs.y; v[2 * i + 1] = a1 * cs.z - o[2 * i + 1] * cs.w; }
      else { v[2 * i] = o[2 * i] * cs.y + a0 * cs.x; v[2 * i + 1] = o[2 * i + 1] * cs.w + a1 * cs.z; }
    }
  }
}
DI uint4 pack8(const float* v) {
  uint4 o; o.x = pack2(v[0], v[1]); o.y = pack2(v[2], v[3]); o.z = pack2(v[4], v[5]); o.w = pack2(v[6], v[7]);
  return o;
}

DI void gemm_epi(const Params& p, int mode, float coef, const f32x4 (&acc)[2][2][4][2], int pm, int pn, int wr, int wc, int fr, int fq) {
  char* ws = launder_ptr(p.ws);
  const float* rt = (const float*)(ws + OFF_ROPE);
#pragma unroll
  for (int ai = 0; ai < 2; ++ai)
#pragma unroll
    for (int m = 0; m < 4; ++m) {
      const int row = pm * BM + ai * HALF + wr * 64 + m * 16 + fr;
      const int b = row >> 12, s = row & 4095;
      if (mode == EPI_GATEUP) {
        float v[8];
#pragma unroll
        for (int n = 0; n < 2; ++n)
#pragma unroll
          for (int e = 0; e < 4; ++e) {
            float gv = acc[ai][0][m][n][e], uv = acc[ai][1][m][n][e];
            v[n * 4 + e] = gv * uv * __builtin_amdgcn_rcpf(1.f + __builtin_amdgcn_exp2f(-1.4426950408889634f * gv));
          }
        *(uint4*)((u16*)(ws + OFF_H) + (size_t)row * F + pn * 128 + wc * 32 + 8 * fq) = pack8(v);
      } else if (mode == EPI_RESID) {
#pragma unroll
        for (int bj = 0; bj < 2; ++bj)
#pragma unroll
          for (int n = 0; n < 2; ++n) {
            float4* xp = (float4*)(p.out + (size_t)row * D + pn * BM + bj * HALF + wc * 32 + 16 * n + 4 * fq);
            float4 x = *xp; f32x4 a = acc[ai][bj][m][n];
            x.x = ALPHA * x.x + coef * a[0]; x.y = ALPHA * x.y + coef * a[1]; x.z = ALPHA * x.z + coef * a[2]; x.w = ALPHA * x.w + coef * a[3];
            *xp = x;
          }
      } else {
#pragma unroll
        for (int bj = 0; bj < 2; ++bj) {
          const int cb = pn * BM + bj * HALF + wc * 32, c = cb + 8 * fq;
          const bool head0 = (wc & 1) == 0;
          float v[8];
#pragma unroll
          for (int e = 0; e < 4; ++e) { v[e] = acc[ai][bj][m][0][e]; v[4 + e] = acc[ai][bj][m][1][e]; }
          if (mode == EPI_NSA_IN) {
            if (cb < 1024) {
#pragma unroll
              for (int e = 0; e < 8; ++e) v[e] *= 0.18033688011112042f;
              *(uint4*)((u16*)(ws + OFF_PROJ) + (size_t)row * D + c) = pack8(v);
            } else if (cb < 1792) {
              const int seg = (cb - 1024) >> 7, g = ((cb - 1024) >> 6) & 1, d = c & 63;
              if (head0 && (seg == 2 || seg == 4)) rope8(v, fq, s, rt, fq * 16 + fr);
              *(uint4*)((u16*)(ws + OFF_SEG + (size_t)seg * SZ_SEG) + ((size_t)(b * 2 + g) * S + s) * 64 + d) = pack8(v);
            } else if (c < 1840) {
              float4* gp = (float4*)((float*)(ws + OFF_GATES) + (size_t)row * 48 + (c - 1792));
              gp[0] = make_float4(v[0], v[1], v[2], v[3]); gp[1] = make_float4(v[4], v[5], v[6], v[7]);
            }
          } else if (mode == EPI_DIFF_Q) {
#pragma unroll
            for (int e = 0; e < 8; ++e) v[e] *= 0.18033688011112042f;
            *(uint4*)((u16*)(ws + OFF_PROJ) + (size_t)row * D + c) = pack8(v);
          } else {
            if (cb < 1024) {
              const int which = cb >> 9, hd = (cb >> 6) & 7, d = c & 63;
              if (head0) rope8(v, fq, s, rt, fq * 16 + fr);
              *(uint4*)((u16*)(ws + OFF_KD) + ((size_t)((b * 2 + which) * 8 + hd) * S + s) * 64 + d) = pack8(v);
            } else {
              const int e0 = c - 1024, hd = e0 >> 7, dv = e0 & 127;
              *(uint4*)((u16*)(ws + OFF_VD) + ((size_t)(b * 8 + hd) * S + s) * 128 + dv) = pack8(v);
            }
          }
        }
      }
    }
}


DI void fused_ln_epi(const Params& p, char* smem, float coef, f32x4 (&acc)[2][2][4][2], int pm, int pn, int wr, int wc, int fr, int fq,
                     int tid, int lnk, const float* g, const float* bt) {
  const int lane = fq * 16 + fr;
  char* ws = launder_ptr(p.ws); float* xout = (float*)launder_ptr((char*)p.out);
  u16* xb = (u16*)(ws + OFF_XB);
  u16* xlo = (u16*)xout;
  float2* P = (float2*)smem;
  float2* Sx = P + 1024;
  u64* slots = (u64*)(ws + OFF_SLOTS);
  unsigned* cnt = (unsigned*)(ws + OFF_CNT);
  int rl0 = wr * 64 + fr;
  asm volatile("" : "+v"(rl0));
  const int coff = pn * BM + wc * 32 + 8 * fq;
#pragma unroll
  for (int ai = 0; ai < 2; ++ai) {
    uint4 hreg[4][2], lreg[4][2];
#pragma unroll
    for (int m = 0; m < 4; ++m) {
      const size_t roff = (size_t)(pm * BM + rl0 + ai * HALF + m * 16);
#pragma unroll
      for (int bj = 0; bj < 2; ++bj) {
        hreg[m][bj] = *(const uint4*)(xb + roff * D + coff + bj * HALF);
        lreg[m][bj] = *(const uint4*)(xlo + roff * 2048 + 1024 + coff + bj * HALF);
      }
    }
#pragma unroll
    for (int m = 0; m < 4; ++m) {
      int rl = rl0 + ai * HALF + m * 16;
      asm volatile("" : "+v"(rl));
      float s = 0.f, q = 0.f;
#pragma unroll
      for (int bj = 0; bj < 2; ++bj) {
        const uint4 h8 = hreg[m][bj], l8 = lreg[m][bj];
        const unsigned hw[4] = {h8.x, h8.y, h8.z, h8.w}, lw[4] = {l8.x, l8.y, l8.z, l8.w};
#pragma unroll
        for (int n = 0; n < 2; ++n) {
          float4 x;
          x.x = __uint_as_float((hw[2 * n] << 16) + (unsigned)(int)(short)(lw[2 * n] & 0xffffu));
          x.y = __uint_as_float((hw[2 * n] & 0xffff0000u) + (unsigned)((int)lw[2 * n] >> 16));
          x.z = __uint_as_float((hw[2 * n + 1] << 16) + (unsigned)(int)(short)(lw[2 * n + 1] & 0xffffu));
          x.w = __uint_as_float((hw[2 * n + 1] & 0xffff0000u) + (unsigned)((int)lw[2 * n + 1] >> 16));
          f32x4 a = acc[ai][bj][m][n];
          a[0] = ALPHA * x.x + coef * a[0]; a[1] = ALPHA * x.y + coef * a[1]; a[2] = ALPHA * x.z + coef * a[2]; a[3] = ALPHA * x.w + coef * a[3];
          acc[ai][bj][m][n] = a;
          s += (a[0] + a[1]) + (a[2] + a[3]);
          q += (a[0] * a[0] + a[1] * a[1]) + (a[2] * a[2] + a[3] * a[3]);
        }
      }
      s += shx(s, 16, lane); q += shx(q, 16, lane);
      s += shx(s, 32, lane); q += shx(q, 32, lane);
      if (fq == 0) P[rl * 4 + wc] = make_float2(s, q);
    }
  }
  float4 gq[2][2], bq2[2][2];
#pragma unroll
  for (int bj = 0; bj < 2; ++bj) {
    const int c = pn * BM + bj * HALF + wc * 32 + 8 * fq;
    gq[bj][0] = *(const float4*)(g + c); gq[bj][1] = *(const float4*)(g + c + 4);
    bq2[bj][0] = *(const float4*)(bt + c); bq2[bj][1] = *(const float4*)(bt + c + 4);
  }
  __syncthreads();
  if (tid < 256) {
    const float2 a0 = P[tid * 4], a1 = P[tid * 4 + 1], a2 = P[tid * 4 + 2], a3 = P[tid * 4 + 3];
    const float s = (a0.x + a1.x) + (a2.x + a3.x), q = (a0.y + a1.y) + (a2.y + a3.y);
    const u64 bits = ((u64)__float_as_uint(q) << 32) | (u64)__float_as_uint(s);
    __hip_atomic_store(slots + ((size_t)(pm * 4 + pn) * 256 + tid), bits, __ATOMIC_RELAXED, __HIP_MEMORY_SCOPE_AGENT);
  }
  asm volatile("s_waitcnt vmcnt(0)" ::: "memory");
  __syncthreads();
  if (tid == 0) {
    unsigned* c = cnt + pm * 64;
    (void)__hip_atomic_fetch_add(c, 1u, __ATOMIC_RELAXED, __HIP_MEMORY_SCOPE_AGENT);
    const unsigned need = 4u * (unsigned)(lnk + 1);
    unsigned sp = 0;
    while (__hip_atomic_load(c, __ATOMIC_RELAXED, __HIP_MEMORY_SCOPE_AGENT) < need) {
      __builtin_amdgcn_s_sleep(1);
      if (++sp > (1u << 24)) break;
    }
  }
  __syncthreads();
  if (tid < 256) {
    float s = 0.f, q = 0.f;
    {
      const u64* sp0 = slots + ((size_t)(pm * 4) * 256 + tid);
      u64 b0, b1, b2, b3;
      asm volatile("global_load_dwordx2 %0, %4, off sc1\n\tglobal_load_dwordx2 %1, %5, off sc1\n\tglobal_load_dwordx2 %2, %6, off sc1\n\tglobal_load_dwordx2 %3, %7, off sc1\n\ts_waitcnt vmcnt(0)"
                   : "=&v"(b0), "=&v"(b1), "=&v"(b2), "=&v"(b3) : "v"(sp0), "v"(sp0 + 256), "v"(sp0 + 512), "v"(sp0 + 768) : "memory");
      s = ((__uint_as_float((unsigned)b0) + __uint_as_float((unsigned)b1)) + __uint_as_float((unsigned)b2)) + __uint_as_float((unsigned)b3);
      q = ((__uint_as_float((unsigned)(b0 >> 32)) + __uint_as_float((unsigned)(b1 >> 32))) + __uint_as_float((unsigned)(b2 >> 32))) + __uint_as_float((unsigned)(b3 >> 32));
    }
    const float mean = s * (1.f / D);
    const float var = fmaxf(q * (1.f / D) - mean * mean, 0.f);
    Sx[tid] = make_float2(mean, rsqrtf(var + 1e-5f));
  }
  __syncthreads();
#pragma unroll
  for (int bj = 0; bj < 2; ++bj) {
    const int c = pn * BM + bj * HALF + wc * 32 + 8 * fq;
    const float4 g0 = gq[bj][0], g1 = gq[bj][1];
    const float4 b0 = bq2[bj][0], b1 = bq2[bj][1];
#pragma unroll
    for (int ai = 0; ai < 2; ++ai)
#pragma unroll
      for (int m = 0; m < 4; ++m) {
        int rl = rl0 + ai * HALF + m * 16;
        asm volatile("" : "+v"(rl));
        const float2 ms = Sx[rl];
        const f32x4 a = acc[ai][bj][m][0], bq = acc[ai][bj][m][1];
        float v[8];
        v[0] = (a[0] - ms.x) * ms.y * g0.x + b0.x; v[1] = (a[1] - ms.x) * ms.y * g0.y + b0.y;
        v[2] = (a[2] - ms.x) * ms.y * g0.z + b0.z; v[3] = (a[3] - ms.x) * ms.y * g0.w + b0.w;
        v[4] = (bq[0] - ms.x) * ms.y * g1.x + b1.x; v[5] = (bq[1] - ms.x) * ms.y * g1.y + b1.y;
        v[6] = (bq[2] - ms.x) * ms.y * g1.z + b1.z; v[7] = (bq[3] - ms.x) * ms.y * g1.w + b1.w;
        const size_t roff = (size_t)(pm * BM + rl);
        if (lnk == 11) {
          float* xo = xout + roff * D + c;
          *(float4*)xo = make_float4(v[0], v[1], v[2], v[3]);
          *(float4*)(xo + 4) = make_float4(v[4], v[5], v[6], v[7]);
        } else {
          const uint4 h8 = pack8(v);
          *(uint4*)(xb + roff * D + c) = h8;
          uint4 l8;
          l8.x = ((__float_as_uint(v[0]) - (h8.x << 16)) & 0xffffu) | ((__float_as_uint(v[1]) - (h8.x & 0xffff0000u)) << 16);
          l8.y = ((__float_as_uint(v[2]) - (h8.y << 16)) & 0xffffu) | ((__float_as_uint(v[3]) - (h8.y & 0xffff0000u)) << 16);
          l8.z = ((__float_as_uint(v[4]) - (h8.z << 16)) & 0xffffu) | ((__float_as_uint(v[5]) - (h8.z & 0xffff0000u)) << 16);
          l8.w = ((__float_as_uint(v[6]) - (h8.w << 16)) & 0xffffu) | ((__float_as_uint(v[7]) - (h8.w & 0xffff0000u)) << 16);
          *(uint4*)(xlo + roff * 2048 + 1024 + c) = l8;
        }
      }
  }
  __syncthreads();
}

DI void gemm_phase(const Params& p, char* smem, const u16* Ag, const u16* Btg, int N, int K, int mode, float coef, int lnk, const float* lng, const float* lnb) {
  LAS unsigned char* lds = (LAS unsigned char*)smem;
  const int tid = get_tid(), wid = __builtin_amdgcn_readfirstlane(tid >> 6), lane = tid & 63, wr = wid >> 2, wc = wid & 3, fr = lane & 15, fq = lane >> 4;
  const int nt = K / BK, nM = M / BM, nN = N / BM;
  const bool perm = true;
  const bool single = (mode == EPI_RESID);
  unsigned voffA[2], voffB[2];
#pragma unroll
  for (int i = 0; i < 2; ++i) {
    int R, C; stage_rc(tid * 16 + i * 8192, R, C);
    const int Rb = perm ? ((R & ~31) + perm32(R & 31)) : R;
    voffA[i] = (unsigned)(R * K + C) * 2u; voffB[i] = (unsigned)(Rb * K + C) * 2u;
  }
  const size_t kstep = (size_t)(BK * 2);
  const size_t hstep = (size_t)HALF * K * 2;
  const size_t tstep = 2 * hstep;
  const unsigned ldsw = (unsigned)wid * 1024u;
  const int aoff = lds_byte(wr * 64 + fr, fq * 8), boff = lds_byte(wc * 32 + fr, fq * 8);
#define G_SA(b, h) (((b) * 2 + (h)) * HTB)
#define G_SB(b, h) ((4 + (b) * 2 + (h)) * HTB)
#define G_STAGE(bufoff, gbase, voff) do { _Pragma("unroll") for (int _i = 0; _i < 2; ++_i) \
    __builtin_amdgcn_global_load_lds((const unsigned*)((const char*)(gbase) + (voff)[_i]), (LAS unsigned*)(lds + (bufoff) + ldsw + _i * 8192), 16, 0, 0); } while (0)
#define G_LDA(dst, b, h) do { _Pragma("unroll") for (int m = 0; m < 4; ++m) _Pragma("unroll") for (int k = 0; k < 2; ++k) dst[m][k] = *(const LAS bf16x8*)(lds + G_SA(b, h) + aoff + m * 2048 + k * 1024); } while (0)
#define G_LDB(dst, b, h) do { _Pragma("unroll") for (int n = 0; n < 2; ++n) _Pragma("unroll") for (int k = 0; k < 2; ++k) dst[n][k] = *(const LAS bf16x8*)(lds + G_SB(b, h) + boff + n * 2048 + k * 1024); } while (0)
#define G_MMA(ai, bj, At, Bt) do { __builtin_amdgcn_s_setprio(1); _Pragma("unroll") for (int m = 0; m < 4; ++m) _Pragma("unroll") for (int n = 0; n < 2; ++n) _Pragma("unroll") for (int k = 0; k < 2; ++k) \
    acc[ai][bj][m][n] = __builtin_amdgcn_mfma_f32_16x16x32_bf16(Bt[n][k], At[m][k], acc[ai][bj][m][n], 0, 0, 0); __builtin_amdgcn_s_setprio(0); } while (0)
#define G_WAIT_V(n) asm volatile("s_waitcnt vmcnt(" #n ")" ::: "memory")
#define G_WAIT_L(n) asm volatile("s_waitcnt lgkmcnt(" #n ")" ::: "memory")
#define G_BAR __builtin_amdgcn_s_barrier()
#define G_SCHED __builtin_amdgcn_sched_barrier(0)
  int cpm, cpn, npm = 0, npn = 0, ui = 0;
  f32x4 acc[2][2][4][2];
  bf16x8 At[4][2], B0[2][2], B1[2][2];
  for (int ubase = 0;; ++ubase) {
  if (!unit_next(ubase, nM, nN, cpm, cpn)) break;
  ui = ubase;
#pragma unroll
  for (int a = 0; a < 2; ++a)
#pragma unroll
    for (int b = 0; b < 2; ++b)
#pragma unroll
      for (int m = 0; m < 4; ++m)
#pragma unroll
        for (int n = 0; n < 2; ++n) acc[a][b][m][n] = (f32x4){0.f, 0.f, 0.f, 0.f};
  const char* cA = (const char*)Ag + (size_t)cpm * tstep; const char* cB = (const char*)Btg + (size_t)cpn * tstep;
  G_STAGE(G_SB(0, 0), cB, voffB); G_STAGE(G_SA(0, 0), cA, voffA); G_STAGE(G_SB(0, 1), cB + hstep, voffB); G_STAGE(G_SA(0, 1), cA + hstep, voffA);
  if (wr == 1) G_BAR;
  G_WAIT_V(4); G_BAR;
  G_STAGE(G_SB(1, 0), cB + kstep, voffB); G_STAGE(G_SA(1, 0), cA + kstep, voffA); G_STAGE(G_SB(1, 1), cB + hstep + kstep, voffB);
  G_WAIT_V(6); G_BAR;
  for (;;) {
    const bool has_next = unit_next(ui + 1, nM, nN, npm, npn);
    const char* nA = has_next ? (const char*)Ag + (size_t)npm * tstep : cA; const char* nB = has_next ? (const char*)Btg + (size_t)npn * tstep : cB;
    for (int t = 0; t < nt; t += 2) {
      const bool last = (t == nt - 2);
      const char* a1 = cA + (size_t)(t + 1) * kstep;
      const char* a2 = last ? nA : cA + (size_t)(t + 2) * kstep; const char* b2 = last ? nB : cB + (size_t)(t + 2) * kstep;
      const char* a3 = a2 + kstep; const char* b3 = b2 + kstep;
      G_LDB(B0, 0, 0); G_SCHED; G_LDA(At, 0, 0); G_STAGE(G_SA(1, 1), a1 + hstep, voffA);
      G_WAIT_L(8); G_BAR; G_WAIT_L(0); G_MMA(0, 0, At, B0); G_BAR; G_SCHED;
      G_LDB(B1, 0, 1); G_STAGE(G_SB(0, 0), b2, voffB);
      G_BAR; G_WAIT_L(0); G_MMA(0, 1, At, B1); G_BAR;
      G_LDA(At, 0, 1); G_STAGE(G_SA(0, 0), a2, voffA);
      G_BAR; G_WAIT_L(0); G_MMA(1, 0, At, B0); G_BAR; G_SCHED;
      G_STAGE(G_SB(0, 1), b2 + hstep, voffB);
      G_WAIT_V(6); G_BAR; G_MMA(1, 1, At, B1); G_BAR;
      G_LDB(B0, 1, 0); G_SCHED; G_LDA(At, 1, 0); G_STAGE(G_SA(0, 1), a2 + hstep, voffA);
      G_WAIT_L(8); G_BAR; G_WAIT_L(0); G_MMA(0, 0, At, B0); G_BAR; G_SCHED;
      G_LDB(B1, 1, 1); G_STAGE(G_SB(1, 0), b3, voffB);
      G_BAR; G_WAIT_L(0); G_MMA(0, 1, At, B1); G_BAR;
      G_LDA(At, 1, 1); G_STAGE(G_SA(1, 0), a3, voffA);
      G_BAR; G_WAIT_L(0); G_MMA(1, 0, At, B0); G_BAR; G_SCHED;
      G_STAGE(G_SB(1, 1), b3 + hstep, voffB);
      G_WAIT_V(6); G_BAR; G_MMA(1, 1, At, B1); G_BAR;
    }
    if (!single) {
      gemm_epi(p, mode, coef, acc, cpm, cpn, wr, wc, fr, fq);
      if (!has_next) break;
    } else {
      if (!has_next) G_WAIT_V(0);
      if (wr == 0) G_BAR;
      if (!has_next) G_BAR;
      fused_ln_epi(p, smem + 131072, coef, acc, cpm, cpn, wr, wc, fr, fq, tid, lnk, lng, lnb);
      if (!has_next) break;
      if (wr == 1) G_BAR;
    }
#pragma unroll
    for (int a = 0; a < 2; ++a)
#pragma unroll
      for (int b = 0; b < 2; ++b)
#pragma unroll
        for (int m = 0; m < 4; ++m)
#pragma unroll
          for (int n = 0; n < 2; ++n) acc[a][b][m][n] = (f32x4){0.f, 0.f, 0.f, 0.f};
    cpm = npm; cpn = npn; cA = nA; cB = nB; ++ui;
  }
  if (!single) {
    G_WAIT_V(0);
    if (wr == 0) G_BAR;
    G_BAR;
  }
  break;
  }
#undef G_SA
#undef G_SB
#undef G_STAGE
#undef G_LDA
#undef G_LDB
#undef G_MMA
}

DI float gelu_tanh(float x) {
  float u = 0.7978845608028654f * (x + 0.044715f * x * x * x);
  return 0.5f * x * (1.f + tanhf(u));
}

DI void compress_phase(const Params& p, char* smem, int l) {
  const int tid = get_tid(), w = tid >> 6, lane = tid & 63, fr = lane & 15, fq = lane >> 4;
  float* hid = (float*)smem;
  char* ws = launder_ptr(p.ws);
  char* mb = layer_w(ws, l) + 2 * (SZ_WGU + SZ_WD);
  for (int item = blockIdx.x; item < 512; item += gridDim.x) {
    const int kv = item & 1, ct = (item >> 1) & 15, bg = item >> 5;
    const u16* src = (const u16*)(ws + OFF_SEG + (size_t)kv * SZ_SEG) + (size_t)bg * S * 64;
    const u16* w1t = (const u16*)(mb + 4194304 + 2097152 + (size_t)kv * 524288);
    const float* w2 = p.in[kv ? 17 : 13] + (size_t)l * 128 * 64;
    const float* b1p = (const float*)(ws + OFF_B1P) + (l * 2 + kv) * 128;
    const int c0 = ct * 16;
    int cr = c0 + fr; if (cr > 254) cr = 254;
    const u16* ap = src + (size_t)cr * 16 * 64 + fq * 8;
    const u16* bp = w1t + (size_t)(w * 16 + fr) * 2048 + fq * 8;
    f32x4 acc = {0.f, 0.f, 0.f, 0.f};
#pragma unroll 16
    for (int kk = 0; kk < 64; ++kk) {
      bf16x8 a = *(const bf16x8*)(ap + kk * 32);
      bf16x8 bb = *(const bf16x8*)(bp + kk * 32);
      acc = __builtin_amdgcn_mfma_f32_16x16x32_bf16(a, bb, acc, 0, 0, 0);
    }
    __syncthreads();
#pragma unroll
    for (int j = 0; j < 4; ++j) {
      int col = w * 16 + fr;
      hid[(fq * 4 + j) * 128 + col] = gelu_tanh(acc[j] + b1p[col]);
    }
    __syncthreads();
#pragma unroll
    for (int e = 0; e < 2; ++e) {
      int o = tid + e * 512, r = o >> 6, d = o & 63;
      float s = 0.f;
      for (int k = 0; k < 128; ++k) s += hid[r * 128 + k] * w2[k * 64 + d];
      int c = c0 + r;
      if (c < 255) {
        if (kv == 0) ((u16*)(ws + OFF_KCMP))[((size_t)bg * 256 + c) * 64 + d] = f2bf(s);
        else ((u16*)(ws + OFF_VCMPT))[((size_t)bg * 256 + c) * 64 + d] = f2bf(s);
      }
    }
  }
}

template <int KS>
DI f32x16 qk_tile(const u16* Ksub, const bf16x8* qf, int ql, int h, float init = 0.f) {
  f32x16 s;
#pragma unroll
  for (int i = 0; i < 16; ++i) s[i] = init;
#pragma unroll
  for (int ks = 0; ks < 4; ++ks) {
    bf16x8 a = *(const bf16x8*)(Ksub + ql * KS + ks * 16 + h * 8);
    s = mfma32(a, qf[ks], s);
  }
  return s;
}
template <int KS>
DI f32x16 qk_tile_lds(const u16* Ksub, const u16* Qsub, int ql, int h, float init) {
  f32x16 s;
#pragma unroll
  for (int i = 0; i < 16; ++i) s[i] = init;
#pragma unroll
  for (int ks = 0; ks < 4; ++ks) {
    bf16x8 a = *(const bf16x8*)(Ksub + ql * KS + ks * 16 + h * 8);
    bf16x8 b = *(const bf16x8*)(Qsub + ql * KS + ks * 16 + h * 8);
    s = mfma32(a, b, s);
  }
  return s;
}
DI s16x4 tr_read(const u16* ptr) { return __builtin_amdgcn_ds_read_tr16_b64_v4i16((LAS s16x4*)ptr); }
template <int NMB, int VS>
DI void pv_tile(const u16* vsub, const bf16x8* pf, f32x16* O, int lane) {
  const int l16 = lane & 15, q = l16 >> 2, pp = l16 & 3, blk = (lane >> 4) & 1, h = lane >> 5;
  const u16* base = vsub + (4 * h + q) * VS + 16 * blk + 4 * pp;
#pragma unroll
  for (int mb = 0; mb < NMB; ++mb)
#pragma unroll
    for (int s2 = 0; s2 < 2; ++s2) {
      s16x4 lo = tr_read(base + (16 * s2) * VS + mb * 32);
      s16x4 hi = tr_read(base + (16 * s2 + 8) * VS + mb * 32);
      bf16x8 a = __builtin_shufflevector(lo, hi, 0, 1, 2, 3, 4, 5, 6, 7);
      O[mb] = mfma32(a, pf[s2], O[mb]);
    }
}
template <int VS>
DI void pv_load(const u16* vsub, bf16x8* vf, int lane) {
  const int l16 = lane & 15, q = l16 >> 2, pp = l16 & 3, blk = (lane >> 4) & 1, h = lane >> 5;
  const u16* base = vsub + (4 * h + q) * VS + 16 * blk + 4 * pp;
#pragma unroll
  for (int mb = 0; mb < 2; ++mb)
#pragma unroll
    for (int s2 = 0; s2 < 2; ++s2) {
      s16x4 lo = tr_read(base + (16 * s2) * VS + mb * 32);
      s16x4 hi = tr_read(base + (16 * s2 + 8) * VS + mb * 32);
      vf[mb * 2 + s2] = __builtin_shufflevector(lo, hi, 0, 1, 2, 3, 4, 5, 6, 7);
    }
}
DI void pv_mma(const bf16x8* vf, const bf16x8* pf, f32x16* O) {
#pragma unroll
  for (int mb = 0; mb < 2; ++mb)
#pragma unroll
    for (int s2 = 0; s2 < 2; ++s2) O[mb] = mfma32(vf[mb * 2 + s2], pf[s2], O[mb]);
}
template <int KS>
DI void k_load8(const u16* Kt, bf16x8* kf, int ql, int h) {
#pragma unroll
  for (int sub = 0; sub < 2; ++sub)
#pragma unroll
    for (int ks = 0; ks < 4; ++ks) kf[sub * 4 + ks] = *(const bf16x8*)(Kt + (sub * 32 + ql) * KS + ks * 16 + h * 8);
}
DI f32x16 qk_mma(const bf16x8* kf, const bf16x8* qf, float init) {
  f32x16 s;
#pragma unroll
  for (int i = 0; i < 16; ++i) s[i] = init;
#pragma unroll
  for (int ks = 0; ks < 4; ++ks) s = mfma32(kf[ks], qf[ks], s);
  return s;
}
template <int VS>
DI void v_load8(const u16* Vt, bf16x8* vf, int lane) {
  const int l16 = lane & 15, q = l16 >> 2, pp = l16 & 3, blk = (lane >> 4) & 1, h = lane >> 5;
  const u16* base = Vt + (4 * h + q) * VS + 16 * blk + 4 * pp;
#pragma unroll
  for (int sub = 0; sub < 2; ++sub)
#pragma unroll
    for (int mb = 0; mb < 2; ++mb)
#pragma unroll
      for (int s2 = 0; s2 < 2; ++s2) {
        s16x4 lo = tr_read(base + (sub * 32 + 16 * s2) * VS + mb * 32);
        s16x4 hi = tr_read(base + (sub * 32 + 16 * s2 + 8) * VS + mb * 32);
        vf[sub * 4 + mb * 2 + s2] = __builtin_shufflevector(lo, hi, 0, 1, 2, 3, 4, 5, 6, 7);
      }
}
DI void pv_mma8(const bf16x8* vf, const bf16x8* pf, f32x16* O) {
#pragma unroll
  for (int sub = 0; sub < 2; ++sub)
#pragma unroll
    for (int mb = 0; mb < 2; ++mb)
#pragma unroll
      for (int s2 = 0; s2 < 2; ++s2) O[mb] = mfma32(vf[sub * 4 + mb * 2 + s2], pf[sub * 2 + s2], O[mb]);
}
constexpr float NINF = -__builtin_inff();
template <bool MASK>
DI bool softmax_step(f32x16& s, int kbase, int lo, int hi, float& m, float& l, float& alpha, bf16x8* pf, int lane) {
  if (MASK) {
#pragma unroll
    for (int i = 0; i < 16; ++i) {
      int kp = kbase + (i & 3) + 8 * (i >> 2);
      s[i] = ((kp > lo) && (kp <= hi)) ? s[i] : NINF;
    }
  }
  float mx = fmaxf(fmaxf(s[0], s[1]), s[2]);
#pragma unroll
  for (int i = 3; i < 15; i += 2) mx = fmaxf(fmaxf(mx, s[i]), s[i + 1]);
  mx = fmaxf(mx, s[15]);
  const bool need = __any(mx > 8.f);
  alpha = 1.f;
  if (need) {
    mx = fmaxf(mx, shx(mx, 32, lane));
    const float d = fmaxf(mx, 0.f);
    alpha = __builtin_amdgcn_exp2f(-d);
    l *= alpha;
    m += d;
#pragma unroll
    for (int i = 0; i < 16; ++i) s[i] -= d;
  }
  float rs = 0.f;
#pragma unroll
  for (int i = 0; i < 16; ++i) {
    float pv = __builtin_amdgcn_exp2f(s[i]);
    s[i] = pv; rs += pv;
  }
  l += rs;
#pragma unroll
  for (int s2 = 0; s2 < 2; ++s2) {
    unsigned u[4];
#pragma unroll
    for (int j = 0; j < 4; ++j) u[j] = pack2(s[8 * s2 + 2 * j], s[8 * s2 + 2 * j + 1]);
    pf[s2] = __builtin_bit_cast(bf16x8, *(uint4*)u);
  }
  return need;
}

template <bool MASK>
DI bool softmax_step64(f32x16& s0, f32x16& s1, int kbase, int lo, int hi, float& m, float& l, float& alpha, bf16x8* pf, int lane) {
  if (MASK) {
#pragma unroll
    for (int i = 0; i < 16; ++i) {
      int kp = kbase + (i & 3) + 8 * (i >> 2);
      s0[i] = ((kp > lo) && (kp <= hi)) ? s0[i] : NINF;
      s1[i] = ((kp + 32 > lo) && (kp + 32 <= hi)) ? s1[i] : NINF;
    }
  }
  float mx = fmaxf(s0[0], s1[0]);
#pragma unroll
  for (int i = 1; i < 16; ++i) mx = fmaxf(fmaxf(mx, s0[i]), s1[i]);
  const bool need = __any(mx > 8.f);
  alpha = 1.f;
  if (need) {
    mx = fmaxf(mx, shx(mx, 32, lane));
    const float d = fmaxf(mx, 0.f);
    alpha = __builtin_amdgcn_exp2f(-d);
    l *= alpha;
    m += d;
#pragma unroll
    for (int i = 0; i < 16; ++i) { s0[i] -= d; s1[i] -= d; }
  }
  float rs0 = 0.f, rs1 = 0.f;
#pragma unroll
  for (int i = 0; i < 16; ++i) {
    float p0 = __builtin_amdgcn_exp2f(s0[i]), p1 = __builtin_amdgcn_exp2f(s1[i]);
    s0[i] = p0; s1[i] = p1; rs0 += p0; rs1 += p1;
  }
  l += rs0 + rs1;
#pragma unroll
  for (int s2 = 0; s2 < 2; ++s2) {
    unsigned u[4], v[4];
#pragma unroll
    for (int j = 0; j < 4; ++j) { u[j] = pack2(s0[8 * s2 + 2 * j], s0[8 * s2 + 2 * j + 1]); v[j] = pack2(s1[8 * s2 + 2 * j], s1[8 * s2 + 2 * j + 1]); }
    pf[s2] = __builtin_bit_cast(bf16x8, *(uint4*)u);
    pf[2 + s2] = __builtin_bit_cast(bf16x8, *(uint4*)v);
  }
  return need;
}

constexpr int KST = 72, VST = 96, VDS = 160;

DI void nsa_load_q(const u16* qbase, long row, int hq, int h, bf16x8* qf) {
#pragma unroll
  for (int ks = 0; ks < 4; ++ks) qf[ks] = *(const bf16x8*)(qbase + row * D + hq * 64 + ks * 16 + h * 8);
}

DI void nsa_attn_phase(const Params& p, char* smem) {
  const int tid0 = get_tid();
  u16* Kb = (u16*)smem;
  u16* Vb = Kb + 2 * 64 * KST;
  u16* Kc = Vb + 2 * 64 * VST;
  u16* Vc = Kc + 256 * KST;
  unsigned* imp = (unsigned*)(Vc + 256 * VST);
  u64* sel = (u64*)(imp + 32 * 65);
  unsigned* uni = (unsigned*)(sel + 32);
  char* ws = launder_ptr(p.ws);
  const u16* KS_g = (const u16*)(ws + OFF_SEG + 2 * SZ_SEG);
  const u16* VS_g = (const u16*)(ws + OFF_SEG + 3 * SZ_SEG);
  const u16* KW_g = (const u16*)(ws + OFF_SEG + 4 * SZ_SEG);
  const u16* VW_g = (const u16*)(ws + OFF_SEG + 5 * SZ_SEG);
  const float* gates = (const float*)(ws + OFF_GATES);
  u16* Oout = (u16*)(ws + OFF_PROJ);

  for (int item = blockIdx.x; item < 2048; item += gridDim.x) {
    const int rnd = item >> 8, j256 = item & 255;
    int tid = tid0; asm volatile("" : "+v"(tid));
    const int w = tid >> 6, lane = tid & 63, ql = lane & 31, h = lane >> 5;
    const int bg = j256 & 15, k16 = j256 >> 4;
    const int tile = rnd * 16 + ((rnd & 1) ? 15 - k16 : k16);
    const int b = bg >> 1, g = bg & 1;
    const int t0 = tile * 32, t = t0 + ql, hq = g * 8 + w;
    const long row = (long)b * S + t;
    const int cur = t0 >> 6;

    __syncthreads();
    const int tidi = tid;
    const int ntc = (t0 >> 9) + 1, nc = ntc * 32;
    for (int i = tidi; i < 32 * 65; i += NTHR) imp[i] = 0;
    if (tidi < 2) uni[tidi] = 0;
    bf16x8 qf[4];
    nsa_load_q((const u16*)(ws + OFF_PROJ), row, hq, h, qf);
    const int lr = tid >> 3, lch = tid & 7;
    uint4 kreg, vreg;
    const float gr0 = gates[row * 48 + hq], gr1 = gates[row * 48 + 16 + hq], gr2 = gates[row * 48 + 32 + hq];
    const float g0 = __builtin_amdgcn_rcpf(1.f + __expf(-gr0)), g1 = __builtin_amdgcn_rcpf(1.f + __expf(-gr1)), g2 = __builtin_amdgcn_rcpf(1.f + __expf(-gr2));
    {
      const u16* kcg = (const u16*)(ws + OFF_KCMP) + (size_t)bg * 256 * 64;
      const u16* vcg = (const u16*)(ws + OFF_VCMPT) + (size_t)bg * 256 * 64;
      uint4 kc4[4], vc4[4];
#pragma unroll
      for (int j = 0; j < 4; ++j) {
        const int i = tidi + j * NTHR;
        kc4[j] = *(const uint4*)(kcg + (i >> 3) * 64 + (i & 7) * 8); vc4[j] = *(const uint4*)(vcg + (i >> 3) * 64 + (i & 7) * 8);
      }
#pragma unroll
      for (int j = 0; j < 4; ++j) {
        const int i = tidi + j * NTHR;
        if (i < nc * 8) { *(uint4*)(Kc + (i >> 3) * KST + (i & 7) * 8) = kc4[j]; *(uint4*)(Vc + (i >> 3) * VST + (i & 7) * 8) = vc4[j]; }
      }
    }
    __syncthreads();

    f32x16 O[2];
    unsigned outp[16];
    bf16x8 pf[4];
    const int cmaxq = (t >= 31) ? ((t - 31) >> 4) : -1;
    float m = NEGF, l = 0.f;
    for (int ct = 0; ct < ntc; ++ct) {
      f32x16 s = qk_tile<KST>(Kc + ct * 32 * KST, qf, ql, h);
      float mx = NEGF;
#pragma unroll
      for (int i = 0; i < 16; ++i) {
        int c = ct * 32 + 4 * h + (i & 3) + 8 * (i >> 2);
        s[i] = (c <= cmaxq) ? s[i] : NEGF;
        mx = fmaxf(mx, s[i]);
      }
      mx = fmaxf(mx, shx(mx, 32, lane));
      const float mn = fmaxf(m, mx);
      float rs = 0.f;
#pragma unroll
      for (int i = 0; i < 16; ++i) rs += (s[i] > -1e29f) ? __builtin_amdgcn_exp2f(s[i] - mn) : 0.f;
      rs += shx(rs, 32, lane);
      l = l * __builtin_amdgcn_exp2f(m - mn) + rs;
      m = mn;
    }
    const float invl = (l > 0.f) ? 1.f / l : 0.f;
#pragma unroll
    for (int mb = 0; mb < 2; ++mb)
#pragma unroll
      for (int i = 0; i < 16; ++i) O[mb][i] = 0.f;
    for (int ct = 0; ct < ntc; ++ct) {
      f32x16 s = qk_tile<KST>(Kc + ct * 32 * KST, qf, ql, h);
#pragma unroll
      for (int i = 0; i < 16; ++i) {
        int c = ct * 32 + 4 * h + (i & 3) + 8 * (i >> 2);
        s[i] = (c <= cmaxq) ? __builtin_amdgcn_exp2f(s[i] - m) * invl : 0.f;
      }
#pragma unroll
      for (int a = 0; a < 4; ++a) {
        int n = ct * 8 + 2 * a + h;
        float mainv = s[4 * a] + s[4 * a + 1] + s[4 * a + 2] + 0.5f * s[4 * a + 3];
        float carry = 0.5f * s[4 * a + 3];
        unsigned um = (unsigned)(mainv * 16777216.f + 0.5f), uc = (unsigned)(carry * 16777216.f + 0.5f);
        if (um) atomicAdd(&imp[ql * 65 + n], um);
        if (uc && n < 63) atomicAdd(&imp[ql * 65 + n + 1], uc);
      }
#pragma unroll
      for (int s2 = 0; s2 < 2; ++s2) {
        unsigned u[4];
#pragma unroll
        for (int j = 0; j < 4; ++j) u[j] = pack2(s[8 * s2 + 2 * j], s[8 * s2 + 2 * j + 1]);
        pf[s2] = __builtin_bit_cast(bf16x8, *(uint4*)u);
      }
      pv_tile<2, VST>(Vc + ct * 32 * VST, pf, O, lane);
    }
#pragma unroll
    for (int mb = 0; mb < 2; ++mb)
#pragma unroll
      for (int i = 0; i < 16; i += 2) outp[mb * 8 + (i >> 1)] = pack2(g0 * O[mb][i], g0 * O[mb][i + 1]);
    __syncthreads();
    for (int qq = 0; qq < 4; ++qq) {
      const int q = w * 4 + qq;
      unsigned v = imp[q * 65 + lane];
      const bool valid = lane <= cur;
      const bool forced = (lane == 0) || (lane == cur) || (lane == cur - 1);
      if (forced) v += (1u << 30);
      int rank = 0;
      for (int mth = 0; mth <= cur; ++mth) {
        unsigned vm = __builtin_amdgcn_readlane(v, mth);
        rank += (vm > v || (vm == v && mth < lane)) ? 1 : 0;
      }
      u64 msk = __ballot(valid && rank < 16);
      if (lane == 0) { sel[q] = msk; atomicOr(&uni[0], (unsigned)msk); atomicOr(&uni[1], (unsigned)(msk >> 32)); }
    }
    __syncthreads();
    const u64 selq = sel[ql];
    const u64 unim = ((u64)uni[1] << 32) | uni[0];
    {
      const float4* r4 = (const float4*)((const float*)(ws + OFF_ROPE) + t * 16);
      const uint4 w4 = __builtin_bit_cast(uint4, qf[0]);
      unsigned wv[4] = {w4.x, w4.y, w4.z, w4.w};
#pragma unroll
      for (int j = 0; j < 4; ++j) {
        const unsigned pw = (unsigned)__builtin_amdgcn_ds_bpermute((lane ^ 32) << 2, (int)wv[j]);
        const float4 cs = r4[j];
        const float a0 = __uint_as_float(wv[j] << 16), a1 = __uint_as_float(wv[j] & 0xffff0000u);
        const float o0 = __uint_as_float(pw << 16), o1 = __uint_as_float(pw & 0xffff0000u);
        float n0, n1;
        if (h == 0) { n0 = a0 * cs.x - o0 * cs.y; n1 = a1 * cs.z - o1 * cs.w; }
        else { n0 = o0 * cs.y + a0 * cs.x; n1 = o1 * cs.w + a1 * cs.z; }
        wv[j] = pack2(n0, n1);
      }
      qf[0] = __builtin_bit_cast(bf16x8, make_uint4(wv[0], wv[1], wv[2], wv[3]));
    }

    for (int br = 1; br <= 2; ++br) {
      const u16* Kg = (br == 1 ? KS_g : KW_g) + (size_t)bg * S * 64;
      const u16* Vg = (br == 1 ? VS_g : VW_g) + (size_t)bg * S * 64;
      u64 tm;
      if (br == 1) tm = unim;
      else {
        int first = (t0 - 512) >> 6; if (first < 0) first = 0;
        tm = (~0ull >> (63 - cur)) & (~0ull << first);
      }
      m = 0.f; l = 0.f;
#pragma unroll
      for (int mb = 0; mb < 2; ++mb)
#pragma unroll
        for (int i = 0; i < 16; ++i) O[mb][i] = 0.f;
#define NSA_LD(KP, VP, nt) do { kreg = *(const uint4*)((KP) + (size_t)((nt) * 64 + lr) * 64 + lch * 8); \
                               vreg = *(const uint4*)((VP) + (size_t)((nt) * 64 + lr) * 64 + lch * 8); } while (0)
#define NSA_ST(bb) do { *(uint4*)(Kb + (bb) * 64 * KST + lr * KST + lch * 8) = kreg; *(uint4*)(Vb + (bb) * 64 * VST + lr * VST + lch * 8) = vreg; } while (0)
      int buf = 0;
      int n = __builtin_ctzll(tm);
      tm &= tm - 1;
      if (br == 1) NSA_LD(Kg, Vg, n);
      NSA_ST(0);
      int n1 = -1;
      if (tm) { n1 = __builtin_ctzll(tm); tm &= tm - 1; NSA_LD(Kg, Vg, n1); }
      bool wpre = false;
      __syncthreads();
      for (;;) {
        int n2 = -1;
        if (n1 >= 0) {
          NSA_ST(buf ^ 1);
          if (tm) { n2 = __builtin_ctzll(tm); tm &= tm - 1; NSA_LD(Kg, Vg, n2); }
        }
        if (br == 1 && n2 < 0 && !wpre) {
          int wf = (t0 - 512) >> 6; if (wf < 0) wf = 0;
          NSA_LD(KW_g + (size_t)bg * S * 64, VW_g + (size_t)bg * S * 64, wf);
          wpre = true;
        }
        const u16* Kt = Kb + buf * 64 * KST;
        const u16* Vt = Vb + buf * 64 * VST;
        int lo, hi = t;
        const bool lsel = (selq >> n) & 1;
        lo = (br == 1) ? -1 : t - 512;
        {
          const int kp0 = n * 64;
          const float init = (br == 2 || lsel) ? -m : NINF;
          bf16x8 fr8[8];
          k_load8<KST>(Kt, fr8, ql, h);
          f32x16 s0 = qk_mma(fr8, qf, init);
          f32x16 s1 = qk_mma(fr8 + 4, qf, init);
          pv_load<VST>(Vt, fr8, lane);
          float alpha; bool need;
          const bool interior = (kp0 + 63 <= t0) && (br == 1 || kp0 > t0 + 31 - 512);
          if (!interior) need = softmax_step64<true>(s0, s1, kp0 + 4 * h, lo, hi, m, l, alpha, pf, lane);
          else need = softmax_step64<false>(s0, s1, 0, 0, 0, m, l, alpha, pf, lane);
          if (need) {
#pragma unroll
            for (int mb = 0; mb < 2; ++mb)
#pragma unroll
              for (int i = 0; i < 16; ++i) O[mb][i] *= alpha;
          }
          pv_mma(fr8, pf, O);
          pv_load<VST>(Vt + 32 * VST, fr8 + 4, lane);
          pv_mma(fr8 + 4, pf + 2, O);
        }
        __syncthreads();
        if (n1 < 0) break;
        n = n1; n1 = n2; buf ^= 1;
      }
#undef NSA_LD
#undef NSA_ST
      l += shx(l, 32, lane);
      const float sc = (br == 1 ? g1 : g2) * ((l > 0.f) ? 1.f / l : 0.f);
#pragma unroll
      for (int mb = 0; mb < 2; ++mb)
#pragma unroll
        for (int i = 0; i < 16; i += 2) {
          const unsigned pk = outp[mb * 8 + (i >> 1)];
          const float a0 = sc * O[mb][i] + __uint_as_float(pk << 16), a1 = sc * O[mb][i + 1] + __uint_as_float(pk & 0xffff0000u);
          if (br == 1) outp[mb * 8 + (i >> 1)] = pack2(a0, a1);
          else { O[mb][i] = a0; O[mb][i + 1] = a1; }
        }
    }
#pragma unroll
    for (int mb = 0; mb < 2; ++mb)
#pragma unroll
      for (int a = 0; a < 4; ++a) {
        uint2 o; o.x = pack2(O[mb][4 * a], O[mb][4 * a + 1]); o.y = pack2(O[mb][4 * a + 2], O[mb][4 * a + 3]);
        *(uint2*)(Oout + row * D + hq * 64 + mb * 32 + 8 * a + 4 * h) = o;
      }
  }
}

DI bf16x8 rope_frag0(bf16x8 f, int t, int h, int lane, const float* rt) {
  const float4* r4 = (const float4*)(rt + t * 16);
  const uint4 w4 = __builtin_bit_cast(uint4, f);
  unsigned wv[4] = {w4.x, w4.y, w4.z, w4.w};
#pragma unroll
  for (int j = 0; j < 4; ++j) {
    const unsigned pw = (unsigned)__builtin_amdgcn_ds_bpermute((lane ^ 32) << 2, (int)wv[j]);
    const float4 cs = r4[j];
    const float a0 = __uint_as_float(wv[j] << 16), a1 = __uint_as_float(wv[j] & 0xffff0000u);
    const float o0 = __uint_as_float(pw << 16), o1 = __uint_as_float(pw & 0xffff0000u);
    float n0, n1;
    if (h == 0) { n0 = a0 * cs.x - o0 * cs.y; n1 = a1 * cs.z - o1 * cs.w; }
    else { n0 = o0 * cs.y + a0 * cs.x; n1 = o1 * cs.w + a1 * cs.z; }
    wv[j] = pack2(n0, n1);
  }
  return __builtin_bit_cast(bf16x8, make_uint4(wv[0], wv[1], wv[2], wv[3]));
}

DI void diff_attn_phase(const Params& p, char* smem, int j) {
  const int tid = get_tid(), w = tid >> 6, lane = tid & 63, ql = lane & 31, h = lane >> 5;
  char* ws = launder_ptr(p.ws);
  u16* K1b = (u16*)smem;
  u16* K2b = K1b + 2 * 64 * KST;
  u16* Vb = K2b + 2 * 64 * KST;
  u16* Qs = Vb + 2 * 64 * VDS + w * (2 * 32 * KST);
  const int layer = 2 + j;
  const float lambda_init = (layer == 2) ? 0.47071301834f : 0.55605820415f;
  float lam;
  {
    float a = p.in[21][j * 64 + lane] * p.in[22][j * 64 + lane];
    float c = p.in[23][j * 64 + lane] * p.in[24][j * 64 + lane];
#pragma unroll
    for (int o = 32; o > 0; o >>= 1) { a += shx(a, o, lane); c += shx(c, o, lane); }
    lam = expf(a) - expf(c) + lambda_init;
  }
  const u16* QD = (const u16*)(ws + OFF_PROJ);
  u16* Oout = (u16*)(ws + OFF_QR);
  const float* sg = p.in[25] + j * 128;

  for (int item = blockIdx.x; item < 1024; item += gridDim.x) {
    const int rnd = item >> 8, j256 = item & 255;
    const int bh = j256 & 63, kq = j256 >> 6;
    const int qb = (rnd == 0) ? kq : (rnd == 1) ? 15 - kq : (rnd == 2) ? 4 + kq : 11 - kq;
    const int b = bh >> 3, hd = bh & 7;
    const int t0 = qb * 256 + w * 32, t = t0 + ql;
    const long row = (long)b * S + t;
    const u16* K1g = (const u16*)(ws + OFF_KD) + ((size_t)((b * 2 + 0) * 8 + hd)) * S * 64;
    const u16* K2g = (const u16*)(ws + OFF_KD) + ((size_t)((b * 2 + 1) * 8 + hd)) * S * 64;
    const u16* Vg = (const u16*)(ws + OFF_VD) + ((size_t)(b * 8 + hd)) * S * 128;
#pragma unroll
    for (int ks = 0; ks < 4; ++ks) {
      bf16x8 qa = *(const bf16x8*)(QD + row * D + hd * 64 + ks * 16 + h * 8);
      bf16x8 qb2 = *(const bf16x8*)(QD + row * D + 512 + hd * 64 + ks * 16 + h * 8);
      if (ks == 0) {
        qa = rope_frag0(qa, t, h, lane, (const float*)(ws + OFF_ROPE));
        qb2 = rope_frag0(qb2, t, h, lane, (const float*)(ws + OFF_ROPE));
      }
      *(bf16x8*)(Qs + ql * KST + ks * 16 + h * 8) = qa;
      *(bf16x8*)(Qs + 32 * KST + ql * KST + ks * 16 + h * 8) = qb2;
    }
    f32x16 O1[4], O2[4];
#pragma unroll
    for (int mb = 0; mb < 4; ++mb)
#pragma unroll
      for (int i = 0; i < 16; ++i) { O1[mb][i] = 0.f; O2[mb][i] = 0.f; }
    float m1 = 0.f, l1 = 0.f, m2 = 0.f, l2 = 0.f;
    const int ntile = (qb + 1) * 4;
    const int lr = tid >> 3, lch = tid & 7;
    uint4 k1r, k2r;
    __syncthreads();
    {
      k1r = *(const uint4*)(K1g + (size_t)lr * 64 + lch * 8);
      k2r = *(const uint4*)(K2g + (size_t)lr * 64 + lch * 8);
      *(uint4*)(K1b + lr * KST + lch * 8) = k1r;
      *(uint4*)(K2b + lr * KST + lch * 8) = k2r;
      k1r = *(const uint4*)(Vg + (size_t)lr * 128 + lch * 8);
      k2r = *(const uint4*)(Vg + (size_t)lr * 128 + 64 + lch * 8);
      *(uint4*)(Vb + lr * VDS + lch * 8) = k1r;
      *(uint4*)(Vb + lr * VDS + 64 + lch * 8) = k2r;
      if (ntile > 1) {
        k1r = *(const uint4*)(Vg + (size_t)(64 + lr) * 128 + lch * 8);
        k2r = *(const uint4*)(Vg + (size_t)(64 + lr) * 128 + 64 + lch * 8);
      }
    }
    __syncthreads();
    int buf = 0;
    for (int n = 0; n < ntile; ++n) {
      const bool more = (n + 1 < ntile);
      if (more) {
        const int nb = buf ^ 1, k0 = (n + 1) * 64;
        *(uint4*)(Vb + nb * 64 * VDS + lr * VDS + lch * 8) = k1r;
        *(uint4*)(Vb + nb * 64 * VDS + lr * VDS + 64 + lch * 8) = k2r;
        k1r = *(const uint4*)(K1g + (size_t)(k0 + lr) * 64 + lch * 8);
        k2r = *(const uint4*)(K2g + (size_t)(k0 + lr) * 64 + lch * 8);
      }
      const u16* K1t = K1b + buf * 64 * KST;
      const u16* K2t = K2b + buf * 64 * KST;
      const u16* Vt = Vb + buf * 64 * VDS;
#pragma unroll
      for (int sub = 0; sub < 2; ++sub) {
        if (sub == 1 && more) {
          const int nb = buf ^ 1, k0 = (n + 2) * 64;
          *(uint4*)(K1b + nb * 64 * KST + lr * KST + lch * 8) = k1r;
          *(uint4*)(K2b + nb * 64 * KST + lr * KST + lch * 8) = k2r;
          if (n + 2 < ntile) {
            k1r = *(const uint4*)(Vg + (size_t)(k0 + lr) * 128 + lch * 8);
            k2r = *(const uint4*)(Vg + (size_t)(k0 + lr) * 128 + 64 + lch * 8);
          }
        }
        const int kp0 = n * 64 + sub * 32;
        if (kp0 > t0 + 31) continue;
        bf16x8 pf1[2], pf2[2];
        {
          f32x16 sA = qk_tile_lds<KST>(K1t + sub * 32 * KST, Qs, ql, h, -m1);
          f32x16 sB = qk_tile_lds<KST>(K2t + sub * 32 * KST, Qs + 32 * KST, ql, h, -m2);
          float alpha1, alpha2; bool need1, need2;
          if (kp0 + 31 <= t0) {
            need1 = softmax_step<false>(sA, 0, 0, 0, m1, l1, alpha1, pf1, lane);
            need2 = softmax_step<false>(sB, 0, 0, 0, m2, l2, alpha2, pf2, lane);
          } else {
            need1 = softmax_step<true>(sA, kp0 + 4 * h, -1, t, m1, l1, alpha1, pf1, lane);
            need2 = softmax_step<true>(sB, kp0 + 4 * h, -1, t, m2, l2, alpha2, pf2, lane);
          }
          if (need1 || need2) {
#pragma unroll
            for (int mb = 0; mb < 4; ++mb)
#pragma unroll
              for (int i = 0; i < 16; ++i) { O1[mb][i] *= alpha1; O2[mb][i] *= alpha2; }
          }
        }
        {
          const int l16 = lane & 15, tq = l16 >> 2, tp = l16 & 3, blk = (lane >> 4) & 1;
          const u16* vbase = Vt + (sub * 32 + 4 * h + tq) * VDS + 16 * blk + 4 * tp;
#pragma unroll
          for (int mb = 0; mb < 4; ++mb)
#pragma unroll
            for (int s2 = 0; s2 < 2; ++s2) {
              s16x4 lo = tr_read(vbase + (16 * s2) * VDS + mb * 32);
              s16x4 hi = tr_read(vbase + (16 * s2 + 8) * VDS + mb * 32);
              bf16x8 a = __builtin_shufflevector(lo, hi, 0, 1, 2, 3, 4, 5, 6, 7);
              O1[mb] = mfma32(a, pf1[s2], O1[mb]);
              O2[mb] = mfma32(a, pf2[s2], O2[mb]);
            }
        }
      }
      __syncthreads();
      buf ^= 1;
    }
    l1 += shx(l1, 32, lane); l2 += shx(l2, 32, lane);
    const float i1 = 1.f / l1, i2 = lam / l2;
    float ss = 0.f;
#pragma unroll
    for (int mb = 0; mb < 4; ++mb)
#pragma unroll
      for (int i = 0; i < 16; ++i) { float o = O1[mb][i] * i1 - O2[mb][i] * i2; O1[mb][i] = o; ss += o * o; }
    ss += shx(ss, 32, lane);
    const float rn = rsqrtf(ss * (1.f / 128.f) + 1e-5f) * (1.f - lambda_init);
#pragma unroll
    for (int mb = 0; mb < 4; ++mb)
#pragma unroll
      for (int a = 0; a < 4; ++a) {
        const int dv = mb * 32 + 8 * a + 4 * h;
        float4 gg = *(const float4*)(sg + dv);
        uint2 o;
        o.x = pack2(O1[mb][4 * a] * rn * gg.x, O1[mb][4 * a + 1] * rn * gg.y);
        o.y = pack2(O1[mb][4 * a + 2] * rn * gg.z, O1[mb][4 * a + 3] * rn * gg.w);
        *(uint2*)(Oout + row * D + hd * 128 + dv) = o;
      }
  }
}


#define XB_TMO      128
#define XB_XCNT(j)  (256  + 64 * (j))
#define XB_XSUB(j)  (1280 + 64 * (j))
#define XB_XGEN(j)  (2304 + 64 * (j))
#define XB_TOP      3328
#define XB_TOPGEN   3392
#define XCD_BAR_WORDS 3456
#define XB_SPIN_CAP (1u << 22)
DI unsigned xb_ld(unsigned* p) { return __hip_atomic_load(p, __ATOMIC_RELAXED, __HIP_MEMORY_SCOPE_AGENT); }
DI unsigned xb_add(unsigned* p, unsigned v) { return __hip_atomic_fetch_add(p, v, __ATOMIC_RELAXED, __HIP_MEMORY_SCOPE_AGENT); }
DI unsigned xb_xcc_id() { return (unsigned)__builtin_amdgcn_s_getreg((3 << 11) | 20) & 0xFu; }
#define XB_SPIN(cond, bar) do { unsigned _sp = 0; while (cond) { __builtin_amdgcn_s_sleep(1); \
    if ((++_sp & 255u) == 0u) { if (xb_ld(&(bar)[XB_TMO])) break; if (_sp > XB_SPIN_CAP) { atomicAdd(&(bar)[XB_TMO], 1u); break; } } } } while (0)
struct XcdBarrier { unsigned* bar; unsigned x; volatile LAS unsigned* st; };
DI XcdBarrier xcd_barrier_post(unsigned* bar, volatile LAS unsigned* st) {
  XcdBarrier b; b.bar = bar; b.x = xb_xcc_id(); b.st = st;
  if (get_tid() == 0) (void)xb_add(&bar[XB_XCNT(b.x)], 1u);
  return b;
}
DI void xcd_barrier_complete(unsigned* bar, unsigned x, unsigned& nloc, unsigned& nx) {
  const unsigned G = gridDim.x * gridDim.y * gridDim.z;
  unsigned sum, cnt, mine, sp = 0u;
  for (;;) {
    sum = 0u; cnt = 0u; mine = 0u;
#pragma unroll
    for (unsigned j = 0; j < 16; ++j) { const unsigned c = xb_ld(&bar[XB_XCNT(j)]); sum += c; cnt += (c > 0u) ? 1u : 0u; mine = (j == x) ? c : mine; }
    if (sum == G) break;
    __builtin_amdgcn_s_sleep(1);
    if ((++sp & 255u) == 0u) { if (xb_ld(&bar[XB_TMO])) break; if (sp > XB_SPIN_CAP) { atomicAdd(&bar[XB_TMO], 1u); break; } }
  }
  nloc = mine > 0u ? mine : 1u; nx = cnt > 0u ? cnt : 1u;
}
DI void xcd_barrier(const XcdBarrier& b) {
  asm volatile("s_waitcnt vmcnt(0)" ::: "memory");
  __syncthreads();
  if (get_tid() == 0) {
    unsigned* bar = b.bar;
    __builtin_amdgcn_s_waitcnt(0);
    unsigned nloc = b.st[0], nx = b.st[1];
    if (nloc == 0u) { xcd_barrier_complete(bar, b.x, nloc, nx); b.st[0] = nloc; b.st[1] = nx; }
    const unsigned old = xb_add(&bar[XB_XSUB(b.x)], 1u);
    const unsigned gen = old / nloc;
    if (old + 1u == (gen + 1u) * nloc) {
      __builtin_amdgcn_fence(__ATOMIC_RELEASE, "agent");
      asm volatile("s_waitcnt vmcnt(0)" ::: "memory");
      const unsigned og = xb_add(&bar[XB_TOP], 1u);
      const unsigned tg = og / nx;
      if (og + 1u == (tg + 1u) * nx) xb_add(&bar[XB_TOPGEN], 1u);
      else XB_SPIN(xb_ld(&bar[XB_TOPGEN]) == tg, bar);
      __builtin_amdgcn_fence(__ATOMIC_ACQUIRE, "agent");
      xb_add(&bar[XB_XGEN(b.x)], 1u);
      asm volatile("s_waitcnt vmcnt(0)" ::: "memory");
    } else {
      XB_SPIN(xb_ld(&bar[XB_XGEN(b.x)]) == gen, bar);
      __builtin_amdgcn_fence(__ATOMIC_ACQUIRE, "agent");
      asm volatile("s_waitcnt vmcnt(0)" ::: "memory");
    }
  }
  __syncthreads();
}

__global__ void __launch_bounds__(NTHR) mega(Params p, int ph_lo, int ph_hi, int coop) {
  extern __shared__ __attribute__((aligned(16))) char smem[];
  cg::grid_group grid = cg::this_grid();
  volatile LAS unsigned* xst = (volatile LAS unsigned*)(smem + SMEM_BYTES - 16);
  if (get_tid() == 0) { xst[0] = 0u; xst[1] = 0u; }
  __syncthreads();
  const XcdBarrier xb = xcd_barrier_post((unsigned*)(p.ws + OFF_BAR), xst);
  int ph = 0;
  if (ph_hi < 0) grid.sync();
  if (ph >= ph_lo && ph < ph_hi) { prep_phase(p, smem); if (coop && ph + 1 < ph_hi) xcd_barrier(xb); }
  ++ph;
  for (int l = 0; l < 4; ++l) {
    for (int st = 0; st < 12; ++st) {
      if (st == 4 && l >= 2) continue;
      if (st == 11 && l != 1) continue;
      if (st == 2 || st == 7 || st == 10) continue;
      if (ph >= ph_lo && ph < ph_hi) {
        char* wsl = launder_ptr(p.ws);
        char* wb = layer_w(wsl, l);
        char* mb = wb + 2 * (SZ_WGU + SZ_WD);
        const u16* XB = (const u16*)(wsl + OFF_XB);
        const u16* HB = (const u16*)(wsl + OFF_H);
        int kind = 0;
        const u16* A = XB; const u16* Bt = nullptr; int N = D, K = D, mode = EPI_RESID; float coef = 1.f; int lni = 0;
        switch (st) {
          case 0: Bt = (const u16*)wb; N = 2 * F; mode = EPI_GATEUP; break;
          case 1: A = HB; Bt = (const u16*)(wb + SZ_WGU); K = F; coef = 0.5f; lni = l * 3; break;
          case 2: kind = 1; lni = l * 3; break;
          case 3: Bt = (const u16*)mb; if (l < 2) { N = 2048; mode = EPI_NSA_IN; } else { mode = EPI_DIFF_Q; } break;
          case 4: kind = 2; break;
          case 5: kind = (l < 2) ? 3 : 4; break;
          case 6: A = (const u16*)(wsl + (l < 2 ? OFF_PROJ : OFF_QR)); Bt = (const u16*)(mb + (l < 2 ? 4194304 : 2097152)); lni = l * 3 + 1; break;
          case 7: kind = 1; lni = l * 3 + 1; break;
          case 8: Bt = (const u16*)(wb + SZ_WGU + SZ_WD); N = 2 * F; mode = EPI_GATEUP; break;
          case 9: A = HB; Bt = (const u16*)(wb + SZ_WGU + SZ_WD + SZ_WGU); K = F; coef = 0.5f; lni = l * 3 + 2; break;
          case 10: kind = 1; lni = l * 3 + 2; break;
          default: Bt = (const u16*)(wsl + OFF_WKV); N = 2048; mode = EPI_DIFF_KV; break;
        }
        if (kind == 0) gemm_phase(p, smem, A, Bt, N, K, mode, coef, lni, p.in[7] + (size_t)lni * D, p.in[8] + (size_t)lni * D);
        else if (kind == 2) compress_phase(p, smem, l);
        else if (kind == 3) nsa_attn_phase(p, smem);
        else diff_attn_phase(p, smem, l - 2);
        if (coop && ph + 1 < ph_hi) xcd_barrier(xb);
      }
      ++ph;
    }
  }
}

extern "C" void kernel_launch(void* const* d_in, const int* in_sizes, int n_in, void* d_out, int out_size, void* d_ws,
                              size_t ws_size, hipStream_t stream) {
  if (n_in < 27 || ws_size < WS_NEED) { fprintf(stderr, "bad args: n_in %d ws %zu need %zu\n", n_in, ws_size, (size_t)WS_NEED); return; }
  Params p{};
  for (int i = 0; i < 27; ++i) p.in[i] = (const float*)d_in[i];
  p.out = (float*)d_out;
  p.ws = (char*)d_ws;
  static int grid_blocks = 0;
  (void)hipFuncSetAttribute((const void*)mega, hipFuncAttributeMaxDynamicSharedMemorySize, SMEM_BYTES);
  if (!grid_blocks) {
    int dev = 0, cus = 0, per_cu = 0;
    (void)hipGetDevice(&dev);
    (void)hipDeviceGetAttribute(&cus, hipDeviceAttributeMultiprocessorCount, dev);
    (void)hipOccupancyMaxActiveBlocksPerMultiprocessor(&per_cu, mega, NTHR, SMEM_BYTES);
    if (per_cu < 1) per_cu = 1;
    grid_blocks = cus;
    if (grid_blocks % 8) grid_blocks -= grid_blocks % 8;
  }
  (void)hipMemsetAsync((char*)d_ws + OFF_BAR, 0, 16384 + 32768, stream);
  int lo = 0, hi = 1000, coop = 1;
  void* args[] = {&p, &lo, &hi, &coop};
  hipError_t e = hipLaunchCooperativeKernel((const void*)mega, dim3(grid_blocks), dim3(NTHR), args, SMEM_BYTES, stream);
  if (e != hipSuccess) fprintf(stderr, "cooperative launch failed: %s (grid %d)\n", hipGetErrorString(e), grid_blocks);
}
```
